# Optimizing an MI355X kernel written in HIP

```python
import jax, jax.numpy as jnp
from jax import lax
import numpy as np

D_MODEL = 1024
BATCH = 32
SEQ = 256
DEPTH = 4
DEC_BATCH = 2
DEC_SEQ = 2048
PAST_LEN = 256

GRID_W = 64
N_MIXERS = 3
CHUNK = 128
D_GMLP = 2 * D_MODEL
N_GROUPS_A = 8
POOL_WINDOWS = (2, 4, 8, 16)
N_POOL_GROUPS = 4
D_POOL_GROUP = D_MODEL // N_POOL_GROUPS
N_HEADS = 16
N_KV_HEADS = 4
HEAD_DIM = 64
Q_PER_KV = N_HEADS // N_KV_HEADS
WINDOW = 128
BLOCK = 128
ROPE_THETA = 10000.0
D_FF = 2816
CONV_W = 3
N_A_LAYERS = (DEPTH + 2) // 3
N_B_LAYERS = (DEPTH + 1) // 3
N_C_LAYERS = DEPTH // 3
EPS = 1e-6
NEG_INF = -1e30

kernel_name = 'hybrid_dit_gmlp_pool_swa_step'


def rms_norm(x, g):
    xf = x.astype(jnp.float32)
    y = xf * lax.rsqrt(jnp.mean(xf * xf, axis=-1, keepdims=True) + EPS)
    return (y * g.astype(jnp.float32)).astype(x.dtype)


def ada_params(cond, w, b):
    m = jax.nn.silu(cond) @ w + b
    return jnp.split(m[:, None, :], 6, axis=-1)


def chunk_gmlp(h, w_in, g_v, w_s, b_s, w_out):
    B, S, _ = h.shape
    z = jax.nn.gelu(h @ w_in)
    u, v = jnp.split(z, 2, axis=-1)
    v = rms_norm(v, g_v)
    vc = v.reshape(B, S // CHUNK, CHUNK, N_GROUPS_A, D_GMLP // N_GROUPS_A)
    sv = jnp.einsum('gij,bnjgc->bnigc', w_s, vc) + b_s.T[None, None, :, :, None]
    return (u * sv.reshape(B, S, D_GMLP)) @ w_out


def multi_pool(h, w_grp, b_grp, scale):
    B, S, D = h.shape
    hf = h.astype(jnp.float32).reshape(B, S, N_POOL_GROUPS, D_POOL_GROUP)
    cs = jnp.concatenate([jnp.zeros_like(hf[:, :1]), jnp.cumsum(hf, axis=1)], axis=1)
    t = jnp.arange(S)[:, None]
    half = jnp.array(POOL_WINDOWS, dtype=jnp.int32)[None, :] // 2
    lo = jnp.clip(t - half, 0, S - 1)
    hi = jnp.clip(t + half - 1, 0, S - 1)
    gi = jnp.arange(N_POOL_GROUPS)[None, :]
    cnt = (hi - lo + 1).astype(jnp.float32)[None, :, :, None]
    pooled = (cs[:, hi + 1, gi] - cs[:, lo, gi]) / cnt
    d = (pooled - hf).astype(h.dtype)
    y = jnp.einsum('bsgi,gio->bsgo', d, w_grp).reshape(B, S, D) + b_grp
    return y * scale


def qkv_proj(h, w_qkv, g_q, g_k):
    B, S, _ = h.shape
    q, k, v = jnp.split(h @ w_qkv, [N_HEADS * HEAD_DIM, (N_HEADS + N_KV_HEADS) * HEAD_DIM], axis=-1)
    q = rms_norm(q.reshape(B, S, N_HEADS, HEAD_DIM), g_q)
    k = rms_norm(k.reshape(B, S, N_KV_HEADS, HEAD_DIM), g_k)
    return q, k, v.reshape(B, S, N_KV_HEADS, HEAD_DIM)


def axial_rope(x):
    B, S, H, _ = x.shape
    rows = S // GRID_W
    row = jnp.repeat(jnp.arange(rows), GRID_W).astype(jnp.float32)
    col = jnp.tile(jnp.arange(GRID_W), rows).astype(jnp.float32)
    n_freq = HEAD_DIM // 4
    inv = ROPE_THETA ** (-jnp.arange(n_freq, dtype=jnp.float32) / n_freq)
    ang = jnp.stack([row[:, None] * inv, col[:, None] * inv], axis=1)[:, None]
    cos, sin = jnp.cos(ang), jnp.sin(ang)
    xr = x.astype(jnp.float32).reshape(B, S, H, 2, 2, n_freq)
    a, b = xr[..., 0, :], xr[..., 1, :]
    out = jnp.stack([a * cos - b * sin, a * sin + b * cos], axis=-2)
    return out.reshape(x.shape).astype(x.dtype)


def sink_softmax(scores, sink):
    sk = jnp.broadcast_to(sink[:, :, None, None].astype(jnp.float32), scores.shape[:-1] + (1,))
    p = jax.nn.softmax(jnp.concatenate([scores, sk], axis=-1), axis=-1)
    return p[..., :-1]


def context_attention(q, k, v, sink):
    B, S = q.shape[:2]
    nb = S // BLOCK
    scale = HEAD_DIM ** -0.5
    qb = q.reshape(B, nb, BLOCK, N_KV_HEADS, Q_PER_KV, HEAD_DIM).transpose(1, 0, 2, 3, 4, 5)

    def one_block(qi):
        s = jnp.einsum('bqkgd,bskd->bkgqs', qi, k, preferred_element_type=jnp.float32) * scale
        p = sink_softmax(s, sink).astype(v.dtype)
        return jnp.einsum('bkgqs,bskd->bqkgd', p, v)

    o = lax.map(one_block, qb)
    return o.transpose(1, 0, 2, 3, 4, 5).reshape(B, S, N_HEADS * HEAD_DIM)


def latent_attention(q, k, v, ctx_k, ctx_v, sink):
    B, S = q.shape[:2]
    nb = S // BLOCK
    span = 3 * BLOCK
    scale = HEAD_DIM ** -0.5
    qb = q.reshape(B, nb, BLOCK, N_KV_HEADS, Q_PER_KV, HEAD_DIM).transpose(1, 0, 2, 3, 4, 5)
    pad = ((0, 0), (BLOCK, BLOCK), (0, 0), (0, 0))
    kp, vp = jnp.pad(k, pad), jnp.pad(v, pad)

    def one_block(args):
        qi, n = args
        start = n * BLOCK
        kw = lax.dynamic_slice_in_dim(kp, start, span, axis=1)
        vw = lax.dynamic_slice_in_dim(vp, start, span, axis=1)
        qpos = start + jnp.arange(BLOCK)
        kpos = start - BLOCK + jnp.arange(span)
        valid = (kpos[None, :] >= 0) & (kpos[None, :] < S) & (jnp.abs(qpos[:, None] - kpos[None, :]) <= WINDOW)
        s_w = jnp.einsum('bqkgd,bskd->bkgqs', qi, kw, preferred_element_type=jnp.float32) * scale
        s_w = jnp.where(valid, s_w, NEG_INF)
        s_c = jnp.einsum('bqkgd,bskd->bkgqs', qi, ctx_k, preferred_element_type=jnp.float32) * scale
        p = sink_softmax(jnp.concatenate([s_w, s_c], axis=-1), sink).astype(v.dtype)
        return (jnp.einsum('bkgqs,bskd->bqkgd', p[..., :span], vw)
                + jnp.einsum('bkgqs,bskd->bqkgd', p[..., span:], ctx_v))

    o = lax.map(one_block, (qb, jnp.arange(nb)))
    return o.transpose(1, 0, 2, 3, 4, 5).reshape(B, S, N_HEADS * HEAD_DIM)


def conv_ffn(h, w_in, conv_w, conv_b, w_out):
    a, u = jnp.split(h @ w_in, 2, axis=-1)
    ap = jnp.pad(a, ((0, 0), (1, 1), (0, 0)))
    a = ap[:, :-2] * conv_w[0] + ap[:, 1:-1] * conv_w[1] + ap[:, 2:] * conv_w[2] + conv_b
    return (jax.nn.gelu(a) * u) @ w_out


def run_trunk(x, cond, is_context, cache_k, cache_v, weights):
    (w_ada, b_ada, g_mix, g_ffn, w_ffn_in, ffn_conv_w, ffn_conv_b, w_ffn_out,
     a_w_in, a_g_v, a_w_s, a_b_s, a_w_out,
     p_w, p_b, p_scale,
     c_w_qkv, c_g_q, c_g_k, c_sink, c_w_o) = weights
    new_k, new_v = [], []
    for i in range(DEPTH):
        kind, j = i % N_MIXERS, i // N_MIXERS
        sh1, sc1, gt1, sh2, sc2, gt2 = ada_params(cond, w_ada[i], b_ada[i])
        h = rms_norm(x, g_mix[i]) * (1 + sc1) + sh1
        if kind == 0:
            y = chunk_gmlp(h, a_w_in[j], a_g_v[j], a_w_s[j], a_b_s[j], a_w_out[j])
        elif kind == 1:
            y = multi_pool(h, p_w[j], p_b[j], p_scale[j])
        else:
            q, k, v = qkv_proj(h, c_w_qkv[j], c_g_q[j], c_g_k[j])
            sink = c_sink[j].reshape(N_KV_HEADS, Q_PER_KV)
            if is_context:
                o = context_attention(q, k, v, sink)
                new_k.append(k)
                new_v.append(v)
            else:
                o = latent_attention(axial_rope(q), axial_rope(k), v, cache_k[:, j], cache_v[:, j], sink)
            y = o @ c_w_o[j]
        x = x + gt1 * y
        h = rms_norm(x, g_ffn[i]) * (1 + sc2) + sh2
        x = x + gt2 * conv_ffn(h, w_ffn_in[i], ffn_conv_w[i], ffn_conv_b[i], w_ffn_out[i])
    return x, new_k, new_v


def setup_inputs(seed: int = 0) -> dict:
    key = jax.random.key(seed)
    ks = jax.random.split(key, 32)
    nrm = jax.random.normal
    D = D_MODEL
    f32 = jnp.float32
    kvd = (N_C_LAYERS, PAST_LEN, N_KV_HEADS, HEAD_DIM)
    return {
        'x_prompt': nrm(ks[0], (BATCH, SEQ, D), f32),
        'x_sample': nrm(ks[1], (DEC_BATCH, DEC_SEQ, D), f32),
        'cache_k': nrm(ks[2], (DEC_BATCH,) + kvd, f32),
        'cache_v': nrm(ks[3], (DEC_BATCH,) + kvd, f32),
        'c': nrm(ks[4], (DEC_BATCH, D), f32),
        'c_ctx': nrm(ks[5], (D,), f32),
        'w_ada': nrm(ks[6], (DEPTH, D, 6 * D), f32) * (0.5 * D ** -0.5),
        'b_ada': nrm(ks[7], (DEPTH, 6 * D), f32) * 0.01,
        'g_mix': 1.0 + 0.1 * nrm(ks[8], (DEPTH, D), f32),
        'g_ffn': 1.0 + 0.1 * nrm(ks[9], (DEPTH, D), f32),
        'w_ffn_in': nrm(ks[10], (DEPTH, D, 2 * D_FF), f32) * D ** -0.5,
        'ffn_conv_w': nrm(ks[11], (DEPTH, CONV_W, D_FF), f32) * CONV_W ** -0.5,
        'ffn_conv_b': nrm(ks[12], (DEPTH, D_FF), f32) * 0.02,
        'w_ffn_out': nrm(ks[13], (DEPTH, D_FF, D), f32) * D_FF ** -0.5,
        'a_w_in': nrm(ks[14], (N_A_LAYERS, D, 2 * D_GMLP), f32) * D ** -0.5,
        'a_g_v': 1.0 + 0.1 * nrm(ks[15], (N_A_LAYERS, D_GMLP), f32),
        'a_w_s': nrm(ks[16], (N_A_LAYERS, N_GROUPS_A, CHUNK, CHUNK), f32) * CHUNK ** -0.5,
        'a_b_s': 1.0 + 0.1 * nrm(ks[17], (N_A_LAYERS, N_GROUPS_A, CHUNK), f32),
        'a_w_out': nrm(ks[18], (N_A_LAYERS, D_GMLP, D), f32) * D_GMLP ** -0.5,
        'p_w': nrm(ks[19], (N_B_LAYERS, N_POOL_GROUPS, D_POOL_GROUP, D_POOL_GROUP), f32) * D_POOL_GROUP ** -0.5,
        'p_b': nrm(ks[20], (N_B_LAYERS, D), f32) * 0.02,
        'p_scale': 1.0 + 0.1 * nrm(ks[21], (N_B_LAYERS, D), f32),
        'c_w_qkv': nrm(ks[22], (N_C_LAYERS, D, (N_HEADS + 2 * N_KV_HEADS) * HEAD_DIM), f32) * D ** -0.5,
        'c_g_q': 1.0 + 0.1 * nrm(ks[23], (N_C_LAYERS, HEAD_DIM), f32),
        'c_g_k': 1.0 + 0.1 * nrm(ks[24], (N_C_LAYERS, HEAD_DIM), f32),
        'c_sink': nrm(ks[25], (N_C_LAYERS, N_HEADS), f32),
        'c_w_o': nrm(ks[26], (N_C_LAYERS, N_HEADS * HEAD_DIM, D), f32) * (N_HEADS * HEAD_DIM) ** -0.5,
    }


def reference(x_prompt, x_sample, cache_k, cache_v, c, c_ctx,
              w_ada, b_ada, g_mix, g_ffn, w_ffn_in, ffn_conv_w, ffn_conv_b, w_ffn_out,
              a_w_in, a_g_v, a_w_s, a_b_s, a_w_out,
              p_w, p_b, p_scale,
              c_w_qkv, c_g_q, c_g_k, c_sink, c_w_o):
    weights = (w_ada, b_ada, g_mix, g_ffn, w_ffn_in, ffn_conv_w, ffn_conv_b, w_ffn_out,
               a_w_in, a_g_v, a_w_s, a_b_s, a_w_out,
               p_w, p_b, p_scale,
               c_w_qkv, c_g_q, c_g_k, c_sink, c_w_o)
    y_prompt, ks_ctx, vs_ctx = run_trunk(x_prompt, c_ctx[None, :], True, None, None, weights)
    new_cache_k = jnp.stack(ks_ctx, axis=1)
    new_cache_v = jnp.stack(vs_ctx, axis=1)
    y_sample, _, _ = run_trunk(x_sample, c, False, cache_k, cache_v, weights)
    return (y_prompt, y_sample, new_cache_k, new_cache_v)
```

```cpp
#include <hip/hip_runtime.h>
#include <hip/hip_cooperative_groups.h>
#include <cstdio>
#include <cstdint>
namespace cg = cooperative_groups;

#ifndef ONE_LAUNCH
#define ONE_LAUNCH 1
#endif

typedef unsigned short bf16_t;
typedef short bf16x8 __attribute__((ext_vector_type(8)));
typedef float f32x16 __attribute__((ext_vector_type(16)));
typedef __bf16 bf16x2_t __attribute__((ext_vector_type(2)));
typedef float f32x2_t __attribute__((ext_vector_type(2)));

constexpr int T = 12288;
constexpr int TCTX = 8192;
constexpr int NPH = 20;
constexpr float LOG2E = 1.4426950408889634f;

struct P {
  const float *x_prompt, *x_sample, *cache_k, *cache_v, *c, *c_ctx;
  const float *w_ada, *b_ada, *g_mix, *g_ffn, *w_ffn_in, *ffn_conv_w, *ffn_conv_b, *w_ffn_out;
  const float *a_w_in, *a_g_v, *a_w_s, *a_b_s, *a_w_out;
  const float *p_w, *p_b, *p_scale;
  const float *c_w_qkv, *c_g_q, *c_g_k, *c_sink, *c_w_o;
  __attribute__((address_space(1))) float* out_g;
  __device__ __forceinline__ float* xo() const { return (float*)out_g; }
  __attribute__((address_space(1))) char* ws;
  __device__ __forceinline__ float* mod() const { return (float*)(ws + 13824ull); }
  __device__ __forceinline__ float* vsq() const { return (float*)(ws + 308736ull); }
  __device__ __forceinline__ bf16_t* wt_ffn_in() const { return (bf16_t*)(ws + 407040ull); }
  __device__ __forceinline__ bf16_t* wt_ffn_out() const { return (bf16_t*)(ws + 46544384ull); }
  __device__ __forceinline__ bf16_t* wt_a_in() const { return (bf16_t*)(ws + 69613056ull); }
  __device__ __forceinline__ bf16_t* wt_a_out() const { return (bf16_t*)(ws + 86390272ull); }
  __device__ __forceinline__ bf16_t* wt_p() const { return (bf16_t*)(ws + 94778880ull); }
  __device__ __forceinline__ bf16_t* wt_qkv() const { return (bf16_t*)(ws + 95303168ull); }
  __device__ __forceinline__ bf16_t* wt_o() const { return (bf16_t*)(ws + 98448896ull); }
  __device__ __forceinline__ bf16_t* ck() const { return (bf16_t*)(ws + 100546048ull); }
  __device__ __forceinline__ bf16_t* cvT() const { return (bf16_t*)(ws + 100808192ull); }
  __device__ __forceinline__ bf16_t* h() const { return (bf16_t*)(ws + 101070336ull); }
  __device__ __forceinline__ char* big1() const { return (char*)(ws + 126236160ull); }
  __device__ __forceinline__ char* big2() const { return (char*)(ws + 264648192ull); }
  __device__ __forceinline__ float* ha() const { return (float*)(ws + 333854208ull); }
  __device__ __forceinline__ float* hu() const { return (float*)(ws + 334575104ull); }
  __device__ __forceinline__ float* rowsq() const { return (float*)(ws + 334935552ull); }
  __device__ __forceinline__ float* shw() const { return (float*)(ws + 335328768ull); }
};

__device__ __forceinline__ unsigned pk_bf16(float lo, float hi) {
  f32x2_t v = {lo, hi};
  bf16x2_t r = __builtin_convertvector(v, bf16x2_t);
  return __builtin_bit_cast(unsigned, r);
}
__device__ __forceinline__ bf16_t f2bf(float x) { return (bf16_t)(pk_bf16(x, 0.f) & 0xffffu); }
__device__ __forceinline__ float bf2f(bf16_t v) { return __uint_as_float(((unsigned)v) << 16); }
__device__ __forceinline__ float bflo(unsigned v) { return __uint_as_float(v << 16); }
__device__ __forceinline__ float bfhi(unsigned v) { return __uint_as_float(v & 0xffff0000u); }
__device__ __forceinline__ float gelu_f(float x) {
  const float t = __builtin_fmaf(x * x, -0.10294324284f, -2.3022081985f);
  const float e = __builtin_amdgcn_exp2f(x * t);
  return x * __builtin_amdgcn_rcpf(1.0f + e);
}
__device__ __forceinline__ float row_ror1(float v) { return __builtin_bit_cast(float, __builtin_amdgcn_update_dpp(0, __builtin_bit_cast(int, v), 0x121, 0xf, 0xf, true)); }
__device__ __forceinline__ float row_ror15(float v) { return __builtin_bit_cast(float, __builtin_amdgcn_update_dpp(0, __builtin_bit_cast(int, v), 0x12f, 0xf, 0xf, true)); }
__device__ __forceinline__ int opaque_tid() { int t = threadIdx.x; asm volatile("" : "+v"(t)); return t; }
__device__ __forceinline__ int opaque_bid() { int b = blockIdx.x; asm volatile("" : "+s"(b)); return b; }
__device__ __forceinline__ int cond_of_row(int row) { return row < 8192 ? 0 : (row < 10240 ? 1 : 2); }
__device__ __forceinline__ int crow(int i, int hh) { return (i & 3) + 8 * (i >> 2) + 4 * hh; }

__device__ __forceinline__ int tile_off(int r, int c) { return r * 128 + ((c ^ ((r >> 1) & 7)) << 4); }

__device__ __forceinline__ uint4 gld16(const void* p) {
  uint4 r;
  asm volatile("global_load_dwordx4 %0, %1, off" : "=v"(r) : "v"(p) : "memory");
  return r;
}

template <bool PAIRED>
__device__ __forceinline__ void compute_ktile(const char* sA, const char* sB, f32x16 (&acc)[2][2], int wm, int wn, int lane) {
  const int l31 = lane & 31, hh = lane >> 5;
#pragma unroll
  for (int ks = 0; ks < 4; ++ks) {
    bf16x8 a[2], b[2];
#pragma unroll
    for (int mb = 0; mb < 2; ++mb) { const int r = wm * 64 + mb * 32 + l31; a[mb] = *(const bf16x8*)(sA + tile_off(r, ks * 2 + hh)); }
#pragma unroll
    for (int nb = 0; nb < 2; ++nb) { const int r = (PAIRED ? nb * 64 + wn * 32 : wn * 64 + nb * 32) + l31; b[nb] = *(const bf16x8*)(sB + tile_off(r, ks * 2 + hh)); }
#pragma unroll
    for (int mb = 0; mb < 2; ++mb)
#pragma unroll
      for (int nb = 0; nb < 2; ++nb) acc[mb][nb] = __builtin_amdgcn_mfma_f32_32x32x16_bf16(a[mb], b[nb], acc[mb][nb], 0, 0, 0);
  }
}


typedef float f32x4 __attribute__((ext_vector_type(4)));
__device__ __forceinline__ int g8_lds_byte(int r, int c) {
  const int st = (r >> 4) * 2 + (c >> 5), rr = r & 15, cc = c & 31, ob = rr * 64 + cc * 2;
  return st * 1024 + (ob ^ (((ob >> 9) & 1) << 5));
}
__device__ __forceinline__ void g8_stage_rc(int b, int& R, int& C) {
  const int st = b / 1024, sb = b % 1024, swz = sb ^ (((sb >> 9) & 1) << 5);
  R = (st >> 1) * 16 + swz / 64; C = (st & 1) * 32 + (swz % 64) / 2;
}
template <bool TRANS, bool R192>
__device__ __forceinline__ void gemm256(const bf16_t* __restrict__ A0, const bf16_t* __restrict__ A1, int lda, const bf16_t* __restrict__ B0, const bf16_t* __restrict__ B1, int ldb,
                                        int nt, char* shm, f32x4 (&acc)[2][2][4][2], int tid, bool pre, bool has_next,
                                        const bf16_t* __restrict__ nA0, const bf16_t* __restrict__ nA1, const bf16_t* __restrict__ nB0, const bf16_t* __restrict__ nB1) {
#define G8LAS __attribute__((address_space(3)))
  constexpr int HTB = 16384;
  G8LAS unsigned char* lds = (G8LAS unsigned char*)shm;
  const int wid = __builtin_amdgcn_readfirstlane(tid >> 6), lane = tid & 63, wr = wid >> 2, wc = wid & 3, fr = lane & 15, fq = lane >> 4;
  unsigned voffA[2], voffB[2];
#pragma unroll
  for (int i = 0; i < 2; ++i) {
    int R, C;
    g8_stage_rc(tid * 16 + i * 8192, R, C);
    voffA[i] = (unsigned)(R * lda + C) * 2u; voffB[i] = (unsigned)(R * ldb + C) * 2u;
  }
  const unsigned ldsw = (unsigned)wid * 1024u;
  const int aoff = g8_lds_byte(wr * 64 + fr, fq * 8), boff = g8_lds_byte(wc * 32 + fr, fq * 8);
  const char* cA0 = (const char*)A0; const char* cA1 = (const char*)A1; const char* cB0 = (const char*)B0; const char* cB1 = (const char*)B1;
  const char* dA0 = (const char*)nA0; const char* dA1 = (const char*)nA1; const char* dB0 = (const char*)nB0; const char* dB1 = (const char*)nB1;
#define SA(b, h) (((b) * 2 + (h)) * HTB)
#define SB(b, h) ((4 + (b) * 2 + (h)) * HTB)
#define STAGE(bufoff, gbase, voff, kt)                                                                                 \
  {                                                                                                                    \
    const unsigned long long _b = (unsigned long long)(gbase) + (unsigned long long)(kt) * 128ull;                     \
    const unsigned _blo = __builtin_amdgcn_readfirstlane((unsigned)_b), _bhi = __builtin_amdgcn_readfirstlane((unsigned)(_b >> 32)); \
    const char* _sb = (const char*)(((unsigned long long)_bhi << 32) | (unsigned long long)_blo);                      \
    _Pragma("unroll") for (int _i = 0; _i < 2; ++_i)                                                                   \
        __builtin_amdgcn_global_load_lds((const unsigned*)(_sb + (voff)[_i]), (G8LAS unsigned*)(lds + (bufoff) + ldsw + _i * 8192), 16, 0, 0); \
  }
#define LDA(dst, b, h)                                                                                                 \
  _Pragma("unroll") for (int m = 0; m < 4; ++m) _Pragma("unroll") for (int k = 0; k < 2; ++k)                          \
      dst[m][k] = *(const G8LAS bf16x8*)(lds + SA(b, h) + aoff + m * 2048 + k * 1024)
#define LDB(dst, b, h)                                                                                                 \
  _Pragma("unroll") for (int n = 0; n < 2; ++n) _Pragma("unroll") for (int k = 0; k < 2; ++k)                          \
      dst[n][k] = *(const G8LAS bf16x8*)(lds + SB(b, h) + boff + n * 2048 + k * 1024)
#define MMA(ai, bj, At_, Bt_)                                                                                          \
  if (!(R192 && (ai) == 1) || wr == 0) {     \
    __builtin_amdgcn_s_setprio(1);                                                                                     \
    _Pragma("unroll") for (int m = 0; m < 4; ++m) _Pragma("unroll") for (int n = 0; n < 2; ++n) _Pragma("unroll") for (int k = 0; k < 2; ++k) \
        acc[ai][bj][m][n] = TRANS ? __builtin_amdgcn_mfma_f32_16x16x32_bf16(Bt_[n][k], At_[m][k], acc[ai][bj][m][n], 0, 0, 0)  \
                                  : __builtin_amdgcn_mfma_f32_16x16x32_bf16(At_[m][k], Bt_[n][k], acc[ai][bj][m][n], 0, 0, 0); \
    __builtin_amdgcn_s_setprio(0);                                                                                     \
  }
#define WAIT_V(n) asm volatile("s_waitcnt vmcnt(" #n ")" ::: "memory")
#define WAIT_L(n) asm volatile("s_waitcnt lgkmcnt(" #n ")" ::: "memory")
#define BAR __builtin_amdgcn_s_barrier()
#define SCHED __builtin_amdgcn_sched_barrier(0)
#pragma unroll
  for (int ai = 0; ai < 2; ++ai)
#pragma unroll
    for (int bj = 0; bj < 2; ++bj)
#pragma unroll
      for (int m = 0; m < 4; ++m)
#pragma unroll
        for (int n = 0; n < 2; ++n) acc[ai][bj][m][n] = (f32x4){0.f, 0.f, 0.f, 0.f};
  bf16x8 At[4][2], Bx0[2][2], Bx1[2][2];
  if (!pre) {
    STAGE(SB(0, 0), cB0, voffB, 0); STAGE(SA(0, 0), cA0, voffA, 0);
    STAGE(SB(0, 1), cB1, voffB, 0); STAGE(SA(0, 1), cA1, voffA, 0);
    if (wr == 1) BAR;
    WAIT_V(4); BAR;
    STAGE(SB(1, 0), cB0, voffB, 1); STAGE(SA(1, 0), cA0, voffA, 1); STAGE(SB(1, 1), cB1, voffB, 1);
    WAIT_V(6); BAR;
  } else {
    if (wr == 1) BAR;
    STAGE(SB(1, 1), cB1, voffB, 1);
    WAIT_V(2); BAR;
  }
  for (int t = 0; t < nt - 2; t += 2) {
    LDB(Bx0, 0, 0); SCHED; LDA(At, 0, 0); STAGE(SA(1, 1), cA1, voffA, t + 1);
    WAIT_L(8); BAR; WAIT_L(0); MMA(0, 0, At, Bx0); BAR; SCHED;
    LDB(Bx1, 0, 1); STAGE(SB(0, 0), cB0, voffB, t + 2);
    BAR; WAIT_L(0); MMA(0, 1, At, Bx1); BAR;
    LDA(At, 0, 1); STAGE(SA(0, 0), cA0, voffA, t + 2);
    BAR; WAIT_L(0); MMA(1, 0, At, Bx0); BAR; SCHED;
    STAGE(SB(0, 1), cB1, voffB, t + 2);
    WAIT_V(6); BAR; MMA(1, 1, At, Bx1); BAR;
    LDB(Bx0, 1, 0); SCHED; LDA(At, 1, 0); STAGE(SA(0, 1), cA1, voffA, t + 2);
    WAIT_L(8); BAR; WAIT_L(0); MMA(0, 0, At, Bx0); BAR; SCHED;
    LDB(Bx1, 1, 1); STAGE(SB(1, 0), cB0, voffB, t + 3);
    BAR; WAIT_L(0); MMA(0, 1, At, Bx1); BAR;
    LDA(At, 1, 1); STAGE(SA(1, 0), cA0, voffA, t + 3);
    BAR; WAIT_L(0); MMA(1, 0, At, Bx0); BAR; SCHED;
    STAGE(SB(1, 1), cB1, voffB, t + 3);
    WAIT_V(6); BAR; MMA(1, 1, At, Bx1); BAR;
  }
  {
    LDB(Bx0, 0, 0); LDA(At, 0, 0); STAGE(SA(1, 1), cA1, voffA, nt - 1);
    BAR; WAIT_L(0); MMA(0, 0, At, Bx0); BAR;
    LDB(Bx1, 0, 1); BAR; WAIT_L(0); MMA(0, 1, At, Bx1); BAR;
    LDA(At, 0, 1);
    if (has_next) { STAGE(SB(0, 0), dB0, voffB, 0); STAGE(SA(0, 0), dA0, voffA, 0); WAIT_V(8); } else { WAIT_V(4); }
    BAR; WAIT_L(0); MMA(1, 0, At, Bx0); MMA(1, 1, At, Bx1); BAR;
  }
  {
    LDB(Bx0, 1, 0); LDA(At, 1, 0);
    if (has_next) { STAGE(SB(0, 1), dB1, voffB, 0); WAIT_V(8); } else { WAIT_V(2); }
    BAR; WAIT_L(0); MMA(0, 0, At, Bx0); BAR;
    LDB(Bx1, 1, 1);
    if (has_next) { STAGE(SA(0, 1), dA1, voffA, 0); WAIT_V(8); } else { WAIT_V(0); }
    BAR; WAIT_L(0); MMA(0, 1, At, Bx1); BAR;
    LDA(At, 1, 1);
    if (has_next) { STAGE(SB(1, 0), dB0, voffB, 1); STAGE(SA(1, 0), dA0, voffA, 1); }
    BAR; WAIT_L(0); MMA(1, 0, At, Bx0); MMA(1, 1, At, Bx1); BAR;
  }
  if (wr == 0) BAR;
#undef SA
#undef SB
#undef STAGE
#undef LDA
#undef LDB
#undef MMA
#undef WAIT_V
#undef WAIT_L
#undef BAR
#undef SCHED
#undef G8LAS
}

#define TR_LOAD(SRC, NN, V0, V1, V2, V3, V4, V5, V6, V7)                                                     \
  {                                                                                                            \
    const float* _s = (SRC) + (long)(tid >> 5) * (NN) + (tid & 31) * 4;                                        \
    V0 = *(const float4*)(_s); V1 = *(const float4*)(_s + (long)16 * (NN)); V2 = *(const float4*)(_s + (long)32 * (NN)); V3 = *(const float4*)(_s + (long)48 * (NN)); \
    V4 = *(const float4*)(_s + (long)64 * (NN)); V5 = *(const float4*)(_s + (long)80 * (NN)); V6 = *(const float4*)(_s + (long)96 * (NN)); V7 = *(const float4*)(_s + (long)112 * (NN)); \
  }
__device__ __forceinline__ void tr_store(bf16_t* __restrict__ dst, int K, float4 v0, float4 v1, float4 v2, float4 v3, float4 v4, float4 v5, float4 v6, float4 v7, float* tile, int tid) {
  const float4 v[8] = {v0, v1, v2, v3, v4, v5, v6, v7};
#pragma unroll
  for (int i = 0; i < 8; ++i) *(float4*)(tile + ((tid >> 5) + 16 * i) * 132 + (tid & 31) * 4) = v[i];
  __syncthreads();
  const int nn = tid & 127, kg = tid >> 7;
  const float* col = tile + (kg * 32) * 132 + nn;
#pragma unroll
  for (int c = 0; c < 4; ++c) {
    uint4 o;
    o.x = pk_bf16(col[(c * 8 + 0) * 132], col[(c * 8 + 1) * 132]);
    o.y = pk_bf16(col[(c * 8 + 2) * 132], col[(c * 8 + 3) * 132]);
    o.z = pk_bf16(col[(c * 8 + 4) * 132], col[(c * 8 + 5) * 132]);
    o.w = pk_bf16(col[(c * 8 + 6) * 132], col[(c * 8 + 7) * 132]);
    *(uint4*)(dst + (long)nn * K + kg * 32 + c * 8) = o;
  }
  __syncthreads();
}

__device__ void ada_item(const P& p, int item, float* sm, int tid) {
  const int l = item / 48, chunk = item % 48;
  float* sc = sm;
  float* red = sm + 3072;
  for (int i = tid; i < 3072; i += 512) {
    const int cb = i >> 10, k = i & 1023;
    const float v = cb == 0 ? p.c_ctx[k] : p.c[(cb - 1) * 1024 + k];
    sc[i] = v / (1.f + __expf(-v));
  }
  __syncthreads();
  const int ng = tid & 31, kg = tid >> 5;
  const float* wp = p.w_ada + ((long)l * 1024 + kg * 64) * 6144 + chunk * 128 + ng * 4;
  float a0[4] = {0.f, 0.f, 0.f, 0.f}, a1[4] = {0.f, 0.f, 0.f, 0.f}, a2[4] = {0.f, 0.f, 0.f, 0.f};
#pragma unroll 8
  for (int k = 0; k < 64; ++k) {
    const float4 wv = *(const float4*)(wp + (long)k * 6144);
    const float s0 = sc[kg * 64 + k], s1 = sc[1024 + kg * 64 + k], s2 = sc[2048 + kg * 64 + k];
    a0[0] += s0 * wv.x; a0[1] += s0 * wv.y; a0[2] += s0 * wv.z; a0[3] += s0 * wv.w;
    a1[0] += s1 * wv.x; a1[1] += s1 * wv.y; a1[2] += s1 * wv.z; a1[3] += s1 * wv.w;
    a2[0] += s2 * wv.x; a2[1] += s2 * wv.y; a2[2] += s2 * wv.z; a2[3] += s2 * wv.w;
  }
#pragma unroll
  for (int j = 0; j < 4; ++j) {
    red[(kg * 3 + 0) * 128 + ng * 4 + j] = a0[j];
    red[(kg * 3 + 1) * 128 + ng * 4 + j] = a1[j];
    red[(kg * 3 + 2) * 128 + ng * 4 + j] = a2[j];
  }
  __syncthreads();
  if (tid < 384) {
    const int cb = tid >> 7, n = tid & 127;
    float s = p.b_ada[l * 6144 + chunk * 128 + n];
#pragma unroll
    for (int g = 0; g < 16; ++g) s += red[(g * 3 + cb) * 128 + n];
    p.mod()[((long)l * 3 + cb) * 6144 + chunk * 128 + n] = s;
  }
  __syncthreads();
}

__device__ __forceinline__ void tr_decode(const P& p, int t, const float*& osrc, bf16_t*& odst, int& oK, int& oN) {
  constexpr int t_ffn_in = 4 * 8 * 44, t_ffn_out = 4 * 22 * 8, t_a_in = 2 * 8 * 32, t_a_out = 2 * 16 * 8, t_p = 4 * 2 * 2, t_qkv = 8 * 12, t_o = 8 * 8;
  const float* src; bf16_t* dst; int K, N;
#define TR_OPAQUE asm volatile("" : "+s"(src), "+s"(dst));
  if (t < t_ffn_in) { src = p.w_ffn_in; dst = p.wt_ffn_in(); K = 1024; N = 5632; TR_OPAQUE }
  else if ((t -= t_ffn_in) < t_ffn_out) { src = p.w_ffn_out; dst = p.wt_ffn_out(); K = 2816; N = 1024; TR_OPAQUE }
  else if ((t -= t_ffn_out) < t_a_in) { src = p.a_w_in; dst = p.wt_a_in(); K = 1024; N = 4096; TR_OPAQUE }
  else if ((t -= t_a_in) < t_a_out) { src = p.a_w_out; dst = p.wt_a_out(); K = 2048; N = 1024; TR_OPAQUE }
  else if ((t -= t_a_out) < t_p) { src = p.p_w; dst = p.wt_p(); K = 256; N = 256; TR_OPAQUE }
  else if ((t -= t_p) < t_qkv) { src = p.c_w_qkv; dst = p.wt_qkv(); K = 1024; N = 1536; TR_OPAQUE }
  else if ((t -= t_qkv) < t_o) { src = p.c_w_o; dst = p.wt_o(); K = 1024; N = 1024; TR_OPAQUE }
  else { t -= t_o; src = p.cache_v; dst = p.cvT(); K = 256; N = 256; TR_OPAQUE }
  const int nkt = K >> 7, nnt = N >> 7, per = nkt * nnt;
  const int mat = t / per, r = t % per;
  const int nt = r % nnt, kt = r / nnt;
  osrc = src + (long)mat * K * N + (long)(kt * 128) * N + nt * 128;
  odst = dst + (long)mat * K * N + (long)(nt * 128) * K + kt * 128;
  oK = K; oN = N;
#undef TR_OPAQUE
}

__device__ __forceinline__ int tr_group_size(int g) { return g == 0 ? 920 : (g == 1 ? 544 : (g == 2 ? 688 : 912)); }
__device__ __forceinline__ int tr_group_map(int g, int i) {
  if (i < 352) return 352 * g + i;
  i -= 352;
  if (i < 176) return 1408 + 176 * g + i;
  i -= 176;
  if (g == 0) return i < 256 ? 2112 + i : (i < 384 ? 2624 + (i - 256) : 3056 + (i - 384));
  if (g == 1) return 2880 + i;
  if (g == 2) return i < 96 ? 2896 + i : 2992 + (i - 96);
  return i < 256 ? 2112 + 256 + i : 2624 + 128 + (i - 256);
}
__device__ void run_transposes(const P& p, int g, int first, int stride, float* sm, int tid) {
  const int n = tr_group_size(g);
  int t = first;
  if (t < n) {
    const float* csrc; bf16_t* cdst; int cK, cN;
    tr_decode(p, tr_group_map(g, t), csrc, cdst, cK, cN);
    float4 a0, a1, a2, a3, a4, a5, a6, a7;
    TR_LOAD(csrc, cN, a0, a1, a2, a3, a4, a5, a6, a7)
    while (true) {
      const int tn = t + stride;
      const bool more = tn < n;
      const float* nsrc; bf16_t* ndst; int nK, nN;
      tr_decode(p, tr_group_map(g, more ? tn : t), nsrc, ndst, nK, nN);
      float4 b0 = a0, b1 = a1, b2 = a2, b3 = a3, b4 = a4, b5 = a5, b6 = a6, b7 = a7;
      if (more) TR_LOAD(nsrc, nN, b0, b1, b2, b3, b4, b5, b6, b7)
      tr_store(cdst, cK, a0, a1, a2, a3, a4, a5, a6, a7, sm, tid);
      if (!more) break;
      a0 = b0; a1 = b1; a2 = b2; a3 = b3; a4 = b4; a5 = b5; a6 = b6; a7 = b7;
      cdst = ndst; cK = nK; t = tn;
    }
  }
}

__device__ void phase_prep(const P& p, char* smem) {
  float* sm = (float*)smem;
  const int tid = opaque_tid();
  constexpr int N_ADA = 192, N_CK = 32, N_Z = 6 + 24;
  constexpr int TR0 = N_ADA + N_CK + N_Z;
  for (int item = opaque_bid(); item < TR0; item += gridDim.x) {
    if (item < N_ADA) { ada_item(p, item, sm, tid); continue; }
    if (item < N_ADA + N_CK) {
      const int i0 = (item - N_ADA) * 4096 + tid * 8;
      const float4 a = *(const float4*)(p.cache_k + i0), b = *(const float4*)(p.cache_k + i0 + 4);
      uint4 o; o.x = pk_bf16(a.x, a.y); o.y = pk_bf16(a.z, a.w); o.z = pk_bf16(b.x, b.y); o.w = pk_bf16(b.z, b.w);
      *(uint4*)(p.ck() + i0) = o;
      continue;
    }
    const int zi = item - N_ADA - N_CK;
    float* zp = zi < 6 ? p.vsq() + zi * 4096 + tid * 8 : p.rowsq() + (zi - 6) * 4096 + tid * 8;
    *(float4*)(zp) = make_float4(0.f, 0.f, 0.f, 0.f);
    *(float4*)(zp + 4) = make_float4(0.f, 0.f, 0.f, 0.f);
  }
  run_transposes(p, 0, (int)(gridDim.x - 1 - opaque_bid()), (int)gridDim.x, sm, tid);
}

__device__ void phase_filler(const P& p, int g, char* smem) {
  const int bid = opaque_bid();
  if (bid < 32) return;
  const int tid = opaque_tid();
  const int fb = bid - 32, nf = (int)gridDim.x - 32;
  __syncthreads();
  run_transposes(p, g, nf - 1 - fb, nf, (float*)smem, tid);
}

__device__ void phase_norm(const P& p, int layer, int which, bool first) {
  const int tid = opaque_tid(), lane = tid & 63, w = tid >> 6;
  const float* g = (which ? p.g_ffn : p.g_mix) + layer * 1024;
  for (int item = opaque_bid(); item < T / 16; item += gridDim.x) {
    const int row0 = item * 16 + w * 2;
    float4 v[2][4];
    float ss[2] = {0.f, 0.f};
#pragma unroll
    for (int r = 0; r < 2; ++r) {
      const int row = row0 + r;
      const float* xr = first ? (row < TCTX ? p.x_prompt + (long)row * 1024 : p.x_sample + (long)(row - TCTX) * 1024) : p.xo() + (long)row * 1024;
#pragma unroll
      for (int i = 0; i < 4; ++i) {
        v[r][i] = *(const float4*)(xr + (i * 64 + lane) * 4);
        ss[r] += v[r][i].x * v[r][i].x + v[r][i].y * v[r][i].y + v[r][i].z * v[r][i].z + v[r][i].w * v[r][i].w;
      }
    }
#pragma unroll
    for (int o = 32; o; o >>= 1) { ss[0] += __shfl_xor(ss[0], o); ss[1] += __shfl_xor(ss[1], o); }
    const float* md = p.mod() + ((long)layer * 3 + cond_of_row(row0)) * 6144 + which * 3072;
#pragma unroll
    for (int i = 0; i < 4; ++i) {
      const int col = (i * 64 + lane) * 4;
      const float4 gg = *(const float4*)(g + col), sh = *(const float4*)(md + col), sc = *(const float4*)(md + 1024 + col);
#pragma unroll
      for (int r = 0; r < 2; ++r) {
        const float rstd = rsqrtf(ss[r] * (1.f / 1024.f) + 1e-6f);
        const float y0 = v[r][i].x * rstd * gg.x * (1.f + sc.x) + sh.x;
        const float y1 = v[r][i].y * rstd * gg.y * (1.f + sc.y) + sh.y;
        const float y2 = v[r][i].z * rstd * gg.z * (1.f + sc.z) + sh.z;
        const float y3 = v[r][i].w * rstd * gg.w * (1.f + sc.w) + sh.w;
        uint2 o; o.x = pk_bf16(y0, y1); o.y = pk_bf16(y2, y3);
        *(uint2*)(p.h() + (long)(row0 + r) * 1024 + col) = o;
        if (first) *(float4*)(p.xo() + (long)(row0 + r) * 1024 + col) = v[r][i];
      }
    }
  }
}

__device__ void phase_shw(const P& p, int ra0, int ra1, int rb0, int rb1) {
  const int tid = opaque_tid(), lane = tid & 63, w = tid >> 6;
  const int na = (ra1 - ra0) >> 6, nb = (rb1 - rb0) >> 6;
  for (int item = opaque_bid(); item < na + nb; item += gridDim.x) {
    int r = (item < na ? ra0 + item * 64 : rb0 + (item - na) * 64) + w * 8;
    int idx, n0; const bf16_t* wrow;
    if (r < 4 * 5632) { const int l = r / 5632; n0 = r - l * 5632; idx = 2 * l + 1; wrow = p.wt_ffn_in() + ((long)l * 5632 + n0) * 1024; }
    else if ((r -= 4 * 5632) < 1536) { n0 = r; idx = 4; wrow = p.wt_qkv() + (long)n0 * 1024; }
    else { n0 = r - 1536; idx = 6; wrow = p.wt_a_in() + ((long)4096 + n0) * 1024; }
    uint4 wv[8][2];
#pragma unroll
    for (int q = 0; q < 8; ++q) { wv[q][0] = *(const uint4*)(wrow + (long)q * 1024 + lane * 16); wv[q][1] = *(const uint4*)(wrow + (long)q * 1024 + lane * 16 + 8); }
    const float* shb = p.mod() + (long)(idx >> 1) * 3 * 6144 + ((idx & 1) ? 3072 : 0) + lane * 16;
    float sacc[8][3];
#pragma unroll
    for (int q = 0; q < 8; ++q) { sacc[q][0] = 0.f; sacc[q][1] = 0.f; sacc[q][2] = 0.f; }
#pragma unroll
    for (int cnd = 0; cnd < 3; ++cnd) {
      const float* sh = shb + cnd * 6144;
      const float4 s0 = *(const float4*)(sh), s1 = *(const float4*)(sh + 4), s2 = *(const float4*)(sh + 8), s3 = *(const float4*)(sh + 12);
#pragma unroll
      for (int q = 0; q < 8; ++q) {
        const uint4 a = wv[q][0], b = wv[q][1];
        sacc[q][cnd] = s0.x * bflo(a.x) + s0.y * bfhi(a.x) + s0.z * bflo(a.y) + s0.w * bfhi(a.y) + s1.x * bflo(a.z) + s1.y * bfhi(a.z) + s1.z * bflo(a.w) + s1.w * bfhi(a.w)
                     + s2.x * bflo(b.x) + s2.y * bfhi(b.x) + s2.z * bflo(b.y) + s2.w * bfhi(b.y) + s3.x * bflo(b.z) + s3.y * bfhi(b.z) + s3.z * bflo(b.w) + s3.w * bfhi(b.w);
      }
    }
#pragma unroll
    for (int o = 32; o; o >>= 1)
#pragma unroll
      for (int q = 0; q < 8; ++q) { sacc[q][0] += __shfl_xor(sacc[q][0], o); sacc[q][1] += __shfl_xor(sacc[q][1], o); sacc[q][2] += __shfl_xor(sacc[q][2], o); }
    if (lane < 24) {
      const int q = lane / 3, cnd = lane - q * 3;
      float v = 0.f;
#pragma unroll
      for (int qq = 0; qq < 8; ++qq)
#pragma unroll
        for (int cc = 0; cc < 3; ++cc) if (qq == q && cc == cnd) v = sacc[qq][cc];
      p.shw()[((long)idx * 3 + cnd) * 5632 + n0 + q] = v;
    }
  }
}

__device__ __forceinline__ void ffn_fix_rows(const P& p, int layer, int lo, int hi, int tid) {
  bf16_t* gbuf = (bf16_t*)p.big2();
  const float* cw = p.ffn_conv_w + (long)layer * 3 * 2816;
  const float* cb = p.ffn_conv_b + (long)layer * 2816;
  bool any = false;
  for (int q = 0; q < 32; ++q) {
    const int lt = q >> 1, e = q & 1;
    const int row = TCTX + lt * 256 + (e == 0 ? 0 : 255);
    if (row < lo || row >= hi) continue;
    if (e == 0 ? (lt & 7) == 0 : (lt & 7) == 7) continue;
    any = true;
    const float* ap = e == 0 ? p.ha() + (long)((lt - 1) * 4 + 3) * 2816 : p.ha() + (long)(lt * 4 + 2) * 2816;
    const float* ac = e == 0 ? p.ha() + (long)(lt * 4 + 0) * 2816 : p.ha() + (long)(lt * 4 + 3) * 2816;
    const float* an = e == 0 ? p.ha() + (long)(lt * 4 + 1) * 2816 : p.ha() + (long)((lt + 1) * 4 + 0) * 2816;
    const float* uu = p.hu() + (long)(lt * 2 + e) * 2816;
    for (int c = tid; c < 2816; c += 512) {
      const float x = cw[c] * ap[c] + cw[2816 + c] * ac[c] + cw[5632 + c] * an[c] + cb[c];
      gbuf[(long)row * 2816 + c] = f2bf(gelu_f(x) * uu[c]);
    }
  }
  if (any) { asm volatile("s_waitcnt vmcnt(0)" ::: "memory"); __syncthreads(); }
}

__device__ __forceinline__ void pool_tile(const P& p, int mt, int g, char* smem, int tid) {
  const int half = 1 << g;
  bf16_t* d = (bf16_t*)p.big1();
  const bf16_t* h = p.h();
  const int r0 = mt * 192;
  int lo0 = r0 - 8; lo0 = lo0 < 0 ? 0 : lo0;
  int hi0 = r0 + 192 + 7; hi0 = hi0 > T ? T : hi0;
  const int nch = (hi0 - lo0) * 32;
  const float* rq = p.rowsq() + (long)2 * T;
  for (int ci = tid; ci < nch; ci += 512) {
    const int row = lo0 + (ci >> 5), c8 = g * 256 + (ci & 31) * 8;
    const uint4 xv = *(const uint4*)(h + (long)row * 1024 + c8);
    const float r = rsqrtf(rq[row] * (1.f / 1024.f) + 1e-6f);
    const float* shp = p.mod() + ((long)1 * 3 + cond_of_row(row)) * 6144 + c8;
    const float4 s0 = *(const float4*)(shp), s1 = *(const float4*)(shp + 4);
    uint4 o;
    o.x = pk_bf16(r * bflo(xv.x) + s0.x, r * bfhi(xv.x) + s0.y); o.y = pk_bf16(r * bflo(xv.y) + s0.z, r * bfhi(xv.y) + s0.w);
    o.z = pk_bf16(r * bflo(xv.z) + s1.x, r * bfhi(xv.z) + s1.y); o.w = pk_bf16(r * bflo(xv.w) + s1.z, r * bfhi(xv.w) + s1.w);
    *(uint4*)(smem + ci * 16) = o;
  }
  __syncthreads();
  const int c4 = (tid & 63) * 4;
  for (int rr = tid >> 6; rr < 192; rr += 8) {
    const int row = r0 + rr;
    int s, S;
    if (row < TCTX) { s = row & 255; S = 256; } else { s = (row - TCTX) & 2047; S = 2048; }
    const int base = row - s;
    int lo = s - half; lo = lo < 0 ? 0 : lo;
    int hi = s + half - 1; hi = hi > S - 1 ? S - 1 : hi;
    float a0 = 0.f, a1 = 0.f, a2 = 0.f, a3 = 0.f;
    for (int q = lo; q <= hi; ++q) {
      const uint2 v = *(const uint2*)(smem + (base + q - lo0) * 512 + c4 * 2);
      a0 += bflo(v.x); a1 += bfhi(v.x); a2 += bflo(v.y); a3 += bfhi(v.y);
    }
    const float inv = 1.f / (float)(hi - lo + 1);
    const uint2 v = *(const uint2*)(smem + (row - lo0) * 512 + c4 * 2);
    uint2 o;
    o.x = pk_bf16(a0 * inv - bflo(v.x), a1 * inv - bfhi(v.x));
    o.y = pk_bf16(a2 * inv - bflo(v.y), a3 * inv - bfhi(v.y));
    *(uint2*)(d + (long)row * 1024 + g * 256 + c4) = o;
  }
  asm volatile("s_waitcnt vmcnt(0)" ::: "memory");
  __syncthreads();
}

enum { G_GMLP_IN = 0, G_RESID = 1, G_POOL = 2, G_QKV = 3, G_FFN_IN = 4, G_GMLP_V = 5, G_QKV_V = 6 };

template <int KIND>
__device__ void phase_gemm(const P& p, const bf16_t* __restrict__ A, int lda, const bf16_t* __restrict__ Bt, int ldb, int K, int ntn, int layer, int aux, int fx, char* smem) {
  constexpr bool R192 = (KIND == G_RESID || KIND == G_POOL);
  constexpr int MT = R192 ? 64 : 48, MROWS = R192 ? 192 : 256;
  constexpr int CHAIN_V = KIND == G_GMLP_IN ? 48 * 8 : (KIND == G_QKV ? 48 * 1 : 0);
  constexpr int CHAIN_VOFF = KIND == G_GMLP_IN ? 8 : 5;
  constexpr int PREV_CNT = KIND == G_GMLP_V ? 48 * 8 : (KIND == G_QKV_V ? 48 * 5 : 0);
  bool pre = PREV_CNT > 0 && opaque_bid() < PREV_CNT;
  for (int item = ((KIND == G_GMLP_V || KIND == G_QKV_V) ? (int)(gridDim.x - 1 - opaque_bid()) : opaque_bid()); item < MT * ntn; item += gridDim.x) {
    const int tid = opaque_tid();
    const int mt = item % MT, nt = item / MT + (KIND == G_GMLP_V ? 8 : (KIND == G_QKV_V ? 5 : 0));
    const bf16_t* At = A + (long)mt * MROWS * lda + (KIND == G_POOL ? nt * 256 : 0);
    const bf16_t* B0 = Bt + (long)nt * (KIND == G_FFN_IN ? 128 : 256) * ldb;
    const bf16_t* B1 = KIND == G_FFN_IN ? Bt + (long)(2816 + nt * 128) * ldb : B0 + (long)128 * ldb;
    const bool own_next = item + (int)gridDim.x < MT * ntn;
    const int vitem0 = (int)gridDim.x - 1 - opaque_bid();
    const bool chain = CHAIN_V > 0 && !own_next && vitem0 < CHAIN_V;
    const bool has_next = own_next || chain;
    const int nitem = own_next ? item + (int)gridDim.x : (chain ? vitem0 : item);
    const int nmt = nitem % MT, nnt = nitem / MT + (chain ? CHAIN_VOFF : (KIND == G_GMLP_V ? 8 : (KIND == G_QKV_V ? 5 : 0)));
    const bf16_t* nAt = A + (long)nmt * MROWS * lda + (KIND == G_POOL ? nnt * 256 : 0);
    const bf16_t* nB0 = Bt + (long)nnt * (KIND == G_FFN_IN ? 128 : 256) * ldb;
    const bf16_t* nB1 = KIND == G_FFN_IN ? Bt + (long)(2816 + nnt * 128) * ldb : nB0 + (long)128 * ldb;
    const bool was_pre = pre;
    pre = has_next;
    if constexpr (KIND == G_RESID) { if (aux == 5120) ffn_fix_rows(p, layer, mt * MROWS, mt * MROWS + MROWS, tid); }
    if constexpr (KIND == G_POOL) pool_tile(p, mt, nt, smem, tid);
    f32x4 acc[2][2][4][2];
#define EPI_IDS()                                                                                                     \
    const int te = opaque_tid(), lane = te & 63, wid = __builtin_amdgcn_readfirstlane(te >> 6), wr = wid >> 2, wc = wid & 3, fr = lane & 15, fq = lane >> 4; \
    const int rb = mt * MROWS + wr * 64, cb = nt * 256 + wc * 32;
    if constexpr (KIND == G_GMLP_V || KIND == G_QKV_V) {
      gemm256<false, false>(At, At + (long)128 * lda, lda, B0, B1, ldb, K >> 6, smem, acc, tid, was_pre, has_next, nAt, nAt + (long)128 * lda, nB0, nB1);
      EPI_IDS()
      const unsigned lo = (unsigned)(fr * T + fq * 4);
      if (fx >= 0) {
        const float* rq = p.rowsq() + (long)fx * T + rb + fq * 4;
        const float* sw = p.shw() + ((long)fx * 3 + cond_of_row(mt * 256)) * 5632 + cb + fr;
#pragma unroll
        for (int ai = 0; ai < 2; ++ai)
#pragma unroll
          for (int m = 0; m < 4; ++m) {
            const float4 q = *(const float4*)(rq + ai * 128 + m * 16);
            const float r0 = rsqrtf(q.x * (1.f / 1024.f) + 1e-6f), r1 = rsqrtf(q.y * (1.f / 1024.f) + 1e-6f), r2 = rsqrtf(q.z * (1.f / 1024.f) + 1e-6f), r3 = rsqrtf(q.w * (1.f / 1024.f) + 1e-6f);
#pragma unroll
            for (int bj = 0; bj < 2; ++bj)
#pragma unroll
              for (int n = 0; n < 2; ++n) {
                const float sv = sw[bj * 128 + n * 16];
                f32x4 v = acc[ai][bj][m][n];
                v[0] = r0 * v[0] + sv; v[1] = r1 * v[1] + sv; v[2] = r2 * v[2] + sv; v[3] = r3 * v[3] + sv;
                acc[ai][bj][m][n] = v;
              }
          }
      }
      if constexpr (KIND == G_QKV_V) {
        bf16_t* vTa = (bf16_t*)p.big2() + (long)T * 1024 + (long)T * 256;
        float* outv = p.xo() + (long)T * 1024 + (long)TCTX * 256;
#pragma unroll
        for (int ai = 0; ai < 2; ++ai)
#pragma unroll
          for (int m = 0; m < 4; ++m)
#pragma unroll
            for (int bj = 0; bj < 2; ++bj)
#pragma unroll
              for (int n = 0; n < 2; ++n) {
                const int c0 = wc * 32 + bj * 128 + n * 16, r0 = rb + ai * 128 + m * 16;
                const f32x4 v = acc[ai][bj][m][n];
                uint2 o; o.x = pk_bf16(v[0], v[1]); o.y = pk_bf16(v[2], v[3]);
                *(uint2*)(vTa + (long)c0 * T + r0 + lo) = o;
                if (mt < 32) {
                  float* ov = outv + (long)(r0 + fq * 4) * 256 + c0 + fr;
                  ov[0] = v[0]; ov[256] = v[1]; ov[512] = v[2]; ov[768] = v[3];
                }
                if (bj == 1 && n == 1) asm volatile("" ::: "memory");
              }
      } else {
      bf16_t* vT = (bf16_t*)p.big1() + (long)T * 2048;
      float* vsq = p.vsq() + (long)aux * T;
#pragma unroll
      for (int ai = 0; ai < 2; ++ai)
#pragma unroll
        for (int m = 0; m < 4; ++m) {
          float sq[4] = {0.f, 0.f, 0.f, 0.f};
#pragma unroll
          for (int bj = 0; bj < 2; ++bj)
#pragma unroll
            for (int n = 0; n < 2; ++n) {
              float z0 = gelu_f(acc[ai][bj][m][n][0]), z1 = gelu_f(acc[ai][bj][m][n][1]), z2 = gelu_f(acc[ai][bj][m][n][2]), z3 = gelu_f(acc[ai][bj][m][n][3]);
              sq[0] += z0 * z0; sq[1] += z1 * z1; sq[2] += z2 * z2; sq[3] += z3 * z3;
              uint2 o; o.x = pk_bf16(z0, z1); o.y = pk_bf16(z2, z3);
              bf16_t* sb = vT + (long)(cb - 2048 + bj * 128 + n * 16) * T + rb + ai * 128 + m * 16;
              *(uint2*)(sb + lo) = o;
            }
#pragma unroll
          for (int j = 0; j < 4; ++j) {
            float s = sq[j];
            s += __shfl_xor(s, 1); s += __shfl_xor(s, 2); s += __shfl_xor(s, 4); s += __shfl_xor(s, 8);
            if (fr == 0) atomicAdd(vsq + rb + ai * 128 + m * 16 + fq * 4 + j, s);
          }
          asm volatile("" ::: "memory");
        }
      }
    } else {
    gemm256<true, R192>(At, At + (long)128 * lda, lda, B0, B1, ldb, K >> 6, smem, acc, tid, was_pre, has_next, nAt, nAt + (long)128 * lda, nB0, nB1);
    EPI_IDS()
    if constexpr (KIND == G_GMLP_IN || KIND == G_QKV || KIND == G_FFN_IN) {
      if (fx >= 0) {
        const float* rq = p.rowsq() + (long)fx * T + rb + fr;
        const float* sw = p.shw() + ((long)fx * 3 + cond_of_row(mt * 256)) * 5632 + (KIND == G_FFN_IN ? nt * 128 + wc * 32 : cb) + fq * 4;
        float rr[2][4];
#pragma unroll
        for (int ai = 0; ai < 2; ++ai)
#pragma unroll
          for (int m = 0; m < 4; ++m) rr[ai][m] = rsqrtf(rq[ai * 128 + m * 16] * (1.f / 1024.f) + 1e-6f);
#pragma unroll
        for (int bj = 0; bj < 2; ++bj)
#pragma unroll
          for (int n = 0; n < 2; ++n) {
            const float4 sv = *(const float4*)(sw + (KIND == G_FFN_IN ? bj * 2816 : bj * 128) + n * 16);
#pragma unroll
            for (int ai = 0; ai < 2; ++ai)
#pragma unroll
              for (int m = 0; m < 4; ++m) {
                f32x4 v = acc[ai][bj][m][n];
                const float r = rr[ai][m];
                v[0] = r * v[0] + sv.x; v[1] = r * v[1] + sv.y; v[2] = r * v[2] + sv.z; v[3] = r * v[3] + sv.w;
                acc[ai][bj][m][n] = v;
              }
          }
      }
    }
    if constexpr (KIND == G_RESID || KIND == G_POOL) {
      const unsigned lo = (unsigned)(fr * 1024 + fq * 4);
      const bool fz = fx >= 0;
      const float* gvec = ((fx & 1) ? p.g_ffn : p.g_mix) + (fx >> 1) * 1024;
      const int nai = wr == 0 ? 2 : 1;
      const unsigned voffx = lo * 4u;
#pragma unroll
      for (int ai = 0; ai < 2; ++ai) {
        if (ai < nai) {
          f32x4 xr[4][4];
#pragma unroll
          for (int m = 0; m < 4; ++m)
#pragma unroll
            for (int q = 0; q < 4; ++q) {
              const float* bp = p.xo() + (long)(rb + ai * 128 + m * 16) * 1024 + cb + (q >> 1) * 128 + (q & 1) * 16;
              asm volatile("global_load_dwordx4 %0, %1, %2" : "=v"(xr[m][q]) : "v"(voffx), "s"(bp) : "memory");
            }
          asm volatile("s_waitcnt vmcnt(0)" ::: "memory");
#pragma unroll
          for (int m = 0; m < 4; ++m) {
            const int row = rb + ai * 128 + m * 16 + fr;
            const int cnd = cond_of_row(row);
            const float* gate = p.mod() + ((long)layer * 3 + cnd) * 6144 + aux + cb + fq * 4;
            const float* scv = p.mod() + ((long)(fx >> 1) * 3 + cnd) * 6144 + ((fx & 1) ? 4096 : 1024) + cb + fq * 4;
            float rsum = 0.f;
#pragma unroll
            for (int bj = 0; bj < 2; ++bj)
#pragma unroll
              for (int n = 0; n < 2; ++n) {
                const int co = bj * 128 + n * 16;
                const float4 g = *(const float4*)(gate + co);
                float4 pb = make_float4(0.f, 0.f, 0.f, 0.f), ps = make_float4(1.f, 1.f, 1.f, 1.f);
                if constexpr (KIND == G_POOL) { pb = *(const float4*)(p.p_b + cb + fq * 4 + co); ps = *(const float4*)(p.p_scale + cb + fq * 4 + co); }
                const long eo = (long)(rb + ai * 128 + m * 16) * 1024 + cb + co;
                float4* xp = (float4*)(p.xo() + eo + lo);
                const f32x4 xl = xr[m][bj * 2 + n];
                float4 x = make_float4(xl[0], xl[1], xl[2], xl[3]);
                const f32x4 v = acc[ai][bj][m][n];
                x.x += g.x * ((v[0] + pb.x) * ps.x); x.y += g.y * ((v[1] + pb.y) * ps.y);
                x.z += g.z * ((v[2] + pb.z) * ps.z); x.w += g.w * ((v[3] + pb.w) * ps.w);
                *xp = x;
                if (fz) {
                  const float4 gv = *(const float4*)(gvec + cb + fq * 4 + co), sc = *(const float4*)(scv + co);
                  rsum += x.x * x.x + x.y * x.y + x.z * x.z + x.w * x.w;
                  uint2 o; o.x = pk_bf16(x.x * gv.x * (1.f + sc.x), x.y * gv.y * (1.f + sc.y)); o.y = pk_bf16(x.z * gv.z * (1.f + sc.z), x.w * gv.w * (1.f + sc.w));
                  *(uint2*)(p.h() + eo + lo) = o;
                }
              }
            if (fz) {
              rsum += __shfl_xor(rsum, 16); rsum += __shfl_xor(rsum, 32);
              if (fq == 0) atomicAdd(p.rowsq() + (long)fx * T + row, rsum);
            }
            asm volatile("" ::: "memory");
          }
        }
      }
    } else if constexpr (KIND == G_GMLP_IN) {
      bf16_t* u = (bf16_t*)p.big1();
      const unsigned lo = (unsigned)(fr * 2048 + fq * 4);
#pragma unroll
      for (int ai = 0; ai < 2; ++ai)
#pragma unroll
        for (int m = 0; m < 4; ++m)
#pragma unroll
          for (int bj = 0; bj < 2; ++bj)
#pragma unroll
            for (int n = 0; n < 2; ++n) {
              bf16_t* sb = u + (long)(rb + ai * 128 + m * 16) * 2048 + cb + bj * 128 + n * 16;
              const f32x4 v = acc[ai][bj][m][n];
              uint2 o; o.x = pk_bf16(gelu_f(v[0]), gelu_f(v[1])); o.y = pk_bf16(gelu_f(v[2]), gelu_f(v[3]));
              *(uint2*)(sb + lo) = o;
              if (bj == 1 && n == 1) asm volatile("" ::: "memory");
            }
    } else if constexpr (KIND == G_QKV) {
      float* part = (float*)(smem + 131072 + 16 + 4096);
      float rinv[2][2][4];
#pragma unroll
      for (int ai = 0; ai < 2; ++ai)
#pragma unroll
        for (int bj = 0; bj < 2; ++bj)
#pragma unroll
          for (int m = 0; m < 4; ++m) {
            const f32x4 a = acc[ai][bj][m][0], b = acc[ai][bj][m][1];
            float sq = a[0] * a[0] + a[1] * a[1] + a[2] * a[2] + a[3] * a[3] + b[0] * b[0] + b[1] * b[1] + b[2] * b[2] + b[3] * b[3];
            sq += __shfl_xor(sq, 16); sq += __shfl_xor(sq, 32);
            rinv[ai][bj][m] = sq;
            if (fq == 0) part[((wid * 2 + ai) * 2 + bj) * 64 + m * 16 + fr] = sq;
          }
      __syncthreads();
      {
        const int pw = wid ^ 1;
#pragma unroll
        for (int ai = 0; ai < 2; ++ai)
#pragma unroll
          for (int bj = 0; bj < 2; ++bj)
#pragma unroll
            for (int m = 0; m < 4; ++m)
              rinv[ai][bj][m] = rsqrtf((rinv[ai][bj][m] + part[((pw * 2 + ai) * 2 + bj) * 64 + m * 16 + fr]) * (1.f / 64.f) + 1e-6f);
      }
      const bool latt = mt >= 32;
      const float* gam = (nt < 4 ? p.c_g_q : p.c_g_k) + (wc & 1) * 32 + fq * 4;
      const float4 g0 = *(const float4*)(gam), g1 = *(const float4*)(gam + 16);
      float finv[4];
#pragma unroll
      for (int j = 0; j < 4; ++j) finv[j] = exp2f(-(float)(fq * 4 + j) * 0.8304820237218406f);
      bf16_t* qb = (bf16_t*)p.big2();
      bf16_t* kb = qb + (long)T * 1024;
      float* outk = p.xo() + (long)T * 1024;
      const float qs = nt < 4 ? 0.125f * LOG2E : 1.f;
#pragma unroll
      for (int ai = 0; ai < 2; ++ai)
#pragma unroll
        for (int m = 0; m < 4; ++m) {
          const int R = rb + ai * 128 + m * 16 + fr;
          float cs[4] = {1.f, 1.f, 1.f, 1.f}, sn[4] = {0.f, 0.f, 0.f, 0.f};
          if (latt) {
            const int sp = (R - TCTX) & 2047;
            const float pos = (float)((wc & 1) ? (sp & 63) : (sp >> 6));
#pragma unroll
            for (int j = 0; j < 4; ++j) { const float ang = pos * finv[j]; cs[j] = __cosf(ang); sn[j] = __sinf(ang); }
          }
#pragma unroll
          for (int bj = 0; bj < 2; ++bj) {
            const float r = rinv[ai][bj][m];
            const f32x4 av = acc[ai][bj][m][0], bv = acc[ai][bj][m][1];
            float a[4] = {av[0] * r * g0.x, av[1] * r * g0.y, av[2] * r * g0.z, av[3] * r * g0.w};
            float b[4] = {bv[0] * r * g1.x, bv[1] * r * g1.y, bv[2] * r * g1.z, bv[3] * r * g1.w};
#pragma unroll
            for (int j = 0; j < 4; ++j) { const float na = a[j] * cs[j] - b[j] * sn[j], nb = a[j] * sn[j] + b[j] * cs[j]; a[j] = na; b[j] = nb; }
            const int cl = bj * 128 + wc * 32 + fq * 4;
            uint2 oa, ob2;
            oa.x = pk_bf16(a[0] * qs, a[1] * qs); oa.y = pk_bf16(a[2] * qs, a[3] * qs);
            ob2.x = pk_bf16(b[0] * qs, b[1] * qs); ob2.y = pk_bf16(b[2] * qs, b[3] * qs);
            if (nt < 4) {
              bf16_t* dst = qb + (long)R * 1024 + nt * 256 + cl;
              *(uint2*)dst = oa; *(uint2*)(dst + 16) = ob2;
            } else {
              bf16_t* dst = kb + (long)R * 256 + cl;
              *(uint2*)dst = oa; *(uint2*)(dst + 16) = ob2;
              if (!latt) {
                float* od = outk + (long)R * 256 + cl;
                *(float4*)od = make_float4(a[0], a[1], a[2], a[3]); *(float4*)(od + 16) = make_float4(b[0], b[1], b[2], b[3]);
              }
            }
          }
          asm volatile("" ::: "memory");
        }
    } else {
      float* edge = (float*)(smem + 131072 + 16);
      const int ecol = wc * 32 + fq * 4;
      if (fr == 0 || fr == 15) {
#pragma unroll
        for (int ai = 0; ai < 2; ++ai)
#pragma unroll
          for (int n = 0; n < 2; ++n) {
            const f32x4 v = fr == 0 ? acc[ai][0][0][n] : acc[ai][0][3][n];
            *(float4*)(edge + ((ai * 2 + wr) * 2 + (fr == 0 ? 0 : 1)) * 128 + ecol + n * 16) = make_float4(v[0], v[1], v[2], v[3]);
          }
      }
      if (mt >= 32) {
        const int lt = mt - 32;
        if (wid < 4 && fr < 2) {
#pragma unroll
          for (int n = 0; n < 2; ++n) {
            const f32x4 v = acc[0][0][0][n];
            *(float4*)(p.ha() + ((long)(lt * 4 + fr)) * 2816 + nt * 128 + ecol + n * 16) = make_float4(v[0], v[1], v[2], v[3]);
            if (fr == 0) { const f32x4 uv = acc[0][1][0][n]; *(float4*)(p.hu() + ((long)(lt * 2 + 0)) * 2816 + nt * 128 + ecol + n * 16) = make_float4(uv[0], uv[1], uv[2], uv[3]); }
          }
        }
        if (wid >= 4 && fr >= 14) {
#pragma unroll
          for (int n = 0; n < 2; ++n) {
            const f32x4 v = acc[1][0][3][n];
            *(float4*)(p.ha() + ((long)(lt * 4 + 2 + (fr - 14))) * 2816 + nt * 128 + ecol + n * 16) = make_float4(v[0], v[1], v[2], v[3]);
            if (fr == 15) { const f32x4 uv = acc[1][1][3][n]; *(float4*)(p.hu() + ((long)(lt * 2 + 1)) * 2816 + nt * 128 + ecol + n * 16) = make_float4(uv[0], uv[1], uv[2], uv[3]); }
          }
        }
      }
      __syncthreads();
      bf16_t* gbuf = (bf16_t*)p.big2();
      const float* cwp = p.ffn_conv_w + (long)layer * 3 * 2816 + nt * 128 + ecol;
      const float* cbp = p.ffn_conv_b + (long)layer * 2816 + nt * 128 + ecol;
      const unsigned lo = (unsigned)(fr * 2816 + fq * 4);
#pragma unroll
      for (int n = 0; n < 2; ++n) {
        const float4 w0 = *(const float4*)(cwp + n * 16), w1 = *(const float4*)(cwp + 2816 + n * 16), w2 = *(const float4*)(cwp + 5632 + n * 16), bb = *(const float4*)(cbp + n * 16);
        const float w0a[4] = {w0.x, w0.y, w0.z, w0.w}, w1a[4] = {w1.x, w1.y, w1.z, w1.w}, w2a[4] = {w2.x, w2.y, w2.z, w2.w}, bba[4] = {bb.x, bb.y, bb.z, bb.w};
#pragma unroll
        for (int ai = 0; ai < 2; ++ai) {
          float4 ep = make_float4(0.f, 0.f, 0.f, 0.f), en = make_float4(0.f, 0.f, 0.f, 0.f);
          if (wr == 1) ep = *(const float4*)(edge + ((ai * 2 + 0) * 2 + 1) * 128 + ecol + n * 16);
          else if (ai == 1) ep = *(const float4*)(edge + ((0 * 2 + 1) * 2 + 1) * 128 + ecol + n * 16);
          if (wr == 0) en = *(const float4*)(edge + ((ai * 2 + 1) * 2 + 0) * 128 + ecol + n * 16);
          else if (ai == 0) en = *(const float4*)(edge + ((1 * 2 + 0) * 2 + 0) * 128 + ecol + n * 16);
          const float epa[4] = {ep.x, ep.y, ep.z, ep.w}, ena[4] = {en.x, en.y, en.z, en.w};
          float gq[4][4];
#pragma unroll
          for (int j = 0; j < 4; ++j) {
            float U[4], Dn[4];
#pragma unroll
            for (int m = 0; m < 4; ++m) { U[m] = row_ror1(acc[ai][0][m][n][j]); Dn[m] = row_ror15(acc[ai][0][m][n][j]); }
#pragma unroll
            for (int m = 0; m < 4; ++m) {
              const float prev = fr == 0 ? (m > 0 ? U[m > 0 ? m - 1 : 0] : epa[j]) : U[m];
              const float next = fr == 15 ? (m < 3 ? Dn[m < 3 ? m + 1 : 3] : ena[j]) : Dn[m];
              const float x = w0a[j] * prev + w1a[j] * acc[ai][0][m][n][j] + w2a[j] * next + bba[j];
              gq[m][j] = gelu_f(x) * acc[ai][1][m][n][j];
            }
          }
#pragma unroll
          for (int m = 0; m < 4; ++m) {
            bf16_t* sb = gbuf + (long)(rb + ai * 128 + m * 16) * 2816 + nt * 128 + wc * 32 + n * 16;
            uint2 o; o.x = pk_bf16(gq[m][0], gq[m][1]); o.y = pk_bf16(gq[m][2], gq[m][3]);
            *(uint2*)(sb + lo) = o;
          }
        }
      }
    }
    }
  }
}

__device__ void phase_spatial(const P& p, int j, char* smem) {
  const int tid = opaque_tid(), lane = tid & 63, w = __builtin_amdgcn_readfirstlane(tid >> 6), wm = w >> 1, wn = w & 1, l31 = lane & 31, hh = lane >> 5;
  const int c = tid & 7, r0 = tid >> 3;
  const bf16_t* u = (const bf16_t*)p.big1();
  const bf16_t* vT = u + (long)T * 2048;
  bf16_t* tt = (bf16_t*)p.big2();
  const float* vsq = p.vsq() + (long)j * T;
  for (int item = opaque_bid(); item < 96 * 8; item += gridDim.x) {
    const int g = item & 7, chunk = item >> 3;
    const float* ws = p.a_w_s + ((long)(j * 8 + g) * 128) * 128;
#pragma unroll 1
    for (int kt = 0; kt < 2; ++kt) {
      float rs[8];
      {
        const float4 q0 = *(const float4*)(vsq + chunk * 128 + kt * 64 + c * 8), q1 = *(const float4*)(vsq + chunk * 128 + kt * 64 + c * 8 + 4);
        rs[0] = rsqrtf(q0.x * (1.f / 2048.f) + 1e-6f); rs[1] = rsqrtf(q0.y * (1.f / 2048.f) + 1e-6f);
        rs[2] = rsqrtf(q0.z * (1.f / 2048.f) + 1e-6f); rs[3] = rsqrtf(q0.w * (1.f / 2048.f) + 1e-6f);
        rs[4] = rsqrtf(q1.x * (1.f / 2048.f) + 1e-6f); rs[5] = rsqrtf(q1.y * (1.f / 2048.f) + 1e-6f);
        rs[6] = rsqrtf(q1.z * (1.f / 2048.f) + 1e-6f); rs[7] = rsqrtf(q1.w * (1.f / 2048.f) + 1e-6f);
      }
#pragma unroll
      for (int i = 0; i < 2; ++i) {
        const int r = r0 + 64 * i;
        const float4 a = *(const float4*)(ws + r * 128 + kt * 64 + c * 8), b = *(const float4*)(ws + r * 128 + kt * 64 + c * 8 + 4);
        uint4 o;
        o.x = pk_bf16(a.x * rs[0], a.y * rs[1]); o.y = pk_bf16(a.z * rs[2], a.w * rs[3]);
        o.z = pk_bf16(b.x * rs[4], b.y * rs[5]); o.w = pk_bf16(b.z * rs[6], b.w * rs[7]);
        *(uint4*)(smem + kt * 16384 + tile_off(r, c)) = o;
      }
#pragma unroll
      for (int i = 0; i < 4; ++i) {
        const int r = r0 + 64 * i;
        const uint4 bv = *(const uint4*)(vT + (long)(g * 256 + r) * T + chunk * 128 + kt * 64 + c * 8);
        *(uint4*)(smem + 32768 + kt * 32768 + tile_off(r, c)) = bv;
      }
    }
    __syncthreads();
    f32x16 acc[2][2];
#pragma unroll
    for (int mb = 0; mb < 2; ++mb)
#pragma unroll
      for (int nb = 0; nb < 2; ++nb)
#pragma unroll
        for (int i = 0; i < 16; ++i) acc[mb][nb][i] = 0.f;
    compute_ktile<false>(smem + 32768, smem, acc, wm, wn, lane);
    compute_ktile<false>(smem + 65536, smem + 16384, acc, wm, wn, lane);
    __syncthreads();
    float* svt = (float*)smem;
#pragma unroll
    for (int nb = 0; nb < 2; ++nb) {
      const int tok = wn * 64 + nb * 32 + l31;
#pragma unroll
      for (int mb = 0; mb < 2; ++mb)
#pragma unroll
        for (int q = 0; q < 4; ++q)
          *(float4*)(svt + tok * 260 + wm * 64 + mb * 32 + 8 * q + 4 * hh) = make_float4(acc[mb][nb][4 * q], acc[mb][nb][4 * q + 1], acc[mb][nb][4 * q + 2], acc[mb][nb][4 * q + 3]);
    }
    __syncthreads();
    {
      const int ch8 = (tid & 31) * 8;
      const float4 gv0 = *(const float4*)(p.a_g_v + j * 2048 + g * 256 + ch8), gv1 = *(const float4*)(p.a_g_v + j * 2048 + g * 256 + ch8 + 4);
#pragma unroll
      for (int it = 0; it < 8; ++it) {
        const int tok = (tid >> 5) + 16 * it;
        const float bs = p.a_b_s[(j * 8 + g) * 128 + tok];
        const float4 s0 = *(const float4*)(svt + tok * 260 + ch8), s1 = *(const float4*)(svt + tok * 260 + ch8 + 4);
        const long ro = (long)(chunk * 128 + tok) * 2048 + g * 256 + ch8;
        const uint4 uu = *(const uint4*)(u + ro);
        uint4 o;
        o.x = pk_bf16(bflo(uu.x) * (gv0.x * s0.x + bs), bfhi(uu.x) * (gv0.y * s0.y + bs));
        o.y = pk_bf16(bflo(uu.y) * (gv0.z * s0.z + bs), bfhi(uu.y) * (gv0.w * s0.w + bs));
        o.z = pk_bf16(bflo(uu.z) * (gv1.x * s1.x + bs), bfhi(uu.z) * (gv1.y * s1.y + bs));
        o.w = pk_bf16(bflo(uu.w) * (gv1.z * s1.z + bs), bfhi(uu.w) * (gv1.w * s1.w + bs));
        *(uint4*)(tt + ro) = o;
      }
    }
    __syncthreads();
  }
}

__device__ __forceinline__ void attn_block_lds(const char* __restrict__ Ks, const char* __restrict__ Vs, bool masked, int kpos0, int qpos,
                                               const bf16x8 (&bq)[4], float& m, float& lsum, f32x16& o0, f32x16& o1, int l31, int hh) {
  f32x16 s[2];
#pragma unroll
  for (int sb = 0; sb < 2; ++sb) {
#pragma unroll
    for (int i = 0; i < 16; ++i) s[sb][i] = 0.f;
#pragma unroll
    for (int ks = 0; ks < 4; ++ks) {
      const bf16x8 a = *(const bf16x8*)(Ks + tile_off(sb * 32 + l31, ks * 2 + hh));
      s[sb] = __builtin_amdgcn_mfma_f32_32x32x16_bf16(a, bq[ks], s[sb], 0, 0, 0);
    }
  }
  if (masked) {
#pragma unroll
    for (int sb = 0; sb < 2; ++sb)
#pragma unroll
      for (int i = 0; i < 16; ++i) {
        int dlt = qpos - (kpos0 + sb * 32 + crow(i, hh));
        dlt = dlt < 0 ? -dlt : dlt;
        if (dlt > 128) s[sb][i] = -1e30f;
      }
  }
  float mx = s[0][0];
#pragma unroll
  for (int sb = 0; sb < 2; ++sb)
#pragma unroll
    for (int i = 0; i < 16; ++i) mx = fmaxf(mx, s[sb][i]);
  mx = fmaxf(mx, __shfl_xor(mx, 32));
  const float mnew = fmaxf(m, mx);
  const float alpha = __builtin_amdgcn_exp2f(m - mnew);
  m = mnew;
  float ps = 0.f;
#pragma unroll
  for (int sb = 0; sb < 2; ++sb)
#pragma unroll
    for (int i = 0; i < 16; ++i) { s[sb][i] = __builtin_amdgcn_exp2f(s[sb][i] - mnew); ps += s[sb][i]; }
  lsum = lsum * alpha + ps;
#pragma unroll
  for (int i = 0; i < 16; ++i) { o0[i] *= alpha; o1[i] *= alpha; }
  const int sw0 = (l31 >> 1) & 7;
#pragma unroll
  for (int sb = 0; sb < 2; ++sb)
#pragma unroll
    for (int st = 0; st < 2; ++st) {
      uint4 pw;
      pw.x = pk_bf16(s[sb][8 * st + 0], s[sb][8 * st + 1]); pw.y = pk_bf16(s[sb][8 * st + 2], s[sb][8 * st + 3]);
      pw.z = pk_bf16(s[sb][8 * st + 4], s[sb][8 * st + 5]); pw.w = pk_bf16(s[sb][8 * st + 6], s[sb][8 * st + 7]);
      const bf16x8 pb = __builtin_bit_cast(bf16x8, pw);
      const int c0 = 4 * sb + 2 * st;
      const char* v0 = Vs + l31 * 128 + 8 * hh;
      uint4 va;
      { const uint2 lo = *(const uint2*)(v0 + ((c0 ^ sw0) << 4)), hi = *(const uint2*)(v0 + (((c0 + 1) ^ sw0) << 4)); va.x = lo.x; va.y = lo.y; va.z = hi.x; va.w = hi.y; }
      o0 = __builtin_amdgcn_mfma_f32_32x32x16_bf16(__builtin_bit_cast(bf16x8, va), pb, o0, 0, 0, 0);
      { const uint2 lo = *(const uint2*)(v0 + 4096 + ((c0 ^ sw0) << 4)), hi = *(const uint2*)(v0 + 4096 + (((c0 + 1) ^ sw0) << 4)); va.x = lo.x; va.y = lo.y; va.z = hi.x; va.w = hi.y; }
      o1 = __builtin_amdgcn_mfma_f32_32x32x16_bf16(__builtin_bit_cast(bf16x8, va), pb, o1, 0, 0, 0);
    }
}

__device__ void phase_attn(const P& p, char* smem) {
  const int tid = opaque_tid(), lane = tid & 63, w = __builtin_amdgcn_readfirstlane(tid >> 6), l31 = lane & 31, hh = lane >> 5;
  const int kr = tid >> 3, kc = tid & 7;
  const bf16_t* qb = (const bf16_t*)p.big2();
  const bf16_t* kb = qb + (long)T * 1024;
  const bf16_t* vTa = kb + (long)T * 256;
  bf16_t* ob = (bf16_t*)(vTa + (long)256 * T);
  const int lo_off = tile_off(kr, kc);
  for (int item = opaque_bid(); item < 768; item += gridDim.x) {
    const bool lat = item >= 512;
    int tok0, head, qblk, b;
    if (!lat) { b = item >> 4; head = item & 15; qblk = 0; tok0 = b * 256; }
    else { const int it = item - 512; b = it >> 7; head = (it >> 3) & 15; qblk = it & 7; tok0 = TCTX + b * 2048; }
    const int kvh = head >> 2;
    const int qloc = qblk * 256 + w * 32;
    const long qrow = tok0 + qloc + l31;
    bf16x8 bq[4];
#pragma unroll
    for (int ks = 0; ks < 4; ++ks) bq[ks] = *(const bf16x8*)(qb + qrow * 1024 + head * 64 + ks * 16 + hh * 8);
    float m = p.c_sink[head] * LOG2E;
    float lsum = hh == 0 ? 1.f : 0.f;
    f32x16 o0, o1;
#pragma unroll
    for (int i = 0; i < 16; ++i) { o0[i] = 0.f; o1[i] = 0.f; }
    int wlo = 0, nwin = 4;
    if (lat) {
      wlo = qblk * 256 - 128; wlo = wlo < 0 ? 0 : wlo;
      int whi = qblk * 256 + 384; whi = whi > 2048 ? 2048 : whi;
      nwin = (whi - wlo) >> 6;
    }
    const int nblk = lat ? nwin + 4 : 4;
    const bf16_t* kwin = kb + (long)(tok0 + wlo + kr) * 256 + kvh * 64 + kc * 8;
    const bf16_t* vwin = vTa + (long)(kvh * 64 + kr) * T + tok0 + wlo + kc * 8;
    const bf16_t* kcach = p.ck() + (long)(b * 256 + kr) * 256 + kvh * 64 + kc * 8;
    const bf16_t* vcach = p.cvT() + (long)(b * 256 + kvh * 64 + kr) * 256 + kc * 8;
    uint4 rk, rv;
    rk = gld16(kwin); rv = gld16(vwin);
    asm volatile("s_waitcnt vmcnt(0)" ::: "memory");
    *(uint4*)(smem + lo_off) = rk; *(uint4*)(smem + 8192 + lo_off) = rv;
    __syncthreads();
    for (int bi = 0; bi < nblk; ++bi) {
      const bool more = bi + 1 < nblk;
      if (more) {
        const int nb = bi + 1;
        if (nb < nwin) { rk = gld16(kwin + (long)nb * 64 * 256); rv = gld16(vwin + nb * 64); }
        else { rk = gld16(kcach + (long)(nb - nwin) * 64 * 256); rv = gld16(vcach + (nb - nwin) * 64); }
      }
      const char* Ks = smem + (bi & 1) * 16384;
      if (bi < nwin) {
        const int k0 = wlo + 64 * bi;
        if (!lat) attn_block_lds(Ks, Ks + 8192, false, 0, 0, bq, m, lsum, o0, o1, l31, hh);
        else if (!(k0 + 63 < qloc - 128 || k0 > qloc + 31 + 128)) attn_block_lds(Ks, Ks + 8192, true, k0, qloc + l31, bq, m, lsum, o0, o1, l31, hh);
      } else {
        attn_block_lds(Ks, Ks + 8192, false, 0, 0, bq, m, lsum, o0, o1, l31, hh);
      }
      if (more) {
        asm volatile("s_waitcnt vmcnt(0)" ::: "memory");
        char* Kn = smem + ((bi + 1) & 1) * 16384;
        *(uint4*)(Kn + lo_off) = rk; *(uint4*)(Kn + 8192 + lo_off) = rv;
      }
      __syncthreads();
    }
    lsum += __shfl_xor(lsum, 32);
    const float inv = 1.f / lsum;
#pragma unroll
    for (int q = 0; q < 4; ++q) {
      uint2 v0, v1;
      v0.x = pk_bf16(o0[4 * q] * inv, o0[4 * q + 1] * inv); v0.y = pk_bf16(o0[4 * q + 2] * inv, o0[4 * q + 3] * inv);
      v1.x = pk_bf16(o1[4 * q] * inv, o1[4 * q + 1] * inv); v1.y = pk_bf16(o1[4 * q + 2] * inv, o1[4 * q + 3] * inv);
      *(uint2*)(ob + qrow * 1024 + head * 64 + 8 * q + 4 * hh) = v0;
      *(uint2*)(ob + qrow * 1024 + head * 64 + 32 + 8 * q + 4 * hh) = v1;
    }
  }
}

enum { OP_PREP, OP_FIRST, OP_NORM_MIX, OP_GMLP_IN, OP_SPATIAL, OP_GMLP_OUT, OP_FFN_IN, OP_FFN_FIX, OP_FFN_OUT, OP_POOL, OP_POOL_GEMM, OP_QKV, OP_QKPREP, OP_ATTN, OP_WO };
__constant__ unsigned char c_prog[NPH][2] = {
    {OP_PREP, 0}, {OP_FIRST, 0},
    {OP_GMLP_IN, 0}, {OP_SPATIAL, 0}, {OP_GMLP_OUT, 0}, {OP_FFN_IN, 0}, {OP_FFN_OUT, 0},
    {OP_POOL_GEMM, 1}, {OP_FFN_IN, 1}, {OP_FFN_OUT, 1},
    {OP_QKV, 2}, {OP_ATTN, 2}, {OP_WO, 2}, {OP_FFN_IN, 2}, {OP_FFN_OUT, 2},
    {OP_GMLP_IN, 3}, {OP_SPATIAL, 3}, {OP_GMLP_OUT, 3}, {OP_FFN_IN, 3}, {OP_FFN_OUT, 3}};

__device__ void run_phase(const P& p0, int ph, char* smem) {
  P p = p0;
  asm volatile("" : "+s"(p.ws), "+s"(p.out_g));
  const int op = c_prog[ph][0], layer = c_prog[ph][1];
  const int j = layer / 3;
  switch (op) {
    case OP_PREP: phase_prep(p, smem); break;
    case OP_FIRST: phase_norm(p, 0, 0, true); phase_shw(p, 0, 5632, 0, 0); break;
    case OP_NORM_MIX: phase_norm(p, layer, 0, false); break;
    case OP_GMLP_IN: {
      const int fx = layer == 0 ? -1 : 2 * layer;
      phase_gemm<G_GMLP_IN>(p, p.h(), 1024, p.wt_a_in() + (long)j * 4096 * 1024, 1024, 1024, 8, layer, j, fx, smem);
      phase_gemm<G_GMLP_V>(p, p.h(), 1024, p.wt_a_in() + (long)j * 4096 * 1024, 1024, 1024, 8, layer, j, fx, smem);
    } break;
    case OP_SPATIAL: phase_spatial(p, j, smem); break;
    case OP_GMLP_OUT: phase_gemm<G_RESID>(p, (const bf16_t*)p.big2(), 2048, p.wt_a_out() + (long)j * 1024 * 2048, 2048, 2048, 4, layer, 2048, 2 * layer + 1, smem); break;
    case OP_FFN_IN:
      phase_gemm<G_FFN_IN>(p, p.h(), 1024, p.wt_ffn_in() + (long)layer * 5632 * 1024, 1024, 1024, 22, layer, 0, 2 * layer + 1, smem);
      if (layer < 3) phase_filler(p, layer + 1, smem);
      break;
    case OP_FFN_OUT:
      phase_gemm<G_RESID>(p, (const bf16_t*)p.big2(), 2816, p.wt_ffn_out() + (long)layer * 1024 * 2816, 2816, 2816, 4, layer, 5120, layer <= 2 ? 2 * layer + 2 : -1, smem);
      if (layer == 0) phase_shw(p, 5632, 11264, 0, 0);
      else if (layer == 1) phase_shw(p, 11264, 16896, 22528, 24064);
      else if (layer == 2) phase_shw(p, 16896, 22528, 24064, 28160);
      break;
    case OP_POOL_GEMM: phase_gemm<G_POOL>(p, (const bf16_t*)p.big1(), 1024, p.wt_p(), 256, 256, 4, layer, 2048, 2 * layer + 1, smem); break;
    case OP_QKV:
      phase_gemm<G_QKV>(p, p.h(), 1024, p.wt_qkv(), 1024, 1024, 5, layer, 0, 2 * layer, smem);
      phase_gemm<G_QKV_V>(p, p.h(), 1024, p.wt_qkv(), 1024, 1024, 1, layer, 0, 2 * layer, smem);
      break;
    case OP_ATTN: phase_attn(p, smem); break;
    default: phase_gemm<G_RESID>(p, (const bf16_t*)p.big2() + (long)T * 1024 + (long)T * 256 + (long)256 * T, 1024, p.wt_o(), 1024, 1024, 4, layer, 2048, 2 * layer + 1, smem); break;
  }
}

#define XB_TMO      128
#define XB_XCNT(j)  (256  + 64 * (j))
#define XB_XSUB(j)  (1280 + 64 * (j))
#define XB_XGEN(j)  (2304 + 64 * (j))
#define XB_TOP      3328
#define XB_TOPGEN   3392
#define XCD_BAR_WORDS 3456
#define XB_SPIN_CAP (1u << 22)
#define LAS __attribute__((address_space(3)))
__device__ __forceinline__ unsigned xb_ld(unsigned* p) { return __hip_atomic_load(p, __ATOMIC_RELAXED, __HIP_MEMORY_SCOPE_AGENT); }
__device__ __forceinline__ unsigned xb_add(unsigned* p, unsigned v) { return __hip_atomic_fetch_add(p, v, __ATOMIC_RELAXED, __HIP_MEMORY_SCOPE_AGENT); }
__device__ __forceinline__ unsigned xb_xcc_id() { return (unsigned)__builtin_amdgcn_s_getreg((3 << 11) | 20) & 0xFu; }
#define XB_SPIN(cond, bar) do { unsigned _sp = 0; while (cond) { __builtin_amdgcn_s_sleep(1); \
    if ((++_sp & 255u) == 0u) { if (xb_ld(&(bar)[XB_TMO])) break; if (_sp > XB_SPIN_CAP) { atomicAdd(&(bar)[XB_TMO], 1u); break; } } } } while (0)
struct XcdBarrier { unsigned* bar; unsigned x; volatile LAS unsigned* st; };
__device__ __forceinline__ XcdBarrier xcd_barrier_post(unsigned* bar, volatile LAS unsigned* st) {
  XcdBarrier b; b.bar = bar; b.x = xb_xcc_id(); b.st = st;
  if (threadIdx.x == 0) (void)xb_add(&bar[XB_XCNT(b.x)], 1u);
  return b;
}
__device__ __forceinline__ void xcd_barrier_complete(unsigned* bar, unsigned x, unsigned& nloc, unsigned& nx) {
  const unsigned G = gridDim.x * gridDim.y * gridDim.z;
  unsigned sum, cnt, mine, sp = 0u;
  for (;;) {
    sum = 0u; cnt = 0u; mine = 0u;
#pragma unroll
    for (unsigned j = 0; j < 16; ++j) { const unsigned c = xb_ld(&bar[XB_XCNT(j)]); sum += c; cnt += (c > 0u) ? 1u : 0u; mine = (j == x) ? c : mine; }
    if (sum == G) break;
    __builtin_amdgcn_s_sleep(1);
    if ((++sp & 255u) == 0u) { if (xb_ld(&bar[XB_TMO])) break; if (sp > XB_SPIN_CAP) { atomicAdd(&bar[XB_TMO], 1u); break; } }
  }
  nloc = mine > 0u ? mine : 1u; nx = cnt > 0u ? cnt : 1u;
}
__device__ __forceinline__ void xcd_barrier(const XcdBarrier& b) {
  asm volatile("s_waitcnt vmcnt(0)" ::: "memory");
  __syncthreads();
  if (threadIdx.x == 0) {
    unsigned* bar = b.bar;
    __builtin_amdgcn_s_waitcnt(0);
    unsigned nloc = b.st[0], nx = b.st[1];
    if (nloc == 0u) { xcd_barrier_complete(bar, b.x, nloc, nx); b.st[0] = nloc; b.st[1] = nx; }
    const unsigned old = xb_add(&bar[XB_XSUB(b.x)], 1u);
    const unsigned gen = old / nloc;
    if (old + 1u == (gen + 1u) * nloc) {
      __builtin_amdgcn_fence(__ATOMIC_RELEASE, "agent");
      asm volatile("s_waitcnt vmcnt(0)" ::: "memory");
      const unsigned og = xb_add(&bar[XB_TOP], 1u);
      const unsigned tg = og / nx;
      if (og + 1u == (tg + 1u) * nx) xb_add(&bar[XB_TOPGEN], 1u);
      else XB_SPIN(xb_ld(&bar[XB_TOPGEN]) == tg, bar);
      __builtin_amdgcn_fence(__ATOMIC_ACQUIRE, "agent");
      xb_add(&bar[XB_XGEN(b.x)], 1u);
      asm volatile("s_waitcnt vmcnt(0)" ::: "memory");
    } else {
      XB_SPIN(xb_ld(&bar[XB_XGEN(b.x)]) == gen, bar);
      __builtin_amdgcn_fence(__ATOMIC_ACQUIRE, "agent");
      asm volatile("s_waitcnt vmcnt(0)" ::: "memory");
    }
  }
  __syncthreads();
}

__global__ void __launch_bounds__(512, 2) mega(P p, unsigned* bar, int lo, int hi) {
  __shared__ __attribute__((aligned(16))) char smem[131072 + 16 + 4096 + 8192 + 16];
  if (hi < 0) cg::this_grid().sync();
  volatile LAS unsigned* st = (volatile LAS unsigned*)(smem + 131072 + 16 + 4096 + 8192);
  if (threadIdx.x == 0) { st[0] = 0u; st[1] = 0u; }
  __syncthreads();
  XcdBarrier xb = xcd_barrier_post(bar, st);
  for (int ph = lo; ph < hi; ++ph) {
    if (ph > lo) xcd_barrier(xb);
    run_phase(p, ph, smem);
  }
}

extern "C" void kernel_launch(void* const* d_in, const int* in_sizes, int n_in, void* d_out, int out_size, void* d_ws, size_t ws_size, hipStream_t stream) {
  static int grid_blocks = 0;
  if (!grid_blocks) {
    int dev = 0, cus = 0, per_cu = 0;
    (void)hipGetDevice(&dev);
    (void)hipDeviceGetAttribute(&cus, hipDeviceAttributeMultiprocessorCount, dev);
    (void)hipOccupancyMaxActiveBlocksPerMultiprocessor(&per_cu, mega, 512, 0);
    if (per_cu > 1) per_cu = 1;
    if (per_cu < 1) per_cu = 1;
    grid_blocks = cus * per_cu;
  }
  P p{};
  const float* const* in = (const float* const*)d_in;
  p.x_prompt = in[0]; p.x_sample = in[1]; p.cache_k = in[2]; p.cache_v = in[3]; p.c = in[4]; p.c_ctx = in[5];
  p.w_ada = in[6]; p.b_ada = in[7]; p.g_mix = in[8]; p.g_ffn = in[9]; p.w_ffn_in = in[10]; p.ffn_conv_w = in[11]; p.ffn_conv_b = in[12]; p.w_ffn_out = in[13];
  p.a_w_in = in[14]; p.a_g_v = in[15]; p.a_w_s = in[16]; p.a_b_s = in[17]; p.a_w_out = in[18];
  p.p_w = in[19]; p.p_b = in[20]; p.p_scale = in[21];
  p.c_w_qkv = in[22]; p.c_g_q = in[23]; p.c_g_k = in[24]; p.c_sink = in[25]; p.c_w_o = in[26];
  p.out_g = (__attribute__((address_space(1))) float*)d_out;
  char* ws = (char*)d_ws;
  unsigned* bar = (unsigned*)ws;
  p.ws = (__attribute__((address_space(1))) char*)ws;
  if ((size_t)335869440ull > ws_size) { fprintf(stderr, "workspace too small: need %zu have %zu\n", (size_t)335869440ull, ws_size); return; }
#if ONE_LAUNCH
  int lo = 0, hi = NPH;
  (void)hipMemsetAsync(bar, 0, (size_t)XCD_BAR_WORDS * 4, stream);
  void* args[] = {&p, &bar, &lo, &hi};
  hipError_t e = hipLaunchCooperativeKernel((void*)mega, dim3(grid_blocks), dim3(512), args, 0, stream);
  if (e != hipSuccess) {
    fprintf(stderr, "cooperative launch failed: %s (grid %d); falling back to one launch per phase\n", hipGetErrorString(e), grid_blocks);
    (void)hipGetLastError();
    for (int ph = 0; ph < NPH; ++ph) mega<<<grid_blocks, 512, 0, stream>>>(p, bar, ph, ph + 1);
  }
#else
  for (int ph = 0; ph < NPH; ++ph) mega<<<grid_blocks, 512, 0, stream>>>(p, bar, ph, ph + 1);
#endif
}
```

```cpp
#include <hip/hip_runtime.h>
#include <hip/hip_cooperative_groups.h>
#include <cstdio>
#include <cstdint>
namespace cg = cooperative_groups;

#ifndef ONE_LAUNCH
#define ONE_LAUNCH 1
#endif

typedef unsigned short bf16_t;
typedef short bf16x8 __attribute__((ext_vector_type(8)));
typedef float f32x16 __attribute__((ext_vector_type(16)));
typedef __bf16 bf16x2_t __attribute__((ext_vector_type(2)));
typedef float f32x2_t __attribute__((ext_vector_type(2)));

constexpr int T = 12288;
constexpr int TCTX = 8192;
constexpr int NPH = 20;
constexpr float LOG2E = 1.4426950408889634f;

struct P {
  const float *x_prompt, *x_sample, *cache_k, *cache_v, *c, *c_ctx;
  const float *w_ada, *b_ada, *g_mix, *g_ffn, *w_ffn_in, *ffn_conv_w, *ffn_conv_b, *w_ffn_out;
  const float *a_w_in, *a_g_v, *a_w_s, *a_b_s, *a_w_out;
  const float *p_w, *p_b, *p_scale;
  const float *c_w_qkv, *c_g_q, *c_g_k, *c_sink, *c_w_o;
  __attribute__((address_space(1))) float* out_g;
  __device__ __forceinline__ float* xo() const { return (float*)out_g; }
  __attribute__((address_space(1))) char* ws;
  __device__ __forceinline__ float* mod() const { return (float*)(ws + 13824ull); }
  __device__ __forceinline__ float* vsq() const { return (float*)(ws + 308736ull); }
  __device__ __forceinline__ bf16_t* wt_ffn_in() const { return (bf16_t*)(ws + 407040ull); }
  __device__ __forceinline__ bf16_t* wt_ffn_out() const { return (bf16_t*)(ws + 46544384ull); }
  __device__ __forceinline__ bf16_t* wt_a_in() const { return (bf16_t*)(ws + 69613056ull); }
  __device__ __forceinline__ bf16_t* wt_a_out() const { return (bf16_t*)(ws + 86390272ull); }
  __device__ __forceinline__ bf16_t* wt_p() const { return (bf16_t*)(ws + 94778880ull); }
  __device__ __forceinline__ bf16_t* wt_qkv() const { return (bf16_t*)(ws + 95303168ull); }
  __device__ __forceinline__ bf16_t* wt_o() const { return (bf16_t*)(ws + 98448896ull); }
  __device__ __forceinline__ bf16_t* ck() const { return (bf16_t*)(ws + 100546048ull); }
  __device__ __forceinline__ bf16_t* cvT() const { return (bf16_t*)(ws + 100808192ull); }
  __device__ __forceinline__ bf16_t* h() const { return (bf16_t*)(ws + 101070336ull); }
  __device__ __forceinline__ char* big1() const { return (char*)(ws + 126236160ull); }
  __device__ __forceinline__ char* big2() const { return (char*)(ws + 264648192ull); }
  __device__ __forceinline__ float* ha() const { return (float*)(ws + 333854208ull); }
  __device__ __forceinline__ float* hu() const { return (float*)(ws + 334575104ull); }
  __device__ __forceinline__ float* rowsq() const { return (float*)(ws + 334935552ull); }
  __device__ __forceinline__ float* shw() const { return (float*)(ws + 335328768ull); }
};

__device__ __forceinline__ unsigned pk_bf16(float lo, float hi) {
  f32x2_t v = {lo, hi};
  bf16x2_t r = __builtin_convertvector(v, bf16x2_t);
  return __builtin_bit_cast(unsigned, r);
}
__device__ __forceinline__ bf16_t f2bf(float x) { return (bf16_t)(pk_bf16(x, 0.f) & 0xffffu); }
__device__ __forceinline__ float bf2f(bf16_t v) { return __uint_as_float(((unsigned)v) << 16); }
__device__ __forceinline__ float bflo(unsigned v) { return __uint_as_float(v << 16); }
__device__ __forceinline__ float bfhi(unsigned v) { return __uint_as_float(v & 0xffff0000u); }
__device__ __forceinline__ float gelu_f(float x) {
  const float t = __builtin_fmaf(x * x, -0.10294324284f, -2.3022081985f);
  const float e = __builtin_amdgcn_exp2f(x * t);
  return x * __builtin_amdgcn_rcpf(1.0f + e);
}
__device__ __forceinline__ float row_ror1(float v) { return __builtin_bit_cast(float, __builtin_amdgcn_update_dpp(0, __builtin_bit_cast(int, v), 0x121, 0xf, 0xf, true)); }
__device__ __forceinline__ float row_ror15(float v) { return __builtin_bit_cast(float, __builtin_amdgcn_update_dpp(0, __builtin_bit_cast(int, v), 0x12f, 0xf, 0xf, true)); }
__device__ __forceinline__ int opaque_tid() { int t = threadIdx.x; asm volatile("" : "+v"(t)); return t; }
__device__ __forceinline__ int opaque_bid() { int b = blockIdx.x; asm volatile("" : "+s"(b)); return b; }
__device__ __forceinline__ int cond_of_row(int row) { return row < 8192 ? 0 : (row < 10240 ? 1 : 2); }
__device__ __forceinline__ int crow(int i, int hh) { return (i & 3) + 8 * (i >> 2) + 4 * hh; }

__device__ __forceinline__ int tile_off(int r, int c) { return r * 128 + ((c ^ ((r >> 1) & 7)) << 4); }

__device__ __forceinline__ uint4 gld16(const void* p) {
  uint4 r;
  asm volatile("global_load_dwordx4 %0, %1, off" : "=v"(r) : "v"(p) : "memory");
  return r;
}

template <bool PAIRED>
__device__ __forceinline__ void compute_ktile(const char* sA, const char* sB, f32x16 (&acc)[2][2], int wm, int wn, int lane) {
  const int l31 = lane & 31, hh = lane >> 5;
#pragma unroll
  for (int ks = 0; ks < 4; ++ks) {
    bf16x8 a[2], b[2];
#pragma unroll
    for (int mb = 0; mb < 2; ++mb) { const int r = wm * 64 + mb * 32 + l31; a[mb] = *(const bf16x8*)(sA + tile_off(r, ks * 2 + hh)); }
#pragma unroll
    for (int nb = 0; nb < 2; ++nb) { const int r = (PAIRED ? nb * 64 + wn * 32 : wn * 64 + nb * 32) + l31; b[nb] = *(const bf16x8*)(sB + tile_off(r, ks * 2 + hh)); }
#pragma unroll
    for (int mb = 0; mb < 2; ++mb)
#pragma unroll
      for (int nb = 0; nb < 2; ++nb) acc[mb][nb] = __builtin_amdgcn_mfma_f32_32x32x16_bf16(a[mb], b[nb], acc[mb][nb], 0, 0, 0);
  }
}


typedef float f32x4 __attribute__((ext_vector_type(4)));
__device__ __forceinline__ int g8_lds_byte(int r, int c) {
  const int st = (r >> 4) * 2 + (c >> 5), rr = r & 15, cc = c & 31, ob = rr * 64 + cc * 2;
  return st * 1024 + (ob ^ (((ob >> 9) & 1) << 5));
}
__device__ __forceinline__ void g8_stage_rc(int b, int& R, int& C) {
  const int st = b / 1024, sb = b % 1024, swz = sb ^ (((sb >> 9) & 1) << 5);
  R = (st >> 1) * 16 + swz / 64; C = (st & 1) * 32 + (swz % 64) / 2;
}
template <bool TRANS, bool R192>
__device__ __forceinline__ void gemm256(const bf16_t* __restrict__ A0, const bf16_t* __restrict__ A1, int lda, const bf16_t* __restrict__ B0, const bf16_t* __restrict__ B1, int ldb,
                                        int nt, char* shm, f32x4 (&acc)[2][2][4][2], int tid, bool pre, bool has_next,
                                        const bf16_t* __restrict__ nA0, const bf16_t* __restrict__ nA1, const bf16_t* __restrict__ nB0, const bf16_t* __restrict__ nB1) {
#define G8LAS __attribute__((address_space(3)))
  constexpr int HTB = 16384;
  G8LAS unsigned char* lds = (G8LAS unsigned char*)shm;
  const int wid = __builtin_amdgcn_readfirstlane(tid >> 6), lane = tid & 63, wr = wid >> 2, wc = wid & 3, fr = lane & 15, fq = lane >> 4;
  unsigned voffA[2], voffB[2];
#pragma unroll
  for (int i = 0; i < 2; ++i) {
    int R, C;
    g8_stage_rc(tid * 16 + i * 8192, R, C);
    voffA[i] = (unsigned)(R * lda + C) * 2u; voffB[i] = (unsigned)(R * ldb + C) * 2u;
  }
  const unsigned ldsw = (unsigned)wid * 1024u;
  const int aoff = g8_lds_byte(wr * 64 + fr, fq * 8), boff = g8_lds_byte(wc * 32 + fr, fq * 8);
  const char* cA0 = (const char*)A0; const char* cA1 = (const char*)A1; const char* cB0 = (const char*)B0; const char* cB1 = (const char*)B1;
  const char* dA0 = (const char*)nA0; const char* dA1 = (const char*)nA1; const char* dB0 = (const char*)nB0; const char* dB1 = (const char*)nB1;
#define SA(b, h) (((b) * 2 + (h)) * HTB)
#define SB(b, h) ((4 + (b) * 2 + (h)) * HTB)
#define STAGE(bufoff, gbase, voff, kt)                                                                                 \
  {                                                                                                                    \
    const unsigned long long _b = (unsigned long long)(gbase) + (unsigned long long)(kt) * 128ull;                     \
    const unsigned _blo = __builtin_amdgcn_readfirstlane((unsigned)_b), _bhi = __builtin_amdgcn_readfirstlane((unsigned)(_b >> 32)); \
    const char* _sb = (const char*)(((unsigned long long)_bhi << 32) | (unsigned long long)_blo);                      \
    _Pragma("unroll") for (int _i = 0; _i < 2; ++_i)                                                                   \
        __builtin_amdgcn_global_load_lds((const unsigned*)(_sb + (voff)[_i]), (G8LAS unsigned*)(lds + (bufoff) + ldsw + _i * 8192), 16, 0, 0); \
  }
#define LDA(dst, b, h)                                                                                                 \
  _Pragma("unroll") for (int m = 0; m < 4; ++m) _Pragma("unroll") for (int k = 0; k < 2; ++k)                          \
      dst[m][k] = *(const G8LAS bf16x8*)(lds + SA(b, h) + aoff + m * 2048 + k * 1024)
#define LDB(dst, b, h)                                                                                                 \
  _Pragma("unroll") for (int n = 0; n < 2; ++n) _Pragma("unroll") for (int k = 0; k < 2; ++k)                          \
      dst[n][k] = *(const G8LAS bf16x8*)(lds + SB(b, h) + boff + n * 2048 + k * 1024)
#define MMA(ai, bj, At_, Bt_)                                                                                          \
  if (!(R192 && (ai) == 1) || wr == 0) {     \
    __builtin_amdgcn_s_setprio(1);                                                                                     \
    _Pragma("unroll") for (int m = 0; m < 4; ++m) _Pragma("unroll") for (int n = 0; n < 2; ++n) _Pragma("unroll") for (int k = 0; k < 2; ++k) \
        acc[ai][bj][m][n] = TRANS ? __builtin_amdgcn_mfma_f32_16x16x32_bf16(Bt_[n][k], At_[m][k], acc[ai][bj][m][n], 0, 0, 0)  \
                                  : __builtin_amdgcn_mfma_f32_16x16x32_bf16(At_[m][k], Bt_[n][k], acc[ai][bj][m][n], 0, 0, 0); \
    __builtin_amdgcn_s_setprio(0);                                                                                     \
  }
#define WAIT_V(n) asm volatile("s_waitcnt vmcnt(" #n ")" ::: "memory")
#define WAIT_L(n) asm volatile("s_waitcnt lgkmcnt(" #n ")" ::: "memory")
#define BAR __builtin_amdgcn_s_barrier()
#define SCHED __builtin_amdgcn_sched_barrier(0)
#pragma unroll
  for (int ai = 0; ai < 2; ++ai)
#pragma unroll
    for (int bj = 0; bj < 2; ++bj)
#pragma unroll
      for (int m = 0; m < 4; ++m)
#pragma unroll
        for (int n = 0; n < 2; ++n) acc[ai][bj][m][n] = (f32x4){0.f, 0.f, 0.f, 0.f};
  bf16x8 At[4][2], Bx0[2][2], Bx1[2][2];
  if (!pre) {
    STAGE(SB(0, 0), cB0, voffB, 0); STAGE(SA(0, 0), cA0, voffA, 0);
    STAGE(SB(0, 1), cB1, voffB, 0); STAGE(SA(0, 1), cA1, voffA, 0);
    if (wr == 1) BAR;
    WAIT_V(4); BAR;
    STAGE(SB(1, 0), cB0, voffB, 1); STAGE(SA(1, 0), cA0, voffA, 1); STAGE(SB(1, 1), cB1, voffB, 1);
    WAIT_V(6); BAR;
  } else {
    if (wr == 1) BAR;
    STAGE(SB(1, 1), cB1, voffB, 1);
    WAIT_V(2); BAR;
  }
  for (int t = 0; t < nt - 2; t += 2) {
    LDB(Bx0, 0, 0); SCHED; LDA(At, 0, 0); STAGE(SA(1, 1), cA1, voffA, t + 1);
    WAIT_L(8); BAR; WAIT_L(0); MMA(0, 0, At, Bx0); BAR; SCHED;
    LDB(Bx1, 0, 1); STAGE(SB(0, 0), cB0, voffB, t + 2);
    BAR; WAIT_L(0); MMA(0, 1, At, Bx1); BAR;
    LDA(At, 0, 1); STAGE(SA(0, 0), cA0, voffA, t + 2);
    BAR; WAIT_L(0); MMA(1, 0, At, Bx0); BAR; SCHED;
    STAGE(SB(0, 1), cB1, voffB, t + 2);
    WAIT_V(6); BAR; MMA(1, 1, At, Bx1); BAR;
    LDB(Bx0, 1, 0); SCHED; LDA(At, 1, 0); STAGE(SA(0, 1), cA1, voffA, t + 2);
    WAIT_L(8); BAR; WAIT_L(0); MMA(0, 0, At, Bx0); BAR; SCHED;
    LDB(Bx1, 1, 1); STAGE(SB(1, 0), cB0, voffB, t + 3);
    BAR; WAIT_L(0); MMA(0, 1, At, Bx1); BAR;
    LDA(At, 1, 1); STAGE(SA(1, 0), cA0, voffA, t + 3);
    BAR; WAIT_L(0); MMA(1, 0, At, Bx0); BAR; SCHED;
    STAGE(SB(1, 1), cB1, voffB, t + 3);
    WAIT_V(6); BAR; MMA(1, 1, At, Bx1); BAR;
  }
  {
    LDB(Bx0, 0, 0); LDA(At, 0, 0); STAGE(SA(1, 1), cA1, voffA, nt - 1);
    BAR; WAIT_L(0); MMA(0, 0, At, Bx0); BAR;
    LDB(Bx1, 0, 1); BAR; WAIT_L(0); MMA(0, 1, At, Bx1); BAR;
    LDA(At, 0, 1);
    if (has_next) { STAGE(SB(0, 0), dB0, voffB, 0); STAGE(SA(0, 0), dA0, voffA, 0); WAIT_V(8); } else { WAIT_V(4); }
    BAR; WAIT_L(0); MMA(1, 0, At, Bx0); MMA(1, 1, At, Bx1); BAR;
  }
  {
    LDB(Bx0, 1, 0); LDA(At, 1, 0);
    if (has_next) { STAGE(SB(0, 1), dB1, voffB, 0); WAIT_V(8); } else { WAIT_V(2); }
    BAR; WAIT_L(0); MMA(0, 0, At, Bx0); BAR;
    LDB(Bx1, 1, 1);
    if (has_next) { STAGE(SA(0, 1), dA1, voffA, 0); WAIT_V(8); } else { WAIT_V(0); }
    BAR; WAIT_L(0); MMA(0, 1, At, Bx1); BAR;
    LDA(At, 1, 1);
    if (has_next) { STAGE(SB(1, 0), dB0, voffB, 1); STAGE(SA(1, 0), dA0, voffA, 1); }
    BAR; WAIT_L(0); MMA(1, 0, At, Bx0); MMA(1, 1, At, Bx1); BAR;
  }
  if (wr == 0) BAR;
#undef SA
#undef SB
#undef STAGE
#undef LDA
#undef LDB
#undef MMA
#undef WAIT_V
#undef WAIT_L
#undef BAR
#undef SCHED
#undef G8LAS
}

#define TR_LOAD(SRC, NN, V0, V1, V2, V3, V4, V5, V6, V7)                                                     \
  {                                                                                                            \
    const float* _s = (SRC) + (long)(tid >> 5) * (NN) + (tid & 31) * 4;                                        \
    V0 = *(const float4*)(_s); V1 = *(const float4*)(_s + (long)16 * (NN)); V2 = *(const float4*)(_s + (long)32 * (NN)); V3 = *(const float4*)(_s + (long)48 * (NN)); \
    V4 = *(const float4*)(_s + (long)64 * (NN)); V5 = *(const float4*)(_s + (long)80 * (NN)); V6 = *(const float4*)(_s + (long)96 * (NN)); V7 = *(const float4*)(_s + (long)112 * (NN)); \
  }
__device__ __forceinline__ void tr_store(bf16_t* __restrict__ dst, int K, float4 v0, float4 v1, float4 v2, float4 v3, float4 v4, float4 v5, float4 v6, float4 v7, float* tile, int tid) {
  const float4 v[8] = {v0, v1, v2, v3, v4, v5, v6, v7};
#pragma unroll
  for (int i = 0; i < 8; ++i) *(float4*)(tile + ((tid >> 5) + 16 * i) * 132 + (tid & 31) * 4) = v[i];
  __syncthreads();
  const int nn = tid & 127, kg = tid >> 7;
  const float* col = tile + (kg * 32) * 132 + nn;
#pragma unroll
  for (int c = 0; c < 4; ++c) {
    uint4 o;
    o.x = pk_bf16(col[(c * 8 + 0) * 132], col[(c * 8 + 1) * 132]);
    o.y = pk_bf16(col[(c * 8 + 2) * 132], col[(c * 8 + 3) * 132]);
    o.z = pk_bf16(col[(c * 8 + 4) * 132], col[(c * 8 + 5) * 132]);
    o.w = pk_bf16(col[(c * 8 + 6) * 132], col[(c * 8 + 7) * 132]);
    *(uint4*)(dst + (long)nn * K + kg * 32 + c * 8) = o;
  }
  __syncthreads();
}

__device__ void ada_item(const P& p, int item, float* sm, int tid) {
  const int l = item / 48, chunk = item % 48;
  float* sc = sm;
  float* red = sm + 3072;
  for (int i = tid; i < 3072; i += 512) {
    const int cb = i >> 10, k = i & 1023;
    const float v = cb == 0 ? p.c_ctx[k] : p.c[(cb - 1) * 1024 + k];
    sc[i] = v / (1.f + __expf(-v));
  }
  __syncthreads();
  const int ng = tid & 31, kg = tid >> 5;
  const float* wp = p.w_ada + ((long)l * 1024 + kg * 64) * 6144 + chunk * 128 + ng * 4;
  float a0[4] = {0.f, 0.f, 0.f, 0.f}, a1[4] = {0.f, 0.f, 0.f, 0.f}, a2[4] = {0.f, 0.f, 0.f, 0.f};
#pragma unroll 8
  for (int k = 0; k < 64; ++k) {
    const float4 wv = *(const float4*)(wp + (long)k * 6144);
    const float s0 = sc[kg * 64 + k], s1 = sc[1024 + kg * 64 + k], s2 = sc[2048 + kg * 64 + k];
    a0[0] += s0 * wv.x; a0[1] += s0 * wv.y; a0[2] += s0 * wv.z; a0[3] += s0 * wv.w;
    a1[0] += s1 * wv.x; a1[1] += s1 * wv.y; a1[2] += s1 * wv.z; a1[3] += s1 * wv.w;
    a2[0] += s2 * wv.x; a2[1] += s2 * wv.y; a2[2] += s2 * wv.z; a2[3] += s2 * wv.w;
  }
#pragma unroll
  for (int j = 0; j < 4; ++j) {
    red[(kg * 3 + 0) * 128 + ng * 4 + j] = a0[j];
    red[(kg * 3 + 1) * 128 + ng * 4 + j] = a1[j];
    red[(kg * 3 + 2) * 128 + ng * 4 + j] = a2[j];
  }
  __syncthreads();
  if (tid < 384) {
    const int cb = tid >> 7, n = tid & 127;
    float s = p.b_ada[l * 6144 + chunk * 128 + n];
#pragma unroll
    for (int g = 0; g < 16; ++g) s += red[(g * 3 + cb) * 128 + n];
    p.mod()[((long)l * 3 + cb) * 6144 + chunk * 128 + n] = s;
  }
  __syncthreads();
}

__device__ __forceinline__ void tr_decode(const P& p, int t, const float*& osrc, bf16_t*& odst, int& oK, int& oN) {
  constexpr int t_ffn_in = 4 * 8 * 44, t_ffn_out = 4 * 22 * 8, t_a_in = 2 * 8 * 32, t_a_out = 2 * 16 * 8, t_p = 4 * 2 * 2, t_qkv = 8 * 12, t_o = 8 * 8;
  const float* src; bf16_t* dst; int K, N;
#define TR_OPAQUE asm volatile("" : "+s"(src), "+s"(dst));
  if (t < t_ffn_in) { src = p.w_ffn_in; dst = p.wt_ffn_in(); K = 1024; N = 5632; TR_OPAQUE }
  else if ((t -= t_ffn_in) < t_ffn_out) { src = p.w_ffn_out; dst = p.wt_ffn_out(); K = 2816; N = 1024; TR_OPAQUE }
  else if ((t -= t_ffn_out) < t_a_in) { src = p.a_w_in; dst = p.wt_a_in(); K = 1024; N = 4096; TR_OPAQUE }
  else if ((t -= t_a_in) < t_a_out) { src = p.a_w_out; dst = p.wt_a_out(); K = 2048; N = 1024; TR_OPAQUE }
  else if ((t -= t_a_out) < t_p) { src = p.p_w; dst = p.wt_p(); K = 256; N = 256; TR_OPAQUE }
  else if ((t -= t_p) < t_qkv) { src = p.c_w_qkv; dst = p.wt_qkv(); K = 1024; N = 1536; TR_OPAQUE }
  else if ((t -= t_qkv) < t_o) { src = p.c_w_o; dst = p.wt_o(); K = 1024; N = 1024; TR_OPAQUE }
  else { t -= t_o; src = p.cache_v; dst = p.cvT(); K = 256; N = 256; TR_OPAQUE }
  const int nkt = K >> 7, nnt = N >> 7, per = nkt * nnt;
  const int mat = t / per, r = t % per;
  const int nt = r % nnt, kt = r / nnt;
  osrc = src + (long)mat * K * N + (long)(kt * 128) * N + nt * 128;
  odst = dst + (long)mat * K * N + (long)(nt * 128) * K + kt * 128;
  oK = K; oN = N;
#undef TR_OPAQUE
}

__device__ __forceinline__ int tr_group_size(int g) { return g == 0 ? 920 : (g == 1 ? 544 : (g == 2 ? 688 : 912)); }
__device__ __forceinline__ int tr_group_map(int g, int i) {
  if (i < 352) return 352 * g + i;
  i -= 352;
  if (i < 176) return 1408 + 176 * g + i;
  i -= 176;
  if (g == 0) return i < 256 ? 2112 + i : (i < 384 ? 2624 + (i - 256) : 3056 + (i - 384));
  if (g == 1) return 2880 + i;
  if (g == 2) return i < 96 ? 2896 + i : 2992 + (i - 96);
  return i < 256 ? 2112 + 256 + i : 2624 + 128 + (i - 256);
}
__device__ void run_transposes(const P& p, int g, int first, int stride, float* sm, int tid) {
  const int n = tr_group_size(g);
  int t = first;
  if (t < n) {
    const float* csrc; bf16_t* cdst; int cK, cN;
    tr_decode(p, tr_group_map(g, t), csrc, cdst, cK, cN);
    float4 a0, a1, a2, a3, a4, a5, a6, a7;
    TR_LOAD(csrc, cN, a0, a1, a2, a3, a4, a5, a6, a7)
    while (true) {
      const int tn = t + stride;
      const bool more = tn < n;
      const float* nsrc; bf16_t* ndst; int nK, nN;
      tr_decode(p, tr_group_map(g, more ? tn : t), nsrc, ndst, nK, nN);
      float4 b0 = a0, b1 = a1, b2 = a2, b3 = a3, b4 = a4, b5 = a5, b6 = a6, b7 = a7;
      if (more) TR_LOAD(nsrc, nN, b0, b1, b2, b3, b4, b5, b6, b7)
      tr_store(cdst, cK, a0, a1, a2, a3, a4, a5, a6, a7, sm, tid);
      if (!more) break;
      a0 = b0; a1 = b1; a2 = b2; a3 = b3; a4 = b4; a5 = b5; a6 = b6; a7 = b7;
      cdst = ndst; cK = nK; t = tn;
    }
  }
}

__device__ void phase_prep(const P& p, char* smem) {
  float* sm = (float*)smem;
  const int tid = opaque_tid();
  constexpr int N_ADA = 192, N_CK = 32, N_Z = 6 + 24;
  constexpr int TR0 = N_ADA + N_CK + N_Z;
  for (int item = opaque_bid(); item < TR0; item += gridDim.x) {
    if (item < N_ADA) { ada_item(p, item, sm, tid); continue; }
    if (item < N_ADA + N_CK) {
      const int i0 = (item - N_ADA) * 4096 + tid * 8;
      const float4 a = *(const float4*)(p.cache_k + i0), b = *(const float4*)(p.cache_k + i0 + 4);
      uint4 o; o.x = pk_bf16(a.x, a.y); o.y = pk_bf16(a.z, a.w); o.z = pk_bf16(b.x, b.y); o.w = pk_bf16(b.z, b.w);
      *(uint4*)(p.ck() + i0) = o;
      continue;
    }
    const int zi = item - N_ADA - N_CK;
    float* zp = zi < 6 ? p.vsq() + zi * 4096 + tid * 8 : p.rowsq() + (zi - 6) * 4096 + tid * 8;
    *(float4*)(zp) = make_float4(0.f, 0.f, 0.f, 0.f);
    *(float4*)(zp + 4) = make_float4(0.f, 0.f, 0.f, 0.f);
  }
  run_transposes(p, 0, (int)(gridDim.x - 1 - opaque_bid()), (int)gridDim.x, sm, tid);
}

__device__ void phase_filler(const P& p, int g, char* smem) {
  const int bid = opaque_bid();
  if (bid < 32) return;
  const int tid = opaque_tid();
  const int fb = bid - 32, nf = (int)gridDim.x - 32;
  __syncthreads();
  run_transposes(p, g, nf - 1 - fb, nf, (float*)smem, tid);
}

__device__ void phase_norm(const P& p, int layer, int which, bool first) {
  const int tid = opaque_tid(), lane = tid & 63, w = tid >> 6;
  const float* g = (which ? p.g_ffn : p.g_mix) + layer * 1024;
  for (int item = opaque_bid(); item < T / 16; item += gridDim.x) {
    const int row0 = item * 16 + w * 2;
    float4 v[2][4];
    float ss[2] = {0.f, 0.f};
#pragma unroll
    for (int r = 0; r < 2; ++r) {
      const int row = row0 + r;
      const float* xr = first ? (row < TCTX ? p.x_prompt + (long)row * 1024 : p.x_sample + (long)(row - TCTX) * 1024) : p.xo() + (long)row * 1024;
#pragma unroll
      for (int i = 0; i < 4; ++i) {
        v[r][i] = *(const float4*)(xr + (i * 64 + lane) * 4);
        ss[r] += v[r][i].x * v[r][i].x + v[r][i].y * v[r][i].y + v[r][i].z * v[r][i].z + v[r][i].w * v[r][i].w;
      }
    }
#pragma unroll
    for (int o = 32; o; o >>= 1) { ss[0] += __shfl_xor(ss[0], o); ss[1] += __shfl_xor(ss[1], o); }
    const float* md = p.mod() + ((long)layer * 3 + cond_of_row(row0)) * 6144 + which * 3072;
#pragma unroll
    for (int i = 0; i < 4; ++i) {
      const int col = (i * 64 + lane) * 4;
      const float4 gg = *(const float4*)(g + col), sh = *(const float4*)(md + col), sc = *(const float4*)(md + 1024 + col);
#pragma unroll
      for (int r = 0; r < 2; ++r) {
        const float rstd = rsqrtf(ss[r] * (1.f / 1024.f) + 1e-6f);
        const float y0 = v[r][i].x * rstd * gg.x * (1.f + sc.x) + sh.x;
        const float y1 = v[r][i].y * rstd * gg.y * (1.f + sc.y) + sh.y;
        const float y2 = v[r][i].z * rstd * gg.z * (1.f + sc.z) + sh.z;
        const float y3 = v[r][i].w * rstd * gg.w * (1.f + sc.w) + sh.w;
        uint2 o; o.x = pk_bf16(y0, y1); o.y = pk_bf16(y2, y3);
        *(uint2*)(p.h() + (long)(row0 + r) * 1024 + col) = o;
        if (first) *(float4*)(p.xo() + (long)(row0 + r) * 1024 + col) = v[r][i];
      }
    }
  }
}

__device__ void phase_shw(const P& p, int ra0, int ra1, int rb0, int rb1) {
  const int tid = opaque_tid(), lane = tid & 63, w = tid >> 6;
  const int na = (ra1 - ra0) >> 6, nb = (rb1 - rb0) >> 6;
  for (int item = opaque_bid(); item < na + nb; item += gridDim.x) {
    int r = (item < na ? ra0 + item * 64 : rb0 + (item - na) * 64) + w * 8;
    int idx, n0; const bf16_t* wrow;
    if (r < 4 * 5632) { const int l = r / 5632; n0 = r - l * 5632; idx = 2 * l + 1; wrow = p.wt_ffn_in() + ((long)l * 5632 + n0) * 1024; }
    else if ((r -= 4 * 5632) < 1536) { n0 = r; idx = 4; wrow = p.wt_qkv() + (long)n0 * 1024; }
    else { n0 = r - 1536; idx = 6; wrow = p.wt_a_in() + ((long)4096 + n0) * 1024; }
    uint4 wv[8][2];
#pragma unroll
    for (int q = 0; q < 8; ++q) { wv[q][0] = *(const uint4*)(wrow + (long)q * 1024 + lane * 16); wv[q][1] = *(const uint4*)(wrow + (long)q * 1024 + lane * 16 + 8); }
    const float* shb = p.mod() + (long)(idx >> 1) * 3 * 6144 + ((idx & 1) ? 3072 : 0) + lane * 16;
    float sacc[8][3];
#pragma unroll
    for (int q = 0; q < 8; ++q) { sacc[q][0] = 0.f; sacc[q][1] = 0.f; sacc[q][2] = 0.f; }
#pragma unroll
    for (int cnd = 0; cnd < 3; ++cnd) {
      const float* sh = shb + cnd * 6144;
      const float4 s0 = *(const float4*)(sh), s1 = *(const float4*)(sh + 4), s2 = *(const float4*)(sh + 8), s3 = *(const float4*)(sh + 12);
#pragma unroll
      for (int q = 0; q < 8; ++q) {
        const uint4 a = wv[q][0], b = wv[q][1];
        sacc[q][cnd] = s0.x * bflo(a.x) + s0.y * bfhi(a.x) + s0.z * bflo(a.y) + s0.w * bfhi(a.y) + s1.x * bflo(a.z) + s1.y * bfhi(a.z) + s1.z * bflo(a.w) + s1.w * bfhi(a.w)
                     + s2.x * bflo(b.x) + s2.y * bfhi(b.x) + s2.z * bflo(b.y) + s2.w * bfhi(b.y) + s3.x * bflo(b.z) + s3.y * bfhi(b.z) + s3.z * bflo(b.w) + s3.w * bfhi(b.w);
      }
    }
#pragma unroll
    for (int o = 32; o; o >>= 1)
#pragma unroll
      for (int q = 0; q < 8; ++q) { sacc[q][0] += __shfl_xor(sacc[q][0], o); sacc[q][1] += __shfl_xor(sacc[q][1], o); sacc[q][2] += __shfl_xor(sacc[q][2], o); }
    if (lane < 24) {
      const int q = lane / 3, cnd = lane - q * 3;
      float v = 0.f;
#pragma unroll
      for (int qq = 0; qq < 8; ++qq)
#pragma unroll
        for (int cc = 0; cc < 3; ++cc) if (qq == q && cc == cnd) v = sacc[qq][cc];
      p.shw()[((long)idx * 3 + cnd) * 5632 + n0 + q] = v;
    }
  }
}

__device__ __forceinline__ void ffn_fix_rows(const P& p, int layer, int lo, int hi, int tid) {
  bf16_t* gbuf = (bf16_t*)p.big2();
  const float* cw = p.ffn_conv_w + (long)layer * 3 * 2816;
  const float* cb = p.ffn_conv_b + (long)layer * 2816;
  bool any = false;
  for (int q = 0; q < 32; ++q) {
    const int lt = q >> 1, e = q & 1;
    const int row = TCTX + lt * 256 + (e == 0 ? 0 : 255);
    if (row < lo || row >= hi) continue;
    if (e == 0 ? (lt & 7) == 0 : (lt & 7) == 7) continue;
    any = true;
    const float* ap = e == 0 ? p.ha() + (long)((lt - 1) * 4 + 3) * 2816 : p.ha() + (long)(lt * 4 + 2) * 2816;
    const float* ac = e == 0 ? p.ha() + (long)(lt * 4 + 0) * 2816 : p.ha() + (long)(lt * 4 + 3) * 2816;
    const float* an = e == 0 ? p.ha() + (long)(lt * 4 + 1) * 2816 : p.ha() + (long)((lt + 1) * 4 + 0) * 2816;
    const float* uu = p.hu() + (long)(lt * 2 + e) * 2816;
    for (int c = tid; c < 2816; c += 512) {
      const float x = cw[c] * ap[c] + cw[2816 + c] * ac[c] + cw[5632 + c] * an[c] + cb[c];
      gbuf[(long)row * 2816 + c] = f2bf(gelu_f(x) * uu[c]);
    }
  }
  if (any) { asm volatile("s_waitcnt vmcnt(0)" ::: "memory"); __syncthreads(); }
}

__device__ __forceinline__ void pool_tile(const P& p, int mt, int g, char* smem, int tid) {
  const int half = 1 << g;
  bf16_t* d = (bf16_t*)p.big1();
  const bf16_t* h = p.h();
  const int r0 = mt * 192;
  int lo0 = r0 - 8; lo0 = lo0 < 0 ? 0 : lo0;
  int hi0 = r0 + 192 + 7; hi0 = hi0 > T ? T : hi0;
  const int nch = (hi0 - lo0) * 32;
  const float* rq = p.rowsq() + (long)2 * T;
  for (int ci = tid; ci < nch; ci += 512) {
    const int row = lo0 + (ci >> 5), c8 = g * 256 + (ci & 31) * 8;
    const uint4 xv = *(const uint4*)(h + (long)row * 1024 + c8);
    const float r = rsqrtf(rq[row] * (1.f / 1024.f) + 1e-6f);
    const float* shp = p.mod() + ((long)1 * 3 + cond_of_row(row)) * 6144 + c8;
    const float4 s0 = *(const float4*)(shp), s1 = *(const float4*)(shp + 4);
    uint4 o;
    o.x = pk_bf16(r * bflo(xv.x) + s0.x, r * bfhi(xv.x) + s0.y); o.y = pk_bf16(r * bflo(xv.y) + s0.z, r * bfhi(xv.y) + s0.w);
    o.z = pk_bf16(r * bflo(xv.z) + s1.x, r * bfhi(xv.z) + s1.y); o.w = pk_bf16(r * bflo(xv.w) + s1.z, r * bfhi(xv.w) + s1.w);
    *(uint4*)(smem + ci * 16) = o;
  }
  __syncthreads();
  const int c4 = (tid & 63) * 4;
  for (int rr = tid >> 6; rr < 192; rr += 8) {
    const int row = r0 + rr;
    int s, S;
    if (row < TCTX) { s = row & 255; S = 256; } else { s = (row - TCTX) & 2047; S = 2048; }
    const int base = row - s;
    int lo = s - half; lo = lo < 0 ? 0 : lo;
    int hi = s + half - 1; hi = hi > S - 1 ? S - 1 : hi;
    float a0 = 0.f, a1 = 0.f, a2 = 0.f, a3 = 0.f;
    for (int q = lo; q <= hi; ++q) {
      const uint2 v = *(const uint2*)(smem + (base + q - lo0) * 512 + c4 * 2);
      a0 += bflo(v.x); a1 += bfhi(v.x); a2 += bflo(v.y); a3 += bfhi(v.y);
    }
    const float inv = 1.f / (float)(hi - lo + 1);
    const uint2 v = *(const uint2*)(smem + (row - lo0) * 512 + c4 * 2);
    uint2 o;
    o.x = pk_bf16(a0 * inv - bflo(v.x), a1 * inv - bfhi(v.x));
    o.y = pk_bf16(a2 * inv - bflo(v.y), a3 * inv - bfhi(v.y));
    *(uint2*)(d + (long)row * 1024 + g * 256 + c4) = o;
  }
  asm volatile("s_waitcnt vmcnt(0)" ::: "memory");
  __syncthreads();
}

enum { G_GMLP_IN = 0, G_RESID = 1, G_POOL = 2, G_QKV = 3, G_FFN_IN = 4, G_GMLP_V = 5, G_QKV_V = 6 };

template <int KIND>
__device__ void phase_gemm(const P& p, const bf16_t* __restrict__ A, int lda, const bf16_t* __restrict__ Bt, int ldb, int K, int ntn, int layer, int aux, int fx, char* smem) {
  constexpr bool R192 = (KIND == G_RESID || KIND == G_POOL);
  constexpr int MT = R192 ? 64 : 48, MROWS = R192 ? 192 : 256;
  constexpr int CHAIN_V = KIND == G_GMLP_IN ? 48 * 8 : (KIND == G_QKV ? 48 * 1 : 0);
  constexpr int CHAIN_VOFF = KIND == G_GMLP_IN ? 8 : 5;
  constexpr int PREV_CNT = KIND == G_GMLP_V ? 48 * 8 : (KIND == G_QKV_V ? 48 * 5 : 0);
  bool pre = PREV_CNT > 0 && opaque_bid() < PREV_CNT;
  for (int item = ((KIND == G_GMLP_V || KIND == G_QKV_V) ? (int)(gridDim.x - 1 - opaque_bid()) : opaque_bid()); item < MT * ntn; item += gridDim.x) {
    const int tid = opaque_tid();
    const int mt = item % MT, nt = item / MT + (KIND == G_GMLP_V ? 8 : (KIND == G_QKV_V ? 5 : 0));
    const bf16_t* At = A + (long)mt * MROWS * lda + (KIND == G_POOL ? nt * 256 : 0);
    const bf16_t* B0 = Bt + (long)nt * (KIND == G_FFN_IN ? 128 : 256) * ldb;
    const bf16_t* B1 = KIND == G_FFN_IN ? Bt + (long)(2816 + nt * 128) * ldb : B0 + (long)128 * ldb;
    const bool own_next = item + (int)gridDim.x < MT * ntn;
    const int vitem0 = (int)gridDim.x - 1 - opaque_bid();
    const bool chain = CHAIN_V > 0 && !own_next && vitem0 < CHAIN_V;
    const bool has_next = own_next || chain;
    const int nitem = own_next ? item + (int)gridDim.x : (chain ? vitem0 : item);
    const int nmt = nitem % MT, nnt = nitem / MT + (chain ? CHAIN_VOFF : (KIND == G_GMLP_V ? 8 : (KIND == G_QKV_V ? 5 : 0)));
    const bf16_t* nAt = A + (long)nmt * MROWS * lda + (KIND == G_POOL ? nnt * 256 : 0);
    const bf16_t* nB0 = Bt + (long)nnt * (KIND == G_FFN_IN ? 128 : 256) * ldb;
    const bf16_t* nB1 = KIND == G_FFN_IN ? Bt + (long)(2816 + nnt * 128) * ldb : nB0 + (long)128 * ldb;
    const bool was_pre = pre;
    pre = has_next;
    if constexpr (KIND == G_RESID) { if (aux == 5120) ffn_fix_rows(p, layer, mt * MROWS, mt * MROWS + MROWS, tid); }
    if constexpr (KIND == G_POOL) pool_tile(p, mt, nt, smem, tid);
    f32x4 acc[2][2][4][2];
#define EPI_IDS()                                                                                                     \
    const int te = opaque_tid(), lane = te & 63, wid = __builtin_amdgcn_readfirstlane(te >> 6), wr = wid >> 2, wc = wid & 3, fr = lane & 15, fq = lane >> 4; \
    const int rb = mt * MROWS + wr * 64, cb = nt * 256 + wc * 32;
    if constexpr (KIND == G_GMLP_V || KIND == G_QKV_V) {
      gemm256<false, false>(At, At + (long)128 * lda, lda, B0, B1, ldb, K >> 6, smem, acc, tid, was_pre, has_next, nAt, nAt + (long)128 * lda, nB0, nB1);
      EPI_IDS()
      const unsigned lo = (unsigned)(fr * T + fq * 4);
      if (fx >= 0) {
        const float* rq = p.rowsq() + (long)fx * T + rb + fq * 4;
        const float* sw = p.shw() + ((long)fx * 3 + cond_of_row(mt * 256)) * 5632 + cb + fr;
#pragma unroll
        for (int ai = 0; ai < 2; ++ai)
#pragma unroll
          for (int m = 0; m < 4; ++m) {
            const float4 q = *(const float4*)(rq + ai * 128 + m * 16);
            const float r0 = rsqrtf(q.x * (1.f / 1024.f) + 1e-6f), r1 = rsqrtf(q.y * (1.f / 1024.f) + 1e-6f), r2 = rsqrtf(q.z * (1.f / 1024.f) + 1e-6f), r3 = rsqrtf(q.w * (1.f / 1024.f) + 1e-6f);
#pragma unroll
            for (int bj = 0; bj < 2; ++bj)
#pragma unroll
              for (int n = 0; n < 2; ++n) {
                const float sv = sw[bj * 128 + n * 16];
                f32x4 v = acc[ai][bj][m][n];
                v[0] = r0 * v[0] + sv; v[1] = r1 * v[1] + sv; v[2] = r2 * v[2] + sv; v[3] = r3 * v[3] + sv;
                acc[ai][bj][m][n] = v;
              }
          }
      }
      if constexpr (KIND == G_QKV_V) {
        bf16_t* vTa = (bf16_t*)p.big2() + (long)T * 1024 + (long)T * 256;
        float* outv = p.xo() + (long)T * 1024 + (long)TCTX * 256;
#pragma unroll
        for (int ai = 0; ai < 2; ++ai)
#pragma unroll
          for (int m = 0; m < 4; ++m)
#pragma unroll
            for (int bj = 0; bj < 2; ++bj)
#pragma unroll
              for (int n = 0; n < 2; ++n) {
                const int c0 = wc * 32 + bj * 128 + n * 16, r0 = rb + ai * 128 + m * 16;
                const f32x4 v = acc[ai][bj][m][n];
                uint2 o; o.x = pk_bf16(v[0], v[1]); o.y = pk_bf16(v[2], v[3]);
                *(uint2*)(vTa + (long)c0 * T + r0 + lo) = o;
                if (mt < 32) {
                  float* ov = outv + (long)(r0 + fq * 4) * 256 + c0 + fr;
                  ov[0] = v[0]; ov[256] = v[1]; ov[512] = v[2]; ov[768] = v[3];
                }
                if (bj == 1 && n == 1) asm volatile("" ::: "memory");
              }
      } else {
      bf16_t* vT = (bf16_t*)p.big1() + (long)T * 2048;
      float* vsq = p.vsq() + (long)aux * T;
#pragma unroll
      for (int ai = 0; ai < 2; ++ai)
#pragma unroll
        for (int m = 0; m < 4; ++m) {
          float sq[4] = {0.f, 0.f, 0.f, 0.f};
#pragma unroll
          for (int bj = 0; bj < 2; ++bj)
#pragma unroll
            for (int n = 0; n < 2; ++n) {
              float z0 = gelu_f(acc[ai][bj][m][n][0]), z1 = gelu_f(acc[ai][bj][m][n][1]), z2 = gelu_f(acc[ai][bj][m][n][2]), z3 = gelu_f(acc[ai][bj][m][n][3]);
              sq[0] += z0 * z0; sq[1] += z1 * z1; sq[2] += z2 * z2; sq[3] += z3 * z3;
              uint2 o; o.x = pk_bf16(z0, z1); o.y = pk_bf16(z2, z3);
              bf16_t* sb = vT + (long)(cb - 2048 + bj * 128 + n * 16) * T + rb + ai * 128 + m * 16;
              *(uint2*)(sb + lo) = o;
            }
#pragma unroll
          for (int j = 0; j < 4; ++j) {
            float s = sq[j];
            s += __shfl_xor(s, 1); s += __shfl_xor(s, 2); s += __shfl_xor(s, 4); s += __shfl_xor(s, 8);
            if (fr == 0) atomicAdd(vsq + rb + ai * 128 + m * 16 + fq * 4 + j, s);
          }
          asm volatile("" ::: "memory");
        }
      }
    } else {
    gemm256<true, R192>(At, At + (long)128 * lda, lda, B0, B1, ldb, K >> 6, smem, acc, tid, was_pre, has_next, nAt, nAt + (long)128 * lda, nB0, nB1);
    EPI_IDS()
    if constexpr (KIND == G_GMLP_IN || KIND == G_QKV || KIND == G_FFN_IN) {
      if (fx >= 0) {
        const float* rq = p.rowsq() + (long)fx * T + rb + fr;
        const float* sw = p.shw() + ((long)fx * 3 + cond_of_row(mt * 256)) * 5632 + (KIND == G_FFN_IN ? nt * 128 + wc * 32 : cb) + fq * 4;
        float rr[2][4];
#pragma unroll
        for (int ai = 0; ai < 2; ++ai)
#pragma unroll
          for (int m = 0; m < 4; ++m) rr[ai][m] = rsqrtf(rq[ai * 128 + m * 16] * (1.f / 1024.f) + 1e-6f);
#pragma unroll
        for (int bj = 0; bj < 2; ++bj)
#pragma unroll
          for (int n = 0; n < 2; ++n) {
            const float4 sv = *(const float4*)(sw + (KIND == G_FFN_IN ? bj * 2816 : bj * 128) + n * 16);
#pragma unroll
            for (int ai = 0; ai < 2; ++ai)
#pragma unroll
              for (int m = 0; m < 4; ++m) {
                f32x4 v = acc[ai][bj][m][n];
                const float r = rr[ai][m];
                v[0] = r * v[0] + sv.x; v[1] = r * v[1] + sv.y; v[2] = r * v[2] + sv.z; v[3] = r * v[3] + sv.w;
                acc[ai][bj][m][n] = v;
              }
          }
      }
    }
    if constexpr (KIND == G_RESID || KIND == G_POOL) {
      const unsigned lo = (unsigned)(fr * 1024 + fq * 4);
      const bool fz = fx >= 0;
      const float* gvec = ((fx & 1) ? p.g_ffn : p.g_mix) + (fx >> 1) * 1024;
      const int nai = wr == 0 ? 2 : 1;
      const unsigned voffx = lo * 4u;
#pragma unroll
      for (int ai = 0; ai < 2; ++ai) {
        if (ai < nai) {
          f32x4 xr[4][4];
#pragma unroll
          for (int m = 0; m < 4; ++m)
#pragma unroll
            for (int q = 0; q < 4; ++q) {
              const float* bp = p.xo() + (long)(rb + ai * 128 + m * 16) * 1024 + cb + (q >> 1) * 128 + (q & 1) * 16;
              asm volatile("global_load_dwordx4 %0, %1, %2" : "=v"(xr[m][q]) : "v"(voffx), "s"(bp) : "memory");
            }
          asm volatile("s_waitcnt vmcnt(0)" ::: "memory");
#pragma unroll
          for (int m = 0; m < 4; ++m) {
            const int row = rb + ai * 128 + m * 16 + fr;
            const int cnd = cond_of_row(rb + ai * 128 + m * 16);
            const float* gate = p.mod() + ((long)layer * 3 + cnd) * 6144 + aux + cb + fq * 4;
            const float* scv = p.mod() + ((long)(fx >> 1) * 3 + cnd) * 6144 + ((fx & 1) ? 4096 : 1024) + cb + fq * 4;
            float rsum = 0.f;
#pragma unroll
            for (int bj = 0; bj < 2; ++bj)
#pragma unroll
              for (int n = 0; n < 2; ++n) {
                const int co = bj * 128 + n * 16;
                const float4 g = *(const float4*)(gate + co);
                float4 pb = make_float4(0.f, 0.f, 0.f, 0.f), ps = make_float4(1.f, 1.f, 1.f, 1.f);
                if constexpr (KIND == G_POOL) { pb = *(const float4*)(p.p_b + cb + fq * 4 + co); ps = *(const float4*)(p.p_scale + cb + fq * 4 + co); }
                const long eo = (long)(rb + ai * 128 + m * 16) * 1024 + cb + co;
                float4* xp = (float4*)(p.xo() + eo + lo);
                const f32x4 xl = xr[m][bj * 2 + n];
                float4 x = make_float4(xl[0], xl[1], xl[2], xl[3]);
                const f32x4 v = acc[ai][bj][m][n];
                x.x += g.x * ((v[0] + pb.x) * ps.x); x.y += g.y * ((v[1] + pb.y) * ps.y);
                x.z += g.z * ((v[2] + pb.z) * ps.z); x.w += g.w * ((v[3] + pb.w) * ps.w);
                *xp = x;
                if (fz) {
                  const float4 gv = *(const float4*)(gvec + cb + fq * 4 + co), sc = *(const float4*)(scv + co);
                  rsum += x.x * x.x + x.y * x.y + x.z * x.z + x.w * x.w;
                  uint2 o; o.x = pk_bf16(x.x * gv.x * (1.f + sc.x), x.y * gv.y * (1.f + sc.y)); o.y = pk_bf16(x.z * gv.z * (1.f + sc.z), x.w * gv.w * (1.f + sc.w));
                  *(uint2*)(p.h() + eo + lo) = o;
                }
              }
            if (fz) {
              rsum += __shfl_xor(rsum, 16); rsum += __shfl_xor(rsum, 32);
              if (fq == 0) atomicAdd(p.rowsq() + (long)fx * T + row, rsum);
            }
            asm volatile("" ::: "memory");
          }
        }
      }
    } else if constexpr (KIND == G_GMLP_IN) {
      bf16_t* u = (bf16_t*)p.big1();
      const unsigned lo = (unsigned)(fr * 2048 + fq * 4);
#pragma unroll
      for (int ai = 0; ai < 2; ++ai)
#pragma unroll
        for (int m = 0; m < 4; ++m)
#pragma unroll
          for (int bj = 0; bj < 2; ++bj)
#pragma unroll
            for (int n = 0; n < 2; ++n) {
              bf16_t* sb = u + (long)(rb + ai * 128 + m * 16) * 2048 + cb + bj * 128 + n * 16;
              const f32x4 v = acc[ai][bj][m][n];
              uint2 o; o.x = pk_bf16(gelu_f(v[0]), gelu_f(v[1])); o.y = pk_bf16(gelu_f(v[2]), gelu_f(v[3]));
              *(uint2*)(sb + lo) = o;
              if (bj == 1 && n == 1) asm volatile("" ::: "memory");
            }
    } else if constexpr (KIND == G_QKV) {
      float* part = (float*)(smem + 131072 + 16 + 4096);
      float rinv[2][2][4];
#pragma unroll
      for (int ai = 0; ai < 2; ++ai)
#pragma unroll
        for (int bj = 0; bj < 2; ++bj)
#pragma unroll
          for (int m = 0; m < 4; ++m) {
            const f32x4 a = acc[ai][bj][m][0], b = acc[ai][bj][m][1];
            float sq = a[0] * a[0] + a[1] * a[1] + a[2] * a[2] + a[3] * a[3] + b[0] * b[0] + b[1] * b[1] + b[2] * b[2] + b[3] * b[3];
            sq += __shfl_xor(sq, 16); sq += __shfl_xor(sq, 32);
            rinv[ai][bj][m] = sq;
            if (fq == 0) part[((wid * 2 + ai) * 2 + bj) * 64 + m * 16 + fr] = sq;
          }
      __syncthreads();
      {
        const int pw = wid ^ 1;
#pragma unroll
        for (int ai = 0; ai < 2; ++ai)
#pragma unroll
          for (int bj = 0; bj < 2; ++bj)
#pragma unroll
            for (int m = 0; m < 4; ++m)
              rinv[ai][bj][m] = rsqrtf((rinv[ai][bj][m] + part[((pw * 2 + ai) * 2 + bj) * 64 + m * 16 + fr]) * (1.f / 64.f) + 1e-6f);
      }
      const bool latt = mt >= 32;
      const float* gam = (nt < 4 ? p.c_g_q : p.c_g_k) + (wc & 1) * 32 + fq * 4;
      const float4 g0 = *(const float4*)(gam), g1 = *(const float4*)(gam + 16);
      float finv[4];
#pragma unroll
      for (int j = 0; j < 4; ++j) finv[j] = exp2f(-(float)(fq * 4 + j) * 0.8304820237218406f);
      bf16_t* qb = (bf16_t*)p.big2();
      bf16_t* kb = qb + (long)T * 1024;
      float* outk = p.xo() + (long)T * 1024;
      const float qs = nt < 4 ? 0.125f * LOG2E : 1.f;
#pragma unroll
      for (int ai = 0; ai < 2; ++ai)
#pragma unroll
        for (int m = 0; m < 4; ++m) {
          const int R = rb + ai * 128 + m * 16 + fr;
          float cs[4] = {1.f, 1.f, 1.f, 1.f}, sn[4] = {0.f, 0.f, 0.f, 0.f};
          if (latt) {
            const int sp = (R - TCTX) & 2047;
            const float pos = (float)((wc & 1) ? (sp & 63) : (sp >> 6));
#pragma unroll
            for (int j = 0; j < 4; ++j) { const float ang = pos * finv[j]; cs[j] = __cosf(ang); sn[j] = __sinf(ang); }
          }
#pragma unroll
          for (int bj = 0; bj < 2; ++bj) {
            const float r = rinv[ai][bj][m];
            const f32x4 av = acc[ai][bj][m][0], bv = acc[ai][bj][m][1];
            float a[4] = {av[0] * r * g0.x, av[1] * r * g0.y, av[2] * r * g0.z, av[3] * r * g0.w};
            float b[4] = {bv[0] * r * g1.x, bv[1] * r * g1.y, bv[2] * r * g1.z, bv[3] * r * g1.w};
#pragma unroll
            for (int j = 0; j < 4; ++j) { const float na = a[j] * cs[j] - b[j] * sn[j], nb = a[j] * sn[j] + b[j] * cs[j]; a[j] = na; b[j] = nb; }
            const int cl = bj * 128 + wc * 32 + fq * 4;
            uint2 oa, ob2;
            oa.x = pk_bf16(a[0] * qs, a[1] * qs); oa.y = pk_bf16(a[2] * qs, a[3] * qs);
            ob2.x = pk_bf16(b[0] * qs, b[1] * qs); ob2.y = pk_bf16(b[2] * qs, b[3] * qs);
            if (nt < 4) {
              bf16_t* dst = qb + (long)R * 1024 + nt * 256 + cl;
              *(uint2*)dst = oa; *(uint2*)(dst + 16) = ob2;
            } else {
              bf16_t* dst = kb + (long)R * 256 + cl;
              *(uint2*)dst = oa; *(uint2*)(dst + 16) = ob2;
              if (!latt) {
                float* od = outk + (long)R * 256 + cl;
                *(float4*)od = make_float4(a[0], a[1], a[2], a[3]); *(float4*)(od + 16) = make_float4(b[0], b[1], b[2], b[3]);
              }
            }
          }
          asm volatile("" ::: "memory");
        }
    } else {
      float* edge = (float*)(smem + 131072 + 16);
      const int ecol = wc * 32 + fq * 4;
      if (fr == 0 || fr == 15) {
#pragma unroll
        for (int ai = 0; ai < 2; ++ai)
#pragma unroll
          for (int n = 0; n < 2; ++n) {
            const f32x4 v = fr == 0 ? acc[ai][0][0][n] : acc[ai][0][3][n];
            *(float4*)(edge + ((ai * 2 + wr) * 2 + (fr == 0 ? 0 : 1)) * 128 + ecol + n * 16) = make_float4(v[0], v[1], v[2], v[3]);
          }
      }
      if (mt >= 32) {
        const int lt = mt - 32;
        if (wid < 4 && fr < 2) {
#pragma unroll
          for (int n = 0; n < 2; ++n) {
            const f32x4 v = acc[0][0][0][n];
            *(float4*)(p.ha() + ((long)(lt * 4 + fr)) * 2816 + nt * 128 + ecol + n * 16) = make_float4(v[0], v[1], v[2], v[3]);
            if (fr == 0) { const f32x4 uv = acc[0][1][0][n]; *(float4*)(p.hu() + ((long)(lt * 2 + 0)) * 2816 + nt * 128 + ecol + n * 16) = make_float4(uv[0], uv[1], uv[2], uv[3]); }
          }
        }
        if (wid >= 4 && fr >= 14) {
#pragma unroll
          for (int n = 0; n < 2; ++n) {
            const f32x4 v = acc[1][0][3][n];
            *(float4*)(p.ha() + ((long)(lt * 4 + 2 + (fr - 14))) * 2816 + nt * 128 + ecol + n * 16) = make_float4(v[0], v[1], v[2], v[3]);
            if (fr == 15) { const f32x4 uv = acc[1][1][3][n]; *(float4*)(p.hu() + ((long)(lt * 2 + 1)) * 2816 + nt * 128 + ecol + n * 16) = make_float4(uv[0], uv[1], uv[2], uv[3]); }
          }
        }
      }
      __syncthreads();
      bf16_t* gbuf = (bf16_t*)p.big2();
      const float* cwp = p.ffn_conv_w + (long)layer * 3 * 2816 + nt * 128 + ecol;
      const float* cbp = p.ffn_conv_b + (long)layer * 2816 + nt * 128 + ecol;
      const unsigned lo = (unsigned)(fr * 2816 + fq * 4);
#pragma unroll
      for (int n = 0; n < 2; ++n) {
        const float4 w0 = *(const float4*)(cwp + n * 16), w1 = *(const float4*)(cwp + 2816 + n * 16), w2 = *(const float4*)(cwp + 5632 + n * 16), bb = *(const float4*)(cbp + n * 16);
        const float w0a[4] = {w0.x, w0.y, w0.z, w0.w}, w1a[4] = {w1.x, w1.y, w1.z, w1.w}, w2a[4] = {w2.x, w2.y, w2.z, w2.w}, bba[4] = {bb.x, bb.y, bb.z, bb.w};
#pragma unroll
        for (int ai = 0; ai < 2; ++ai) {
          float4 ep = make_float4(0.f, 0.f, 0.f, 0.f), en = make_float4(0.f, 0.f, 0.f, 0.f);
          if (wr == 1) ep = *(const float4*)(edge + ((ai * 2 + 0) * 2 + 1) * 128 + ecol + n * 16);
          else if (ai == 1) ep = *(const float4*)(edge + ((0 * 2 + 1) * 2 + 1) * 128 + ecol + n * 16);
          if (wr == 0) en = *(const float4*)(edge + ((ai * 2 + 1) * 2 + 0) * 128 + ecol + n * 16);
          else if (ai == 0) en = *(const float4*)(edge + ((1 * 2 + 0) * 2 + 0) * 128 + ecol + n * 16);
          const float epa[4] = {ep.x, ep.y, ep.z, ep.w}, ena[4] = {en.x, en.y, en.z, en.w};
          float gq[4][4];
#pragma unroll
          for (int j = 0; j < 4; ++j) {
            float U[4], Dn[4];
#pragma unroll
            for (int m = 0; m < 4; ++m) { U[m] = row_ror1(acc[ai][0][m][n][j]); Dn[m] = row_ror15(acc[ai][0][m][n][j]); }
#pragma unroll
            for (int m = 0; m < 4; ++m) {
              const float prev = fr == 0 ? (m > 0 ? U[m > 0 ? m - 1 : 0] : epa[j]) : U[m];
              const float next = fr == 15 ? (m < 3 ? Dn[m < 3 ? m + 1 : 3] : ena[j]) : Dn[m];
              const float x = w0a[j] * prev + w1a[j] * acc[ai][0][m][n][j] + w2a[j] * next + bba[j];
              gq[m][j] = gelu_f(x) * acc[ai][1][m][n][j];
            }
          }
#pragma unroll
          for (int m = 0; m < 4; ++m) {
            bf16_t* sb = gbuf + (long)(rb + ai * 128 + m * 16) * 2816 + nt * 128 + wc * 32 + n * 16;
            uint2 o; o.x = pk_bf16(gq[m][0], gq[m][1]); o.y = pk_bf16(gq[m][2], gq[m][3]);
            *(uint2*)(sb + lo) = o;
          }
        }
      }
    }
    }
  }
}

__device__ void phase_spatial(const P& p, int j, char* smem) {
  const int tid = opaque_tid(), lane = tid & 63, w = __builtin_amdgcn_readfirstlane(tid >> 6), wm = w >> 1, wn = w & 1, l31 = lane & 31, hh = lane >> 5;
  const int c = tid & 7, r0 = tid >> 3;
  const bf16_t* u = (const bf16_t*)p.big1();
  const bf16_t* vT = u + (long)T * 2048;
  bf16_t* tt = (bf16_t*)p.big2();
  const float* vsq = p.vsq() + (long)j * T;
  for (int item = opaque_bid(); item < 96 * 8; item += gridDim.x) {
    const int g = item & 7, chunk = item >> 3;
    const float* ws = p.a_w_s + ((long)(j * 8 + g) * 128) * 128;
#pragma unroll 1
    for (int kt = 0; kt < 2; ++kt) {
      float rs[8];
      {
        const float4 q0 = *(const float4*)(vsq + chunk * 128 + kt * 64 + c * 8), q1 = *(const float4*)(vsq + chunk * 128 + kt * 64 + c * 8 + 4);
        rs[0] = rsqrtf(q0.x * (1.f / 2048.f) + 1e-6f); rs[1] = rsqrtf(q0.y * (1.f / 2048.f) + 1e-6f);
        rs[2] = rsqrtf(q0.z * (1.f / 2048.f) + 1e-6f); rs[3] = rsqrtf(q0.w * (1.f / 2048.f) + 1e-6f);
        rs[4] = rsqrtf(q1.x * (1.f / 2048.f) + 1e-6f); rs[5] = rsqrtf(q1.y * (1.f / 2048.f) + 1e-6f);
        rs[6] = rsqrtf(q1.z * (1.f / 2048.f) + 1e-6f); rs[7] = rsqrtf(q1.w * (1.f / 2048.f) + 1e-6f);
      }
#pragma unroll
      for (int i = 0; i < 2; ++i) {
        const int r = r0 + 64 * i;
        const float4 a = *(const float4*)(ws + r * 128 + kt * 64 + c * 8), b = *(const float4*)(ws + r * 128 + kt * 64 + c * 8 + 4);
        uint4 o;
        o.x = pk_bf16(a.x * rs[0], a.y * rs[1]); o.y = pk_bf16(a.z * rs[2], a.w * rs[3]);
        o.z = pk_bf16(b.x * rs[4], b.y * rs[5]); o.w = pk_bf16(b.z * rs[6], b.w * rs[7]);
        *(uint4*)(smem + kt * 16384 + tile_off(r, c)) = o;
      }
#pragma unroll
      for (int i = 0; i < 4; ++i) {
        const int r = r0 + 64 * i;
        const uint4 bv = *(const uint4*)(vT + (long)(g * 256 + r) * T + chunk * 128 + kt * 64 + c * 8);
        *(uint4*)(smem + 32768 + kt * 32768 + tile_off(r, c)) = bv;
      }
    }
    __syncthreads();
    f32x16 acc[2][2];
#pragma unroll
    for (int mb = 0; mb < 2; ++mb)
#pragma unroll
      for (int nb = 0; nb < 2; ++nb)
#pragma unroll
        for (int i = 0; i < 16; ++i) acc[mb][nb][i] = 0.f;
    compute_ktile<false>(smem + 32768, smem, acc, wm, wn, lane);
    compute_ktile<false>(smem + 65536, smem + 16384, acc, wm, wn, lane);
    __syncthreads();
    float* svt = (float*)smem;
#pragma unroll
    for (int nb = 0; nb < 2; ++nb) {
      const int tok = wn * 64 + nb * 32 + l31;
#pragma unroll
      for (int mb = 0; mb < 2; ++mb)
#pragma unroll
        for (int q = 0; q < 4; ++q)
          *(float4*)(svt + tok * 260 + wm * 64 + mb * 32 + 8 * q + 4 * hh) = make_float4(acc[mb][nb][4 * q], acc[mb][nb][4 * q + 1], acc[mb][nb][4 * q + 2], acc[mb][nb][4 * q + 3]);
    }
    __syncthreads();
    {
      const int ch8 = (tid & 31) * 8;
      const float4 gv0 = *(const float4*)(p.a_g_v + j * 2048 + g * 256 + ch8), gv1 = *(const float4*)(p.a_g_v + j * 2048 + g * 256 + ch8 + 4);
#pragma unroll
      for (int it = 0; it < 8; ++it) {
        const int tok = (tid >> 5) + 16 * it;
        const float bs = p.a_b_s[(j * 8 + g) * 128 + tok];
        const float4 s0 = *(const float4*)(svt + tok * 260 + ch8), s1 = *(const float4*)(svt + tok * 260 + ch8 + 4);
        const long ro = (long)(chunk * 128 + tok) * 2048 + g * 256 + ch8;
        const uint4 uu = *(const uint4*)(u + ro);
        uint4 o;
        o.x = pk_bf16(bflo(uu.x) * (gv0.x * s0.x + bs), bfhi(uu.x) * (gv0.y * s0.y + bs));
        o.y = pk_bf16(bflo(uu.y) * (gv0.z * s0.z + bs), bfhi(uu.y) * (gv0.w * s0.w + bs));
        o.z = pk_bf16(bflo(uu.z) * (gv1.x * s1.x + bs), bfhi(uu.z) * (gv1.y * s1.y + bs));
        o.w = pk_bf16(bflo(uu.w) * (gv1.z * s1.z + bs), bfhi(uu.w) * (gv1.w * s1.w + bs));
        *(uint4*)(tt + ro) = o;
      }
    }
    __syncthreads();
  }
}

__device__ __forceinline__ void attn_block_lds(const char* __restrict__ Ks, const char* __restrict__ Vs, bool masked, int kpos0, int qpos,
                                               const bf16x8 (&bq)[4], float& m, float& lsum, f32x16& o0, f32x16& o1, int l31, int hh) {
  f32x16 s[2];
#pragma unroll
  for (int sb = 0; sb < 2; ++sb) {
#pragma unroll
    for (int i = 0; i < 16; ++i) s[sb][i] = 0.f;
#pragma unroll
    for (int ks = 0; ks < 4; ++ks) {
      const bf16x8 a = *(const bf16x8*)(Ks + tile_off(sb * 32 + l31, ks * 2 + hh));
      s[sb] = __builtin_amdgcn_mfma_f32_32x32x16_bf16(a, bq[ks], s[sb], 0, 0, 0);
    }
  }
  if (masked) {
#pragma unroll
    for (int sb = 0; sb < 2; ++sb)
#pragma unroll
      for (int i = 0; i < 16; ++i) {
        int dlt = qpos - (kpos0 + sb * 32 + crow(i, hh));
        dlt = dlt < 0 ? -dlt : dlt;
        if (dlt > 128) s[sb][i] = -1e30f;
      }
  }
  float mx = s[0][0];
#pragma unroll
  for (int sb = 0; sb < 2; ++sb)
#pragma unroll
    for (int i = 0; i < 16; ++i) mx = fmaxf(mx, s[sb][i]);
  mx = fmaxf(mx, __shfl_xor(mx, 32));
  const float mnew = fmaxf(m, mx);
  const float alpha = __builtin_amdgcn_exp2f(m - mnew);
  m = mnew;
  float ps = 0.f;
#pragma unroll
  for (int sb = 0; sb < 2; ++sb)
#pragma unroll
    for (int i = 0; i < 16; ++i) { s[sb][i] = __builtin_amdgcn_exp2f(s[sb][i] - mnew); ps += s[sb][i]; }
  lsum = lsum * alpha + ps;
#pragma unroll
  for (int i = 0; i < 16; ++i) { o0[i] *= alpha; o1[i] *= alpha; }
  const int sw0 = (l31 >> 1) & 7;
#pragma unroll
  for (int sb = 0; sb < 2; ++sb)
#pragma unroll
    for (int st = 0; st < 2; ++st) {
      uint4 pw;
      pw.x = pk_bf16(s[sb][8 * st + 0], s[sb][8 * st + 1]); pw.y = pk_bf16(s[sb][8 * st + 2], s[sb][8 * st + 3]);
      pw.z = pk_bf16(s[sb][8 * st + 4], s[sb][8 * st + 5]); pw.w = pk_bf16(s[sb][8 * st + 6], s[sb][8 * st + 7]);
      const bf16x8 pb = __builtin_bit_cast(bf16x8, pw);
      const int c0 = 4 * sb + 2 * st;
      const char* v0 = Vs + l31 * 128 + 8 * hh;
      uint4 va;
      { const uint2 lo = *(const uint2*)(v0 + ((c0 ^ sw0) << 4)), hi = *(const uint2*)(v0 + (((c0 + 1) ^ sw0) << 4)); va.x = lo.x; va.y = lo.y; va.z = hi.x; va.w = hi.y; }
      o0 = __builtin_amdgcn_mfma_f32_32x32x16_bf16(__builtin_bit_cast(bf16x8, va), pb, o0, 0, 0, 0);
      { const uint2 lo = *(const uint2*)(v0 + 4096 + ((c0 ^ sw0) << 4)), hi = *(const uint2*)(v0 + 4096 + (((c0 + 1) ^ sw0) << 4)); va.x = lo.x; va.y = lo.y; va.z = hi.x; va.w = hi.y; }
      o1 = __builtin_amdgcn_mfma_f32_32x32x16_bf16(__builtin_bit_cast(bf16x8, va), pb, o1, 0, 0, 0);
    }
}

__device__ void phase_attn(const P& p, char* smem) {
  const int tid = opaque_tid(), lane = tid & 63, w = __builtin_amdgcn_readfirstlane(tid >> 6), l31 = lane & 31, hh = lane >> 5;
  const int kr = tid >> 3, kc = tid & 7;
  const bf16_t* qb = (const bf16_t*)p.big2();
  const bf16_t* kb = qb + (long)T * 1024;
  const bf16_t* vTa = kb + (long)T * 256;
  bf16_t* ob = (bf16_t*)(vTa + (long)256 * T);
  const int lo_off = tile_off(kr, kc);
  for (int item = opaque_bid(); item < 768; item += gridDim.x) {
    const bool lat = item >= 512;
    int tok0, head, qblk, b;
    if (!lat) { b = item >> 4; head = item & 15; qblk = 0; tok0 = b * 256; }
    else { const int it = item - 512; b = it >> 7; head = (it >> 3) & 15; qblk = it & 7; tok0 = TCTX + b * 2048; }
    const int kvh = head >> 2;
    const int qloc = qblk * 256 + w * 32;
    const long qrow = tok0 + qloc + l31;
    bf16x8 bq[4];
#pragma unroll
    for (int ks = 0; ks < 4; ++ks) bq[ks] = *(const bf16x8*)(qb + qrow * 1024 + head * 64 + ks * 16 + hh * 8);
    float m = p.c_sink[head] * LOG2E;
    float lsum = hh == 0 ? 1.f : 0.f;
    f32x16 o0, o1;
#pragma unroll
    for (int i = 0; i < 16; ++i) { o0[i] = 0.f; o1[i] = 0.f; }
    int wlo = 0, nwin = 4;
    if (lat) {
      wlo = qblk * 256 - 128; wlo = wlo < 0 ? 0 : wlo;
      int whi = qblk * 256 + 384; whi = whi > 2048 ? 2048 : whi;
      nwin = (whi - wlo) >> 6;
    }
    const int nblk = lat ? nwin + 4 : 4;
    const bf16_t* kwin = kb + (long)(tok0 + wlo + kr) * 256 + kvh * 64 + kc * 8;
    const bf16_t* vwin = vTa + (long)(kvh * 64 + kr) * T + tok0 + wlo + kc * 8;
    const bf16_t* kcach = p.ck() + (long)(b * 256 + kr) * 256 + kvh * 64 + kc * 8;
    const bf16_t* vcach = p.cvT() + (long)(b * 256 + kvh * 64 + kr) * 256 + kc * 8;
    uint4 rk, rv;
    rk = gld16(kwin); rv = gld16(vwin);
    asm volatile("s_waitcnt vmcnt(0)" ::: "memory");
    *(uint4*)(smem + lo_off) = rk; *(uint4*)(smem + 8192 + lo_off) = rv;
    __syncthreads();
    for (int bi = 0; bi < nblk; ++bi) {
      const bool more = bi + 1 < nblk;
      if (more) {
        const int nb = bi + 1;
        if (nb < nwin) { rk = gld16(kwin + (long)nb * 64 * 256); rv = gld16(vwin + nb * 64); }
        else { rk = gld16(kcach + (long)(nb - nwin) * 64 * 256); rv = gld16(vcach + (nb - nwin) * 64); }
      }
      const char* Ks = smem + (bi & 1) * 16384;
      if (bi < nwin) {
        const int k0 = wlo + 64 * bi;
        if (!lat) attn_block_lds(Ks, Ks + 8192, false, 0, 0, bq, m, lsum, o0, o1, l31, hh);
        else if (!(k0 + 63 < qloc - 128 || k0 > qloc + 31 + 128)) attn_block_lds(Ks, Ks + 8192, true, k0, qloc + l31, bq, m, lsum, o0, o1, l31, hh);
      } else {
        attn_block_lds(Ks, Ks + 8192, false, 0, 0, bq, m, lsum, o0, o1, l31, hh);
      }
      if (more) {
        asm volatile("s_waitcnt vmcnt(0)" ::: "memory");
        char* Kn = smem + ((bi + 1) & 1) * 16384;
        *(uint4*)(Kn + lo_off) = rk; *(uint4*)(Kn + 8192 + lo_off) = rv;
      }
      __syncthreads();
    }
    lsum += __shfl_xor(lsum, 32);
    const float inv = 1.f / lsum;
#pragma unroll
    for (int q = 0; q < 4; ++q) {
      uint2 v0, v1;
      v0.x = pk_bf16(o0[4 * q] * inv, o0[4 * q + 1] * inv); v0.y = pk_bf16(o0[4 * q + 2] * inv, o0[4 * q + 3] * inv);
      v1.x = pk_bf16(o1[4 * q] * inv, o1[4 * q + 1] * inv); v1.y = pk_bf16(o1[4 * q + 2] * inv, o1[4 * q + 3] * inv);
      *(uint2*)(ob + qrow * 1024 + head * 64 + 8 * q + 4 * hh) = v0;
      *(uint2*)(ob + qrow * 1024 + head * 64 + 32 + 8 * q + 4 * hh) = v1;
    }
  }
}

enum { OP_PREP, OP_FIRST, OP_NORM_MIX, OP_GMLP_IN, OP_SPATIAL, OP_GMLP_OUT, OP_FFN_IN, OP_FFN_FIX, OP_FFN_OUT, OP_POOL, OP_POOL_GEMM, OP_QKV, OP_QKPREP, OP_ATTN, OP_WO };
__constant__ unsigned char c_prog[NPH][2] = {
    {OP_PREP, 0}, {OP_FIRST, 0},
    {OP_GMLP_IN, 0}, {OP_SPATIAL, 0}, {OP_GMLP_OUT, 0}, {OP_FFN_IN, 0}, {OP_FFN_OUT, 0},
    {OP_POOL_GEMM, 1}, {OP_FFN_IN, 1}, {OP_FFN_OUT, 1},
    {OP_QKV, 2}, {OP_ATTN, 2}, {OP_WO, 2}, {OP_FFN_IN, 2}, {OP_FFN_OUT, 2},
    {OP_GMLP_IN, 3}, {OP_SPATIAL, 3}, {OP_GMLP_OUT, 3}, {OP_FFN_IN, 3}, {OP_FFN_OUT, 3}};

__device__ void run_phase(const P& p0, int ph, char* smem) {
  P p = p0;
  asm volatile("" : "+s"(p.ws), "+s"(p.out_g));
  const int op = c_prog[ph][0], layer = c_prog[ph][1];
  const int j = layer / 3;
  switch (op) {
    case OP_PREP: phase_prep(p, smem); break;
    case OP_FIRST: phase_norm(p, 0, 0, true); phase_shw(p, 0, 5632, 0, 0); break;
    case OP_NORM_MIX: phase_norm(p, layer, 0, false); break;
    case OP_GMLP_IN: {
      const int fx = layer == 0 ? -1 : 2 * layer;
      phase_gemm<G_GMLP_IN>(p, p.h(), 1024, p.wt_a_in() + (long)j * 4096 * 1024, 1024, 1024, 8, layer, j, fx, smem);
      phase_gemm<G_GMLP_V>(p, p.h(), 1024, p.wt_a_in() + (long)j * 4096 * 1024, 1024, 1024, 8, layer, j, fx, smem);
    } break;
    case OP_SPATIAL: phase_spatial(p, j, smem); break;
    case OP_GMLP_OUT: phase_gemm<G_RESID>(p, (const bf16_t*)p.big2(), 2048, p.wt_a_out() + (long)j * 1024 * 2048, 2048, 2048, 4, layer, 2048, 2 * layer + 1, smem); break;
    case OP_FFN_IN:
      phase_gemm<G_FFN_IN>(p, p.h(), 1024, p.wt_ffn_in() + (long)layer * 5632 * 1024, 1024, 1024, 22, layer, 0, 2 * layer + 1, smem);
      if (layer < 3) phase_filler(p, layer + 1, smem);
      break;
    case OP_FFN_OUT:
      phase_gemm<G_RESID>(p, (const bf16_t*)p.big2(), 2816, p.wt_ffn_out() + (long)layer * 1024 * 2816, 2816, 2816, 4, layer, 5120, layer <= 2 ? 2 * layer + 2 : -1, smem);
      if (layer == 0) phase_shw(p, 5632, 11264, 0, 0);
      else if (layer == 1) phase_shw(p, 11264, 16896, 22528, 24064);
      else if (layer == 2) phase_shw(p, 16896, 22528, 24064, 28160);
      break;
    case OP_POOL_GEMM: phase_gemm<G_POOL>(p, (const bf16_t*)p.big1(), 1024, p.wt_p(), 256, 256, 4, layer, 2048, 2 * layer + 1, smem); break;
    case OP_QKV:
      phase_gemm<G_QKV>(p, p.h(), 1024, p.wt_qkv(), 1024, 1024, 5, layer, 0, 2 * layer, smem);
      phase_gemm<G_QKV_V>(p, p.h(), 1024, p.wt_qkv(), 1024, 1024, 1, layer, 0, 2 * layer, smem);
      break;
    case OP_ATTN: phase_attn(p, smem); break;
    default: phase_gemm<G_RESID>(p, (const bf16_t*)p.big2() + (long)T * 1024 + (long)T * 256 + (long)256 * T, 1024, p.wt_o(), 1024, 1024, 4, layer, 2048, 2 * layer + 1, smem); break;
  }
}

#define XB_TMO      128
#define XB_XCNT(j)  (256  + 64 * (j))
#define XB_XSUB(j)  (1280 + 64 * (j))
#define XB_XGEN(j)  (2304 + 64 * (j))
#define XB_TOP      3328
#define XB_TOPGEN   3392
#define XCD_BAR_WORDS 3456
#define XB_SPIN_CAP (1u << 22)
#define LAS __attribute__((address_space(3)))
__device__ __forceinline__ unsigned xb_ld(unsigned* p) { return __hip_atomic_load(p, __ATOMIC_RELAXED, __HIP_MEMORY_SCOPE_AGENT); }
__device__ __forceinline__ unsigned xb_add(unsigned* p, unsigned v) { return __hip_atomic_fetch_add(p, v, __ATOMIC_RELAXED, __HIP_MEMORY_SCOPE_AGENT); }
__device__ __forceinline__ unsigned xb_xcc_id() { return (unsigned)__builtin_amdgcn_s_getreg((3 << 11) | 20) & 0xFu; }
#define XB_SPIN(cond, bar) do { unsigned _sp = 0; while (cond) { __builtin_amdgcn_s_sleep(1); \
    if ((++_sp & 255u) == 0u) { if (xb_ld(&(bar)[XB_TMO])) break; if (_sp > XB_SPIN_CAP) { atomicAdd(&(bar)[XB_TMO], 1u); break; } } } } while (0)
struct XcdBarrier { unsigned* bar; unsigned x; volatile LAS unsigned* st; };
__device__ __forceinline__ XcdBarrier xcd_barrier_post(unsigned* bar, volatile LAS unsigned* st) {
  XcdBarrier b; b.bar = bar; b.x = xb_xcc_id(); b.st = st;
  if (threadIdx.x == 0) (void)xb_add(&bar[XB_XCNT(b.x)], 1u);
  return b;
}
__device__ __forceinline__ void xcd_barrier_complete(unsigned* bar, unsigned x, unsigned& nloc, unsigned& nx) {
  const unsigned G = gridDim.x * gridDim.y * gridDim.z;
  unsigned sum, cnt, mine, sp = 0u;
  for (;;) {
    sum = 0u; cnt = 0u; mine = 0u;
#pragma unroll
    for (unsigned j = 0; j < 16; ++j) { const unsigned c = xb_ld(&bar[XB_XCNT(j)]); sum += c; cnt += (c > 0u) ? 1u : 0u; mine = (j == x) ? c : mine; }
    if (sum == G) break;
    __builtin_amdgcn_s_sleep(1);
    if ((++sp & 255u) == 0u) { if (xb_ld(&bar[XB_TMO])) break; if (sp > XB_SPIN_CAP) { atomicAdd(&bar[XB_TMO], 1u); break; } }
  }
  nloc = mine > 0u ? mine : 1u; nx = cnt > 0u ? cnt : 1u;
}
__device__ __forceinline__ void xcd_barrier(const XcdBarrier& b) {
  asm volatile("s_waitcnt vmcnt(0)" ::: "memory");
  __syncthreads();
  if (threadIdx.x == 0) {
    unsigned* bar = b.bar;
    __builtin_amdgcn_s_waitcnt(0);
    unsigned nloc = b.st[0], nx = b.st[1];
    if (nloc == 0u) { xcd_barrier_complete(bar, b.x, nloc, nx); b.st[0] = nloc; b.st[1] = nx; }
    const unsigned old = xb_add(&bar[XB_XSUB(b.x)], 1u);
    const unsigned gen = old / nloc;
    if (old + 1u == (gen + 1u) * nloc) {
      __builtin_amdgcn_fence(__ATOMIC_RELEASE, "agent");
      asm volatile("s_waitcnt vmcnt(0)" ::: "memory");
      const unsigned og = xb_add(&bar[XB_TOP], 1u);
      const unsigned tg = og / nx;
      if (og + 1u == (tg + 1u) * nx) xb_add(&bar[XB_TOPGEN], 1u);
      else XB_SPIN(xb_ld(&bar[XB_TOPGEN]) == tg, bar);
      __builtin_amdgcn_fence(__ATOMIC_ACQUIRE, "agent");
      xb_add(&bar[XB_XGEN(b.x)], 1u);
      asm volatile("s_waitcnt vmcnt(0)" ::: "memory");
    } else {
      XB_SPIN(xb_ld(&bar[XB_XGEN(b.x)]) == gen, bar);
      __builtin_amdgcn_fence(__ATOMIC_ACQUIRE, "agent");
      asm volatile("s_waitcnt vmcnt(0)" ::: "memory");
    }
  }
  __syncthreads();
}

__global__ void __launch_bounds__(512, 2) mega(P p, unsigned* bar, int lo, int hi) {
  __shared__ __attribute__((aligned(16))) char smem[131072 + 16 + 4096 + 8192 + 16];
  if (hi < 0) cg::this_grid().sync();
  volatile LAS unsigned* st = (volatile LAS unsigned*)(smem + 131072 + 16 + 4096 + 8192);
  if (threadIdx.x == 0) { st[0] = 0u; st[1] = 0u; }
  __syncthreads();
  XcdBarrier xb = xcd_barrier_post(bar, st);
  for (int ph = lo; ph < hi; ++ph) {
    if (ph > lo) xcd_barrier(xb);
    run_phase(p, ph, smem);
  }
}

extern "C" void kernel_launch(void* const* d_in, const int* in_sizes, int n_in, void* d_out, int out_size, void* d_ws, size_t ws_size, hipStream_t stream) {
  static int grid_blocks = 0;
  if (!grid_blocks) {
    int dev = 0, cus = 0, per_cu = 0;
    (void)hipGetDevice(&dev);
    (void)hipDeviceGetAttribute(&cus, hipDeviceAttributeMultiprocessorCount, dev);
    (void)hipOccupancyMaxActiveBlocksPerMultiprocessor(&per_cu, mega, 512, 0);
    if (per_cu > 1) per_cu = 1;
    if (per_cu < 1) per_cu = 1;
    grid_blocks = cus * per_cu;
  }
  P p{};
  const float* const* in = (const float* const*)d_in;
  p.x_prompt = in[0]; p.x_sample = in[1]; p.cache_k = in[2]; p.cache_v = in[3]; p.c = in[4]; p.c_ctx = in[5];
  p.w_ada = in[6]; p.b_ada = in[7]; p.g_mix = in[8]; p.g_ffn = in[9]; p.w_ffn_in = in[10]; p.ffn_conv_w = in[11]; p.ffn_conv_b = in[12]; p.w_ffn_out = in[13];
  p.a_w_in = in[14]; p.a_g_v = in[15]; p.a_w_s = in[16]; p.a_b_s = in[17]; p.a_w_out = in[18];
  p.p_w = in[19]; p.p_b = in[20]; p.p_scale = in[21];
  p.c_w_qkv = in[22]; p.c_g_q = in[23]; p.c_g_k = in[24]; p.c_sink = in[25]; p.c_w_o = in[26];
  p.out_g = (__attribute__((address_space(1))) float*)d_out;
  char* ws = (char*)d_ws;
  unsigned* bar = (unsigned*)ws;
  p.ws = (__attribute__((address_space(1))) char*)ws;
  if ((size_t)335869440ull > ws_size) { fprintf(stderr, "workspace too small: need %zu have %zu\n", (size_t)335869440ull, ws_size); return; }
#if ONE_LAUNCH
  int lo = 0, hi = NPH;
  (void)hipMemsetAsync(bar, 0, (size_t)XCD_BAR_WORDS * 4, stream);
  void* args[] = {&p, &bar, &lo, &hi};
  hipError_t e = hipLaunchCooperativeKernel((void*)mega, dim3(grid_blocks), dim3(512), args, 0, stream);
  if (e != hipSuccess) {
    fprintf(stderr, "cooperative launch failed: %s (grid %d); falling back to one launch per phase\n", hipGetErrorString(e), grid_blocks);
    (void)hipGetLastError();
    for (int ph = 0; ph < NPH; ++ph) mega<<<grid_blocks, 512, 0, stream>>>(p, bar, ph, ph + 1);
  }
#else
  for (int ph = 0; ph < NPH; ++ph) mega<<<grid_blocks, 512, 0, stream>>>(p, bar, ph, ph + 1);
#endif
}
```

```cpp
#include <hip/hip_runtime.h>
#include <hip/hip_cooperative_groups.h>
#include <cstdio>
#include <cstdint>
namespace cg = cooperative_groups;

#ifndef ONE_LAUNCH
#define ONE_LAUNCH 1
#endif

typedef unsigned short bf16_t;
typedef short bf16x8 __attribute__((ext_vector_type(8)));
typedef float f32x16 __attribute__((ext_vector_type(16)));
typedef __bf16 bf16x2_t __attribute__((ext_vector_type(2)));
typedef float f32x2_t __attribute__((ext_vector_type(2)));

constexpr int T = 12288;
constexpr int TCTX = 8192;
constexpr int NPH = 20;
constexpr float LOG2E = 1.4426950408889634f;

struct P {
  const float *x_prompt, *x_sample, *cache_k, *cache_v, *c, *c_ctx;
  const float *w_ada, *b_ada, *g_mix, *g_ffn, *w_ffn_in, *ffn_conv_w, *ffn_conv_b, *w_ffn_out;
  const float *a_w_in, *a_g_v, *a_w_s, *a_b_s, *a_w_out;
  const float *p_w, *p_b, *p_scale;
  const float *c_w_qkv, *c_g_q, *c_g_k, *c_sink, *c_w_o;
  __attribute__((address_space(1))) float* out_g;
  __device__ __forceinline__ float* xo() const { return (float*)out_g; }
  __attribute__((address_space(1))) char* ws;
  __device__ __forceinline__ float* mod() const { return (float*)(ws + 13824ull); }
  __device__ __forceinline__ float* vsq() const { return (float*)(ws + 308736ull); }
  __device__ __forceinline__ bf16_t* wt_ffn_in() const { return (bf16_t*)(ws + 407040ull); }
  __device__ __forceinline__ bf16_t* wt_ffn_out() const { return (bf16_t*)(ws + 46544384ull); }
  __device__ __forceinline__ bf16_t* wt_a_in() const { return (bf16_t*)(ws + 69613056ull); }
  __device__ __forceinline__ bf16_t* wt_a_out() const { return (bf16_t*)(ws + 86390272ull); }
  __device__ __forceinline__ bf16_t* wt_p() const { return (bf16_t*)(ws + 94778880ull); }
  __device__ __forceinline__ bf16_t* wt_qkv() const { return (bf16_t*)(ws + 95303168ull); }
  __device__ __forceinline__ bf16_t* wt_o() const { return (bf16_t*)(ws + 98448896ull); }
  __device__ __forceinline__ bf16_t* ck() const { return (bf16_t*)(ws + 100546048ull); }
  __device__ __forceinline__ bf16_t* cvT() const { return (bf16_t*)(ws + 100808192ull); }
  __device__ __forceinline__ bf16_t* h() const { return (bf16_t*)(ws + 101070336ull); }
  __device__ __forceinline__ char* big1() const { return (char*)(ws + 126236160ull); }
  __device__ __forceinline__ char* big2() const { return (char*)(ws + 264648192ull); }
  __device__ __forceinline__ float* ha() const { return (float*)(ws + 333854208ull); }
  __device__ __forceinline__ float* hu() const { return (float*)(ws + 334575104ull); }
  __device__ __forceinline__ float* rowsq() const { return (float*)(ws + 334935552ull); }
  __device__ __forceinline__ float* shw() const { return (float*)(ws + 335328768ull); }
};

__device__ __forceinline__ unsigned pk_bf16(float lo, float hi) {
  f32x2_t v = {lo, hi};
  bf16x2_t r = __builtin_convertvector(v, bf16x2_t);
  return __builtin_bit_cast(unsigned, r);
}
__device__ __forceinline__ bf16_t f2bf(float x) { return (bf16_t)(pk_bf16(x, 0.f) & 0xffffu); }
__device__ __forceinline__ float bf2f(bf16_t v) { return __uint_as_float(((unsigned)v) << 16); }
__device__ __forceinline__ float bflo(unsigned v) { return __uint_as_float(v << 16); }
__device__ __forceinline__ float bfhi(unsigned v) { return __uint_as_float(v & 0xffff0000u); }
__device__ __forceinline__ float gelu_f(float x) {
  const float t = __builtin_fmaf(x * x, -0.10294324284f, -2.3022081985f);
  const float e = __builtin_amdgcn_exp2f(x * t);
  return x * __builtin_amdgcn_rcpf(1.0f + e);
}
__device__ __forceinline__ float row_ror1(float v) { return __builtin_bit_cast(float, __builtin_amdgcn_update_dpp(0, __builtin_bit_cast(int, v), 0x121, 0xf, 0xf, true)); }
__device__ __forceinline__ float row_ror15(float v) { return __builtin_bit_cast(float, __builtin_amdgcn_update_dpp(0, __builtin_bit_cast(int, v), 0x12f, 0xf, 0xf, true)); }
__device__ __forceinline__ int opaque_tid() { int t = threadIdx.x; asm volatile("" : "+v"(t)); return t; }
__device__ __forceinline__ int opaque_bid() { int b = blockIdx.x; asm volatile("" : "+s"(b)); return b; }
__device__ __forceinline__ int cond_of_row(int row) { return row < 8192 ? 0 : (row < 10240 ? 1 : 2); }
__device__ __forceinline__ int crow(int i, int hh) { return (i & 3) + 8 * (i >> 2) + 4 * hh; }

__device__ __forceinline__ int tile_off(int r, int c) { return r * 128 + ((c ^ ((r >> 1) & 7)) << 4); }

__device__ __forceinline__ uint4 gld16(const void* p) {
  uint4 r;
  asm volatile("global_load_dwordx4 %0, %1, off" : "=v"(r) : "v"(p) : "memory");
  return r;
}

template <bool PAIRED>
__device__ __forceinline__ void compute_ktile(const char* sA, const char* sB, f32x16 (&acc)[2][2], int wm, int wn, int lane) {
  const int l31 = lane & 31, hh = lane >> 5;
#pragma unroll
  for (int ks = 0; ks < 4; ++ks) {
    bf16x8 a[2], b[2];
#pragma unroll
    for (int mb = 0; mb < 2; ++mb) { const int r = wm * 64 + mb * 32 + l31; a[mb] = *(const bf16x8*)(sA + tile_off(r, ks * 2 + hh)); }
#pragma unroll
    for (int nb = 0; nb < 2; ++nb) { const int r = (PAIRED ? nb * 64 + wn * 32 : wn * 64 + nb * 32) + l31; b[nb] = *(const bf16x8*)(sB + tile_off(r, ks * 2 + hh)); }
#pragma unroll
    for (int mb = 0; mb < 2; ++mb)
#pragma unroll
      for (int nb = 0; nb < 2; ++nb) acc[mb][nb] = __builtin_amdgcn_mfma_f32_32x32x16_bf16(a[mb], b[nb], acc[mb][nb], 0, 0, 0);
  }
}


typedef float f32x4 __attribute__((ext_vector_type(4)));
__device__ __forceinline__ int g8_lds_byte(int r, int c) {
  const int st = (r >> 4) * 2 + (c >> 5), rr = r & 15, cc = c & 31, ob = rr * 64 + cc * 2;
  return st * 1024 + (ob ^ (((ob >> 9) & 1) << 5));
}
__device__ __forceinline__ void g8_stage_rc(int b, int& R, int& C) {
  const int st = b / 1024, sb = b % 1024, swz = sb ^ (((sb >> 9) & 1) << 5);
  R = (st >> 1) * 16 + swz / 64; C = (st & 1) * 32 + (swz % 64) / 2;
}
template <bool TRANS, bool R192>
__device__ __forceinline__ void gemm256(const bf16_t* __restrict__ A0, const bf16_t* __restrict__ A1, int lda, const bf16_t* __restrict__ B0, const bf16_t* __restrict__ B1, int ldb,
                                        int nt, char* shm, f32x4 (&acc)[2][2][4][2], int tid, bool pre, bool has_next,
                                        const bf16_t* __restrict__ nA0, const bf16_t* __restrict__ nA1, const bf16_t* __restrict__ nB0, const bf16_t* __restrict__ nB1) {
#define G8LAS __attribute__((address_space(3)))
  constexpr int HTB = 16384;
  G8LAS unsigned char* lds = (G8LAS unsigned char*)shm;
  const int wid = __builtin_amdgcn_readfirstlane(tid >> 6), lane = tid & 63, wr = wid >> 2, wc = wid & 3, fr = lane & 15, fq = lane >> 4;
  unsigned voffA[2], voffB[2];
#pragma unroll
  for (int i = 0; i < 2; ++i) {
    int R, C;
    g8_stage_rc(tid * 16 + i * 8192, R, C);
    voffA[i] = (unsigned)(R * lda + C) * 2u; voffB[i] = (unsigned)(R * ldb + C) * 2u;
  }
  const unsigned ldsw = (unsigned)wid * 1024u;
  const int aoff = g8_lds_byte(wr * 64 + fr, fq * 8), boff = g8_lds_byte(wc * 32 + fr, fq * 8);
  const char* cA0 = (const char*)A0; const char* cA1 = (const char*)A1; const char* cB0 = (const char*)B0; const char* cB1 = (const char*)B1;
  const char* dA0 = (const char*)nA0; const char* dA1 = (const char*)nA1; const char* dB0 = (const char*)nB0; const char* dB1 = (const char*)nB1;
#define SA(b, h) (((b) * 2 + (h)) * HTB)
#define SB(b, h) ((4 + (b) * 2 + (h)) * HTB)
#define STAGE(bufoff, gbase, voff, kt)                                                                                 \
  {                                                                                                                    \
    const unsigned long long _b = (unsigned long long)(gbase) + (unsigned long long)(kt) * 128ull;                     \
    const unsigned _blo = __builtin_amdgcn_readfirstlane((unsigned)_b), _bhi = __builtin_amdgcn_readfirstlane((unsigned)(_b >> 32)); \
    const char* _sb = (const char*)(((unsigned long long)_bhi << 32) | (unsigned long long)_blo);                      \
    _Pragma("unroll") for (int _i = 0; _i < 2; ++_i)                                                                   \
        __builtin_amdgcn_global_load_lds((const unsigned*)(_sb + (voff)[_i]), (G8LAS unsigned*)(lds + (bufoff) + ldsw + _i * 8192), 16, 0, 0); \
  }
#define LDA(dst, b, h)                                                                                                 \
  _Pragma("unroll") for (int m = 0; m < 4; ++m) _Pragma("unroll") for (int k = 0; k < 2; ++k)                          \
      dst[m][k] = *(const G8LAS bf16x8*)(lds + SA(b, h) + aoff + m * 2048 + k * 1024)
#define LDB(dst, b, h)                                                                                                 \
  _Pragma("unroll") for (int n = 0; n < 2; ++n) _Pragma("unroll") for (int k = 0; k < 2; ++k)                          \
      dst[n][k] = *(const G8LAS bf16x8*)(lds + SB(b, h) + boff + n * 2048 + k * 1024)
#define MMA(ai, bj, At_, Bt_)                                                                                          \
  if (!(R192 && (ai) == 1) || wr == 0) {     \
    __builtin_amdgcn_s_setprio(1);                                                                                     \
    _Pragma("unroll") for (int m = 0; m < 4; ++m) _Pragma("unroll") for (int n = 0; n < 2; ++n) _Pragma("unroll") for (int k = 0; k < 2; ++k) \
        acc[ai][bj][m][n] = TRANS ? __builtin_amdgcn_mfma_f32_16x16x32_bf16(Bt_[n][k], At_[m][k], acc[ai][bj][m][n], 0, 0, 0)  \
                                  : __builtin_amdgcn_mfma_f32_16x16x32_bf16(At_[m][k], Bt_[n][k], acc[ai][bj][m][n], 0, 0, 0); \
    __builtin_amdgcn_s_setprio(0);                                                                                     \
  }
#define WAIT_V(n) asm volatile("s_waitcnt vmcnt(" #n ")" ::: "memory")
#define WAIT_L(n) asm volatile("s_waitcnt lgkmcnt(" #n ")" ::: "memory")
#define BAR __builtin_amdgcn_s_barrier()
#define SCHED __builtin_amdgcn_sched_barrier(0)
#pragma unroll
  for (int ai = 0; ai < 2; ++ai)
#pragma unroll
    for (int bj = 0; bj < 2; ++bj)
#pragma unroll
      for (int m = 0; m < 4; ++m)
#pragma unroll
        for (int n = 0; n < 2; ++n) acc[ai][bj][m][n] = (f32x4){0.f, 0.f, 0.f, 0.f};
  bf16x8 At[4][2], Bx0[2][2], Bx1[2][2];
  if (!pre) {
    STAGE(SB(0, 0), cB0, voffB, 0); STAGE(SA(0, 0), cA0, voffA, 0);
    STAGE(SB(0, 1), cB1, voffB, 0); STAGE(SA(0, 1), cA1, voffA, 0);
    if (wr == 1) BAR;
    WAIT_V(4); BAR;
    STAGE(SB(1, 0), cB0, voffB, 1); STAGE(SA(1, 0), cA0, voffA, 1); STAGE(SB(1, 1), cB1, voffB, 1);
    WAIT_V(6); BAR;
  } else {
    if (wr == 1) BAR;
    STAGE(SB(1, 1), cB1, voffB, 1);
    WAIT_V(2); BAR;
  }
  for (int t = 0; t < nt - 2; t += 2) {
    LDB(Bx0, 0, 0); SCHED; LDA(At, 0, 0); STAGE(SA(1, 1), cA1, voffA, t + 1);
    WAIT_L(8); BAR; WAIT_L(0); MMA(0, 0, At, Bx0); BAR; SCHED;
    LDB(Bx1, 0, 1); STAGE(SB(0, 0), cB0, voffB, t + 2);
    BAR; WAIT_L(0); MMA(0, 1, At, Bx1); BAR;
    LDA(At, 0, 1); STAGE(SA(0, 0), cA0, voffA, t + 2);
    BAR; WAIT_L(0); MMA(1, 0, At, Bx0); BAR; SCHED;
    STAGE(SB(0, 1), cB1, voffB, t + 2);
    WAIT_V(6); BAR; MMA(1, 1, At, Bx1); BAR;
    LDB(Bx0, 1, 0); SCHED; LDA(At, 1, 0); STAGE(SA(0, 1), cA1, voffA, t + 2);
    WAIT_L(8); BAR; WAIT_L(0); MMA(0, 0, At, Bx0); BAR; SCHED;
    LDB(Bx1, 1, 1); STAGE(SB(1, 0), cB0, voffB, t + 3);
    BAR; WAIT_L(0); MMA(0, 1, At, Bx1); BAR;
    LDA(At, 1, 1); STAGE(SA(1, 0), cA0, voffA, t + 3);
    BAR; WAIT_L(0); MMA(1, 0, At, Bx0); BAR; SCHED;
    STAGE(SB(1, 1), cB1, voffB, t + 3);
    WAIT_V(6); BAR; MMA(1, 1, At, Bx1); BAR;
  }
  {
    LDB(Bx0, 0, 0); LDA(At, 0, 0); STAGE(SA(1, 1), cA1, voffA, nt - 1);
    BAR; WAIT_L(0); MMA(0, 0, At, Bx0); BAR;
    LDB(Bx1, 0, 1); BAR; WAIT_L(0); MMA(0, 1, At, Bx1); BAR;
    LDA(At, 0, 1);
    if (has_next) { STAGE(SB(0, 0), dB0, voffB, 0); STAGE(SA(0, 0), dA0, voffA, 0); WAIT_V(8); } else { WAIT_V(4); }
    BAR; WAIT_L(0); MMA(1, 0, At, Bx0); MMA(1, 1, At, Bx1); BAR;
  }
  {
    LDB(Bx0, 1, 0); LDA(At, 1, 0);
    if (has_next) { STAGE(SB(0, 1), dB1, voffB, 0); WAIT_V(8); } else { WAIT_V(2); }
    BAR; WAIT_L(0); MMA(0, 0, At, Bx0); BAR;
    LDB(Bx1, 1, 1);
    if (has_next) { STAGE(SA(0, 1), dA1, voffA, 0); WAIT_V(8); } else { WAIT_V(0); }
    BAR; WAIT_L(0); MMA(0, 1, At, Bx1); BAR;
    LDA(At, 1, 1);
    if (has_next) { STAGE(SB(1, 0), dB0, voffB, 1); STAGE(SA(1, 0), dA0, voffA, 1); }
    BAR; WAIT_L(0); MMA(1, 0, At, Bx0); MMA(1, 1, At, Bx1); BAR;
  }
  if (wr == 0) BAR;
#undef SA
#undef SB
#undef STAGE
#undef LDA
#undef LDB
#undef MMA
#undef WAIT_V
#undef WAIT_L
#undef BAR
#undef SCHED
#undef G8LAS
}

#define TR_LOAD(SRC, NN, V0, V1, V2, V3, V4, V5, V6, V7)                                                     \
  {                                                                                                            \
    const float* _s = (SRC) + (long)(tid >> 5) * (NN) + (tid & 31) * 4;                                        \
    V0 = *(const float4*)(_s); V1 = *(const float4*)(_s + (long)16 * (NN)); V2 = *(const float4*)(_s + (long)32 * (NN)); V3 = *(const float4*)(_s + (long)48 * (NN)); \
    V4 = *(const float4*)(_s + (long)64 * (NN)); V5 = *(const float4*)(_s + (long)80 * (NN)); V6 = *(const float4*)(_s + (long)96 * (NN)); V7 = *(const float4*)(_s + (long)112 * (NN)); \
  }
__device__ __forceinline__ void tr_store(bf16_t* __restrict__ dst, int K, float4 v0, float4 v1, float4 v2, float4 v3, float4 v4, float4 v5, float4 v6, float4 v7, float* tile, int tid) {
  const float4 v[8] = {v0, v1, v2, v3, v4, v5, v6, v7};
#pragma unroll
  for (int i = 0; i < 8; ++i) *(float4*)(tile + ((tid >> 5) + 16 * i) * 132 + (tid & 31) * 4) = v[i];
  __syncthreads();
  const int nn = tid & 127, kg = tid >> 7;
  const float* col = tile + (kg * 32) * 132 + nn;
#pragma unroll
  for (int c = 0; c < 4; ++c) {
    uint4 o;
    o.x = pk_bf16(col[(c * 8 + 0) * 132], col[(c * 8 + 1) * 132]);
    o.y = pk_bf16(col[(c * 8 + 2) * 132], col[(c * 8 + 3) * 132]);
    o.z = pk_bf16(col[(c * 8 + 4) * 132], col[(c * 8 + 5) * 132]);
    o.w = pk_bf16(col[(c * 8 + 6) * 132], col[(c * 8 + 7) * 132]);
    *(uint4*)(dst + (long)nn * K + kg * 32 + c * 8) = o;
  }
  __syncthreads();
}

__device__ void ada_item(const P& p, int item, float* sm, int tid) {
  const int l = item / 48, chunk = item % 48;
  float* sc = sm;
  float* red = sm + 3072;
  for (int i = tid; i < 3072; i += 512) {
    const int cb = i >> 10, k = i & 1023;
    const float v = cb == 0 ? p.c_ctx[k] : p.c[(cb - 1) * 1024 + k];
    sc[i] = v / (1.f + __expf(-v));
  }
  __syncthreads();
  const int ng = tid & 31, kg = tid >> 5;
  const float* wp = p.w_ada + ((long)l * 1024 + kg * 64) * 6144 + chunk * 128 + ng * 4;
  float a0[4] = {0.f, 0.f, 0.f, 0.f}, a1[4] = {0.f, 0.f, 0.f, 0.f}, a2[4] = {0.f, 0.f, 0.f, 0.f};
#pragma unroll 8
  for (int k = 0; k < 64; ++k) {
    const float4 wv = *(const float4*)(wp + (long)k * 6144);
    const float s0 = sc[kg * 64 + k], s1 = sc[1024 + kg * 64 + k], s2 = sc[2048 + kg * 64 + k];
    a0[0] += s0 * wv.x; a0[1] += s0 * wv.y; a0[2] += s0 * wv.z; a0[3] += s0 * wv.w;
    a1[0] += s1 * wv.x; a1[1] += s1 * wv.y; a1[2] += s1 * wv.z; a1[3] += s1 * wv.w;
    a2[0] += s2 * wv.x; a2[1] += s2 * wv.y; a2[2] += s2 * wv.z; a2[3] += s2 * wv.w;
  }
#pragma unroll
  for (int j = 0; j < 4; ++j) {
    red[(kg * 3 + 0) * 128 + ng * 4 + j] = a0[j];
    red[(kg * 3 + 1) * 128 + ng * 4 + j] = a1[j];
    red[(kg * 3 + 2) * 128 + ng * 4 + j] = a2[j];
  }
  __syncthreads();
  if (tid < 384) {
    const int cb = tid >> 7, n = tid & 127;
    float s = p.b_ada[l * 6144 + chunk * 128 + n];
#pragma unroll
    for (int g = 0; g < 16; ++g) s += red[(g * 3 + cb) * 128 + n];
    p.mod()[((long)l * 3 + cb) * 6144 + chunk * 128 + n] = s;
  }
  __syncthreads();
}

__device__ __forceinline__ void tr_decode(const P& p, int t, const float*& osrc, bf16_t*& odst, int& oK, int& oN) {
  constexpr int t_ffn_in = 4 * 8 * 44, t_ffn_out = 4 * 22 * 8, t_a_in = 2 * 8 * 32, t_a_out = 2 * 16 * 8, t_p = 4 * 2 * 2, t_qkv = 8 * 12, t_o = 8 * 8;
  const float* src; bf16_t* dst; int K, N;
#define TR_OPAQUE asm volatile("" : "+s"(src), "+s"(dst));
  if (t < t_ffn_in) { src = p.w_ffn_in; dst = p.wt_ffn_in(); K = 1024; N = 5632; TR_OPAQUE }
  else if ((t -= t_ffn_in) < t_ffn_out) { src = p.w_ffn_out; dst = p.wt_ffn_out(); K = 2816; N = 1024; TR_OPAQUE }
  else if ((t -= t_ffn_out) < t_a_in) { src = p.a_w_in; dst = p.wt_a_in(); K = 1024; N = 4096; TR_OPAQUE }
  else if ((t -= t_a_in) < t_a_out) { src = p.a_w_out; dst = p.wt_a_out(); K = 2048; N = 1024; TR_OPAQUE }
  else if ((t -= t_a_out) < t_p) { src = p.p_w; dst = p.wt_p(); K = 256; N = 256; TR_OPAQUE }
  else if ((t -= t_p) < t_qkv) { src = p.c_w_qkv; dst = p.wt_qkv(); K = 1024; N = 1536; TR_OPAQUE }
  else if ((t -= t_qkv) < t_o) { src = p.c_w_o; dst = p.wt_o(); K = 1024; N = 1024; TR_OPAQUE }
  else { t -= t_o; src = p.cache_v; dst = p.cvT(); K = 256; N = 256; TR_OPAQUE }
  const int nkt = K >> 7, nnt = N >> 7, per = nkt * nnt;
  const int mat = t / per, r = t % per;
  const int nt = r % nnt, kt = r / nnt;
  osrc = src + (long)mat * K * N + (long)(kt * 128) * N + nt * 128;
  odst = dst + (long)mat * K * N + (long)(nt * 128) * K + kt * 128;
  oK = K; oN = N;
#undef TR_OPAQUE
}

__device__ __forceinline__ int tr_group_size(int g) { return g == 0 ? 920 : (g == 1 ? 544 : (g == 2 ? 688 : 912)); }
__device__ __forceinline__ int tr_group_map(int g, int i) {
  if (i < 352) return 352 * g + i;
  i -= 352;
  if (i < 176) return 1408 + 176 * g + i;
  i -= 176;
  if (g == 0) return i < 256 ? 2112 + i : (i < 384 ? 2624 + (i - 256) : 3056 + (i - 384));
  if (g == 1) return 2880 + i;
  if (g == 2) return i < 96 ? 2896 + i : 2992 + (i - 96);
  return i < 256 ? 2112 + 256 + i : 2624 + 128 + (i - 256);
}
__device__ void run_transposes(const P& p, int g, int first, int stride, float* sm, int tid) {
  const int n = tr_group_size(g);
  int t = first;
  if (t < n) {
    const float* csrc; bf16_t* cdst; int cK, cN;
    tr_decode(p, tr_group_map(g, t), csrc, cdst, cK, cN);
    float4 a0, a1, a2, a3, a4, a5, a6, a7;
    TR_LOAD(csrc, cN, a0, a1, a2, a3, a4, a5, a6, a7)
    while (true) {
      const int tn = t + stride;
      const bool more = tn < n;
      const float* nsrc; bf16_t* ndst; int nK, nN;
      tr_decode(p, tr_group_map(g, more ? tn : t), nsrc, ndst, nK, nN);
      float4 b0 = a0, b1 = a1, b2 = a2, b3 = a3, b4 = a4, b5 = a5, b6 = a6, b7 = a7;
      if (more) TR_LOAD(nsrc, nN, b0, b1, b2, b3, b4, b5, b6, b7)
      tr_store(cdst, cK, a0, a1, a2, a3, a4, a5, a6, a7, sm, tid);
      if (!more) break;
      a0 = b0; a1 = b1; a2 = b2; a3 = b3; a4 = b4; a5 = b5; a6 = b6; a7 = b7;
      cdst = ndst; cK = nK; t = tn;
    }
  }
}

__device__ void phase_prep(const P& p, char* smem) {
  float* sm = (float*)smem;
  const int tid = opaque_tid();
  constexpr int N_ADA = 192, N_CK = 32, N_Z = 6 + 24;
  constexpr int TR0 = N_ADA + N_CK + N_Z;
  for (int item = opaque_bid(); item < TR0; item += gridDim.x) {
    if (item < N_ADA) { ada_item(p, item, sm, tid); continue; }
    if (item < N_ADA + N_CK) {
      const int i0 = (item - N_ADA) * 4096 + tid * 8;
      const float4 a = *(const float4*)(p.cache_k + i0), b = *(const float4*)(p.cache_k + i0 + 4);
      uint4 o; o.x = pk_bf16(a.x, a.y); o.y = pk_bf16(a.z, a.w); o.z = pk_bf16(b.x, b.y); o.w = pk_bf16(b.z, b.w);
      *(uint4*)(p.ck() + i0) = o;
      continue;
    }
    const int zi = item - N_ADA - N_CK;
    float* zp = zi < 6 ? p.vsq() + zi * 4096 + tid * 8 : p.rowsq() + (zi - 6) * 4096 + tid * 8;
    *(float4*)(zp) = make_float4(0.f, 0.f, 0.f, 0.f);
    *(float4*)(zp + 4) = make_float4(0.f, 0.f, 0.f, 0.f);
  }
  run_transposes(p, 0, (int)(gridDim.x - 1 - opaque_bid()), (int)gridDim.x, sm, tid);
}

__device__ void phase_filler(const P& p, int g, char* smem) {
  const int bid = opaque_bid();
  if (bid < 32) return;
  const int tid = opaque_tid();
  const int fb = bid - 32, nf = (int)gridDim.x - 32;
  __syncthreads();
  run_transposes(p, g, nf - 1 - fb, nf, (float*)smem, tid);
}

__device__ void phase_norm(const P& p, int layer, int which, bool first) {
  const int tid = opaque_tid(), lane = tid & 63, w = tid >> 6;
  const float* g = (which ? p.g_ffn : p.g_mix) + layer * 1024;
  for (int item = opaque_bid(); item < T / 16; item += gridDim.x) {
    const int row0 = item * 16 + w * 2;
    float4 v[2][4];
    float ss[2] = {0.f, 0.f};
#pragma unroll
    for (int r = 0; r < 2; ++r) {
      const int row = row0 + r;
      const float* xr = first ? (row < TCTX ? p.x_prompt + (long)row * 1024 : p.x_sample + (long)(row - TCTX) * 1024) : p.xo() + (long)row * 1024;
#pragma unroll
      for (int i = 0; i < 4; ++i) {
        v[r][i] = *(const float4*)(xr + (i * 64 + lane) * 4);
        ss[r] += v[r][i].x * v[r][i].x + v[r][i].y * v[r][i].y + v[r][i].z * v[r][i].z + v[r][i].w * v[r][i].w;
      }
    }
#pragma unroll
    for (int o = 32; o; o >>= 1) { ss[0] += __shfl_xor(ss[0], o); ss[1] += __shfl_xor(ss[1], o); }
    const float* md = p.mod() + ((long)layer * 3 + cond_of_row(row0)) * 6144 + which * 3072;
#pragma unroll
    for (int i = 0; i < 4; ++i) {
      const int col = (i * 64 + lane) * 4;
      const float4 gg = *(const float4*)(g + col), sh = *(const float4*)(md + col), sc = *(const float4*)(md + 1024 + col);
#pragma unroll
      for (int r = 0; r < 2; ++r) {
        const float rstd = rsqrtf(ss[r] * (1.f / 1024.f) + 1e-6f);
        const float y0 = v[r][i].x * rstd * gg.x * (1.f + sc.x) + sh.x;
        const float y1 = v[r][i].y * rstd * gg.y * (1.f + sc.y) + sh.y;
        const float y2 = v[r][i].z * rstd * gg.z * (1.f + sc.z) + sh.z;
        const float y3 = v[r][i].w * rstd * gg.w * (1.f + sc.w) + sh.w;
        uint2 o; o.x = pk_bf16(y0, y1); o.y = pk_bf16(y2, y3);
        *(uint2*)(p.h() + (long)(row0 + r) * 1024 + col) = o;
        if (first) *(float4*)(p.xo() + (long)(row0 + r) * 1024 + col) = v[r][i];
      }
    }
  }
}

__device__ void phase_shw(const P& p, int ra0, int ra1, int rb0, int rb1) {
  const int tid = opaque_tid(), lane = tid & 63, w = tid >> 6;
  const int na = (ra1 - ra0) >> 6, nb = (rb1 - rb0) >> 6;
  for (int item = opaque_bid(); item < na + nb; item += gridDim.x) {
    int r = (item < na ? ra0 + item * 64 : rb0 + (item - na) * 64) + w * 8;
    int idx, n0; const bf16_t* wrow;
    if (r < 4 * 5632) { const int l = r / 5632; n0 = r - l * 5632; idx = 2 * l + 1; wrow = p.wt_ffn_in() + ((long)l * 5632 + n0) * 1024; }
    else if ((r -= 4 * 5632) < 1536) { n0 = r; idx = 4; wrow = p.wt_qkv() + (long)n0 * 1024; }
    else { n0 = r - 1536; idx = 6; wrow = p.wt_a_in() + ((long)4096 + n0) * 1024; }
    uint4 wv[8][2];
#pragma unroll
    for (int q = 0; q < 8; ++q) { wv[q][0] = *(const uint4*)(wrow + (long)q * 1024 + lane * 16); wv[q][1] = *(const uint4*)(wrow + (long)q * 1024 + lane * 16 + 8); }
    const float* shb = p.mod() + (long)(idx >> 1) * 3 * 6144 + ((idx & 1) ? 3072 : 0) + lane * 16;
    float sacc[8][3];
#pragma unroll
    for (int q = 0; q < 8; ++q) { sacc[q][0] = 0.f; sacc[q][1] = 0.f; sacc[q][2] = 0.f; }
#pragma unroll
    for (int cnd = 0; cnd < 3; ++cnd) {
      const float* sh = shb + cnd * 6144;
      const float4 s0 = *(const float4*)(sh), s1 = *(const float4*)(sh + 4), s2 = *(const float4*)(sh + 8), s3 = *(const float4*)(sh + 12);
#pragma unroll
      for (int q = 0; q < 8; ++q) {
        const uint4 a = wv[q][0], b = wv[q][1];
        sacc[q][cnd] = s0.x * bflo(a.x) + s0.y * bfhi(a.x) + s0.z * bflo(a.y) + s0.w * bfhi(a.y) + s1.x * bflo(a.z) + s1.y * bfhi(a.z) + s1.z * bflo(a.w) + s1.w * bfhi(a.w)
                     + s2.x * bflo(b.x) + s2.y * bfhi(b.x) + s2.z * bflo(b.y) + s2.w * bfhi(b.y) + s3.x * bflo(b.z) + s3.y * bfhi(b.z) + s3.z * bflo(b.w) + s3.w * bfhi(b.w);
      }
    }
#pragma unroll
    for (int o = 32; o; o >>= 1)
#pragma unroll
      for (int q = 0; q < 8; ++q) { sacc[q][0] += __shfl_xor(sacc[q][0], o); sacc[q][1] += __shfl_xor(sacc[q][1], o); sacc[q][2] += __shfl_xor(sacc[q][2], o); }
    if (lane < 24) {
      const int q = lane / 3, cnd = lane - q * 3;
      float v = 0.f;
#pragma unroll
      for (int qq = 0; qq < 8; ++qq)
#pragma unroll
        for (int cc = 0; cc < 3; ++cc) if (qq == q && cc == cnd) v = sacc[qq][cc];
      p.shw()[((long)idx * 3 + cnd) * 5632 + n0 + q] = v;
    }
  }
}

__device__ __forceinline__ void ffn_fix_rows(const P& p, int layer, int lo, int hi, int tid) {
  bf16_t* gbuf = (bf16_t*)p.big2();
  const float* cw = p.ffn_conv_w + (long)layer * 3 * 2816;
  const float* cb = p.ffn_conv_b + (long)layer * 2816;
  bool any = false;
  for (int q = 0; q < 32; ++q) {
    const int lt = q >> 1, e = q & 1;
    const int row = TCTX + lt * 256 + (e == 0 ? 0 : 255);
    if (row < lo || row >= hi) continue;
    if (e == 0 ? (lt & 7) == 0 : (lt & 7) == 7) continue;
    any = true;
    const float* ap = e == 0 ? p.ha() + (long)((lt - 1) * 4 + 3) * 2816 : p.ha() + (long)(lt * 4 + 2) * 2816;
    const float* ac = e == 0 ? p.ha() + (long)(lt * 4 + 0) * 2816 : p.ha() + (long)(lt * 4 + 3) * 2816;
    const float* an = e == 0 ? p.ha() + (long)(lt * 4 + 1) * 2816 : p.ha() + (long)((lt + 1) * 4 + 0) * 2816;
    const float* uu = p.hu() + (long)(lt * 2 + e) * 2816;
    for (int c = tid; c < 2816; c += 512) {
      const float x = cw[c] * ap[c] + cw[2816 + c] * ac[c] + cw[5632 + c] * an[c] + cb[c];
      gbuf[(long)row * 2816 + c] = f2bf(gelu_f(x) * uu[c]);
    }
  }
  if (any) { asm volatile("s_waitcnt vmcnt(0)" ::: "memory"); __syncthreads(); }
}

__device__ __forceinline__ void pool_tile(const P& p, int mt, int g, char* smem, int tid) {
  const int half = 1 << g;
  bf16_t* d = (bf16_t*)p.big1();
  const bf16_t* h = p.h();
  const int r0 = mt * 192;
  int lo0 = r0 - 8; lo0 = lo0 < 0 ? 0 : lo0;
  int hi0 = r0 + 192 + 7; hi0 = hi0 > T ? T : hi0;
  const int nch = (hi0 - lo0) * 32;
  const float* rq = p.rowsq() + (long)2 * T;
  for (int ci = tid; ci < nch; ci += 512) {
    const int row = lo0 + (ci >> 5), c8 = g * 256 + (ci & 31) * 8;
    const uint4 xv = *(const uint4*)(h + (long)row * 1024 + c8);
    const float r = rsqrtf(rq[row] * (1.f / 1024.f) + 1e-6f);
    const float* shp = p.mod() + ((long)1 * 3 + cond_of_row(row)) * 6144 + c8;
    const float4 s0 = *(const float4*)(shp), s1 = *(const float4*)(shp + 4);
    uint4 o;
    o.x = pk_bf16(r * bflo(xv.x) + s0.x, r * bfhi(xv.x) + s0.y); o.y = pk_bf16(r * bflo(xv.y) + s0.z, r * bfhi(xv.y) + s0.w);
    o.z = pk_bf16(r * bflo(xv.z) + s1.x, r * bfhi(xv.z) + s1.y); o.w = pk_bf16(r * bflo(xv.w) + s1.z, r * bfhi(xv.w) + s1.w);
    *(uint4*)(smem + ci * 16) = o;
  }
  __syncthreads();
  const int c4 = (tid & 63) * 4;
  for (int rr = tid >> 6; rr < 192; rr += 8) {
    const int row = r0 + rr;
    int s, S;
    if (row < TCTX) { s = row & 255; S = 256; } else { s = (row - TCTX) & 2047; S = 2048; }
    const int base = row - s;
    int lo = s - half; lo = lo < 0 ? 0 : lo;
    int hi = s + half - 1; hi = hi > S - 1 ? S - 1 : hi;
    float a0 = 0.f, a1 = 0.f, a2 = 0.f, a3 = 0.f;
    for (int q = lo; q <= hi; ++q) {
      const uint2 v = *(const uint2*)(smem + (base + q - lo0) * 512 + c4 * 2);
      a0 += bflo(v.x); a1 += bfhi(v.x); a2 += bflo(v.y); a3 += bfhi(v.y);
    }
    const float inv = 1.f / (float)(hi - lo + 1);
    const uint2 v = *(const uint2*)(smem + (row - lo0) * 512 + c4 * 2);
    uint2 o;
    o.x = pk_bf16(a0 * inv - bflo(v.x), a1 * inv - bfhi(v.x));
    o.y = pk_bf16(a2 * inv - bflo(v.y), a3 * inv - bfhi(v.y));
    *(uint2*)(d + (long)row * 1024 + g * 256 + c4) = o;
  }
  asm volatile("s_waitcnt vmcnt(0)" ::: "memory");
  __syncthreads();
}

enum { G_GMLP_IN = 0, G_RESID = 1, G_POOL = 2, G_QKV = 3, G_FFN_IN = 4, G_GMLP_V = 5, G_QKV_V = 6 };

template <int KIND>
__device__ void phase_gemm(const P& p, const bf16_t* __restrict__ A, int lda, const bf16_t* __restrict__ Bt, int ldb, int K, int ntn, int layer, int aux, int fx, char* smem) {
  constexpr bool R192 = (KIND == G_RESID || KIND == G_POOL);
  constexpr int MT = R192 ? 64 : 48, MROWS = R192 ? 192 : 256;
  constexpr int CHAIN_V = KIND == G_GMLP_IN ? 48 * 8 : (KIND == G_QKV ? 48 * 1 : 0);
  constexpr int CHAIN_VOFF = KIND == G_GMLP_IN ? 8 : 5;
  constexpr int PREV_CNT = KIND == G_GMLP_V ? 48 * 8 : (KIND == G_QKV_V ? 48 * 5 : 0);
  bool pre = PREV_CNT > 0 && opaque_bid() < PREV_CNT;
  for (int item = ((KIND == G_GMLP_V || KIND == G_QKV_V) ? (int)(gridDim.x - 1 - opaque_bid()) : opaque_bid()); item < MT * ntn; item += gridDim.x) {
    const int tid = opaque_tid();
    const int mt = item % MT, nt = item / MT + (KIND == G_GMLP_V ? 8 : (KIND == G_QKV_V ? 5 : 0));
    const bf16_t* At = A + (long)mt * MROWS * lda + (KIND == G_POOL ? nt * 256 : 0);
    const bf16_t* B0 = Bt + (long)nt * (KIND == G_FFN_IN ? 128 : 256) * ldb;
    const bf16_t* B1 = KIND == G_FFN_IN ? Bt + (long)(2816 + nt * 128) * ldb : B0 + (long)128 * ldb;
    const bool own_next = item + (int)gridDim.x < MT * ntn;
    const int vitem0 = (int)gridDim.x - 1 - opaque_bid();
    const bool chain = CHAIN_V > 0 && !own_next && vitem0 < CHAIN_V;
    const bool has_next = own_next || chain;
    const int nitem = own_next ? item + (int)gridDim.x : (chain ? vitem0 : item);
    const int nmt = nitem % MT, nnt = nitem / MT + (chain ? CHAIN_VOFF : (KIND == G_GMLP_V ? 8 : (KIND == G_QKV_V ? 5 : 0)));
    const bf16_t* nAt = A + (long)nmt * MROWS * lda + (KIND == G_POOL ? nnt * 256 : 0);
    const bf16_t* nB0 = Bt + (long)nnt * (KIND == G_FFN_IN ? 128 : 256) * ldb;
    const bf16_t* nB1 = KIND == G_FFN_IN ? Bt + (long)(2816 + nnt * 128) * ldb : nB0 + (long)128 * ldb;
    const bool was_pre = pre;
    pre = has_next;
    if constexpr (KIND == G_RESID) { if (aux == 5120) ffn_fix_rows(p, layer, mt * MROWS, mt * MROWS + MROWS, tid); }
    if constexpr (KIND == G_POOL) pool_tile(p, mt, nt, smem, tid);
    f32x4 acc[2][2][4][2];
#define EPI_IDS()                                                                                                     \
    const int te = opaque_tid(), lane = te & 63, wid = __builtin_amdgcn_readfirstlane(te >> 6), wr = wid >> 2, wc = wid & 3, fr = lane & 15, fq = lane >> 4; \
    const int rb = mt * MROWS + wr * 64, cb = nt * 256 + wc * 32;
    if constexpr (KIND == G_GMLP_V || KIND == G_QKV_V) {
      gemm256<false, false>(At, At + (long)128 * lda, lda, B0, B1, ldb, K >> 6, smem, acc, tid, was_pre, has_next, nAt, nAt + (long)128 * lda, nB0, nB1);
      EPI_IDS()
      const unsigned lo = (unsigned)(fr * T + fq * 4);
      if (fx >= 0) {
        const float* rq = p.rowsq() + (long)fx * T + rb + fq * 4;
        const float* sw = p.shw() + ((long)fx * 3 + cond_of_row(mt * 256)) * 5632 + cb + fr;
#pragma unroll
        for (int ai = 0; ai < 2; ++ai)
#pragma unroll
          for (int m = 0; m < 4; ++m) {
            const float4 q = *(const float4*)(rq + ai * 128 + m * 16);
            const float r0 = rsqrtf(q.x * (1.f / 1024.f) + 1e-6f), r1 = rsqrtf(q.y * (1.f / 1024.f) + 1e-6f), r2 = rsqrtf(q.z * (1.f / 1024.f) + 1e-6f), r3 = rsqrtf(q.w * (1.f / 1024.f) + 1e-6f);
#pragma unroll
            for (int bj = 0; bj < 2; ++bj)
#pragma unroll
              for (int n = 0; n < 2; ++n) {
                const float sv = sw[bj * 128 + n * 16];
                f32x4 v = acc[ai][bj][m][n];
                v[0] = r0 * v[0] + sv; v[1] = r1 * v[1] + sv; v[2] = r2 * v[2] + sv; v[3] = r3 * v[3] + sv;
                acc[ai][bj][m][n] = v;
              }
          }
      }
      if constexpr (KIND == G_QKV_V) {
        bf16_t* vTa = (bf16_t*)p.big2() + (long)T * 1024 + (long)T * 256;
        float* outv = p.xo() + (long)T * 1024 + (long)TCTX * 256;
#pragma unroll
        for (int ai = 0; ai < 2; ++ai)
#pragma unroll
          for (int m = 0; m < 4; ++m)
#pragma unroll
            for (int bj = 0; bj < 2; ++bj)
#pragma unroll
              for (int n = 0; n < 2; ++n) {
                const int c0 = wc * 32 + bj * 128 + n * 16, r0 = rb + ai * 128 + m * 16;
                const f32x4 v = acc[ai][bj][m][n];
                uint2 o; o.x = pk_bf16(v[0], v[1]); o.y = pk_bf16(v[2], v[3]);
                *(uint2*)(vTa + (long)c0 * T + r0 + lo) = o;
                if (mt < 32) {
                  float* ov = outv + (long)(r0 + fq * 4) * 256 + c0 + fr;
                  ov[0] = v[0]; ov[256] = v[1]; ov[512] = v[2]; ov[768] = v[3];
                }
                if (bj == 1 && n == 1) asm volatile("" ::: "memory");
              }
      } else {
      bf16_t* vT = (bf16_t*)p.big1() + (long)T * 2048;
      float* vsq = p.vsq() + (long)aux * T;
#pragma unroll
      for (int ai = 0; ai < 2; ++ai)
#pragma unroll
        for (int m = 0; m < 4; ++m) {
          float sq[4] = {0.f, 0.f, 0.f, 0.f};
#pragma unroll
          for (int bj = 0; bj < 2; ++bj)
#pragma unroll
            for (int n = 0; n < 2; ++n) {
              float z0 = gelu_f(acc[ai][bj][m][n][0]), z1 = gelu_f(acc[ai][bj][m][n][1]), z2 = gelu_f(acc[ai][bj][m][n][2]), z3 = gelu_f(acc[ai][bj][m][n][3]);
              sq[0] += z0 * z0; sq[1] += z1 * z1; sq[2] += z2 * z2; sq[3] += z3 * z3;
              uint2 o; o.x = pk_bf16(z0, z1); o.y = pk_bf16(z2, z3);
              bf16_t* sb = vT + (long)(cb - 2048 + bj * 128 + n * 16) * T + rb + ai * 128 + m * 16;
              *(uint2*)(sb + lo) = o;
            }
#pragma unroll
          for (int j = 0; j < 4; ++j) {
            float s = sq[j];
            s += __shfl_xor(s, 1); s += __shfl_xor(s, 2); s += __shfl_xor(s, 4); s += __shfl_xor(s, 8);
            if (fr == 0) atomicAdd(vsq + rb + ai * 128 + m * 16 + fq * 4 + j, s);
          }
          asm volatile("" ::: "memory");
        }
      }
    } else {
    gemm256<true, R192>(At, At + (long)128 * lda, lda, B0, B1, ldb, K >> 6, smem, acc, tid, was_pre, has_next, nAt, nAt + (long)128 * lda, nB0, nB1);
    EPI_IDS()
    if constexpr (KIND == G_GMLP_IN || KIND == G_QKV || KIND == G_FFN_IN) {
      if (fx >= 0) {
        const float* rq = p.rowsq() + (long)fx * T + rb + fr;
        const float* sw = p.shw() + ((long)fx * 3 + cond_of_row(mt * 256)) * 5632 + (KIND == G_FFN_IN ? nt * 128 + wc * 32 : cb) + fq * 4;
        float rr[2][4];
#pragma unroll
        for (int ai = 0; ai < 2; ++ai)
#pragma unroll
          for (int m = 0; m < 4; ++m) rr[ai][m] = rsqrtf(rq[ai * 128 + m * 16] * (1.f / 1024.f) + 1e-6f);
#pragma unroll
        for (int bj = 0; bj < 2; ++bj)
#pragma unroll
          for (int n = 0; n < 2; ++n) {
            const float4 sv = *(const float4*)(sw + (KIND == G_FFN_IN ? bj * 2816 : bj * 128) + n * 16);
#pragma unroll
            for (int ai = 0; ai < 2; ++ai)
#pragma unroll
              for (int m = 0; m < 4; ++m) {
                f32x4 v = acc[ai][bj][m][n];
                const float r = rr[ai][m];
                v[0] = r * v[0] + sv.x; v[1] = r * v[1] + sv.y; v[2] = r * v[2] + sv.z; v[3] = r * v[3] + sv.w;
                acc[ai][bj][m][n] = v;
              }
          }
      }
    }
    if constexpr (KIND == G_RESID || KIND == G_POOL) {
      const unsigned lo = (unsigned)(fr * 1024 + fq * 4);
      const bool fz = fx >= 0;
      const float* gvec = ((fx & 1) ? p.g_ffn : p.g_mix) + (fx >> 1) * 1024;
      const int nai = wr == 0 ? 2 : 1;
      const unsigned voffx = lo * 4u;
      float4 gvq[4];
#pragma unroll
      for (int q = 0; q < 4; ++q) gvq[q] = fz ? *(const float4*)(gvec + cb + fq * 4 + (q >> 1) * 128 + (q & 1) * 16) : make_float4(0.f, 0.f, 0.f, 0.f);
#pragma unroll
      for (int ai = 0; ai < 2; ++ai) {
        if (ai < nai) {
          f32x4 xr[4][4];
#pragma unroll
          for (int m = 0; m < 4; ++m)
#pragma unroll
            for (int q = 0; q < 4; ++q) {
              const float* bp = p.xo() + (long)(rb + ai * 128 + m * 16) * 1024 + cb + (q >> 1) * 128 + (q & 1) * 16;
              asm volatile("global_load_dwordx4 %0, %1, %2" : "=v"(xr[m][q]) : "v"(voffx), "s"(bp) : "memory");
            }
          asm volatile("s_waitcnt vmcnt(0)" ::: "memory");
#pragma unroll
          for (int m = 0; m < 4; ++m) {
            const int row = rb + ai * 128 + m * 16 + fr;
            const int cnd = cond_of_row(rb + ai * 128 + m * 16);
            const float* gate = p.mod() + ((long)layer * 3 + cnd) * 6144 + aux + cb + fq * 4;
            const float* scv = p.mod() + ((long)(fx >> 1) * 3 + cnd) * 6144 + ((fx & 1) ? 4096 : 1024) + cb + fq * 4;
            float rsum = 0.f;
#pragma unroll
            for (int bj = 0; bj < 2; ++bj)
#pragma unroll
              for (int n = 0; n < 2; ++n) {
                const int co = bj * 128 + n * 16;
                const float4 g = *(const float4*)(gate + co);
                float4 pb = make_float4(0.f, 0.f, 0.f, 0.f), ps = make_float4(1.f, 1.f, 1.f, 1.f);
                if constexpr (KIND == G_POOL) { pb = *(const float4*)(p.p_b + cb + fq * 4 + co); ps = *(const float4*)(p.p_scale + cb + fq * 4 + co); }
                const long eo = (long)(rb + ai * 128 + m * 16) * 1024 + cb + co;
                float4* xp = (float4*)(p.xo() + eo + lo);
                const f32x4 xl = xr[m][bj * 2 + n];
                float4 x = make_float4(xl[0], xl[1], xl[2], xl[3]);
                const f32x4 v = acc[ai][bj][m][n];
                x.x += g.x * ((v[0] + pb.x) * ps.x); x.y += g.y * ((v[1] + pb.y) * ps.y);
                x.z += g.z * ((v[2] + pb.z) * ps.z); x.w += g.w * ((v[3] + pb.w) * ps.w);
                *xp = x;
                if (fz) {
                  const float4 gv = gvq[bj * 2 + n], sc = *(const float4*)(scv + co);
                  rsum += x.x * x.x + x.y * x.y + x.z * x.z + x.w * x.w;
                  uint2 o; o.x = pk_bf16(x.x * gv.x * (1.f + sc.x), x.y * gv.y * (1.f + sc.y)); o.y = pk_bf16(x.z * gv.z * (1.f + sc.z), x.w * gv.w * (1.f + sc.w));
                  *(uint2*)(p.h() + eo + lo) = o;
                }
              }
            if (fz) {
              rsum += __shfl_xor(rsum, 16); rsum += __shfl_xor(rsum, 32);
              if (fq == 0) atomicAdd(p.rowsq() + (long)fx * T + row, rsum);
            }
            asm volatile("" ::: "memory");
          }
        }
      }
    } else if constexpr (KIND == G_GMLP_IN) {
      bf16_t* u = (bf16_t*)p.big1();
      const unsigned lo = (unsigned)(fr * 2048 + fq * 4);
#pragma unroll
      for (int ai = 0; ai < 2; ++ai)
#pragma unroll
        for (int m = 0; m < 4; ++m)
#pragma unroll
          for (int bj = 0; bj < 2; ++bj)
#pragma unroll
            for (int n = 0; n < 2; ++n) {
              bf16_t* sb = u + (long)(rb + ai * 128 + m * 16) * 2048 + cb + bj * 128 + n * 16;
              const f32x4 v = acc[ai][bj][m][n];
              uint2 o; o.x = pk_bf16(gelu_f(v[0]), gelu_f(v[1])); o.y = pk_bf16(gelu_f(v[2]), gelu_f(v[3]));
              *(uint2*)(sb + lo) = o;
              if (bj == 1 && n == 1) asm volatile("" ::: "memory");
            }
    } else if constexpr (KIND == G_QKV) {
      float* part = (float*)(smem + 131072 + 16 + 4096);
      float rinv[2][2][4];
#pragma unroll
      for (int ai = 0; ai < 2; ++ai)
#pragma unroll
        for (int bj = 0; bj < 2; ++bj)
#pragma unroll
          for (int m = 0; m < 4; ++m) {
            const f32x4 a = acc[ai][bj][m][0], b = acc[ai][bj][m][1];
            float sq = a[0] * a[0] + a[1] * a[1] + a[2] * a[2] + a[3] * a[3] + b[0] * b[0] + b[1] * b[1] + b[2] * b[2] + b[3] * b[3];
            sq += __shfl_xor(sq, 16); sq += __shfl_xor(sq, 32);
            rinv[ai][bj][m] = sq;
            if (fq == 0) part[((wid * 2 + ai) * 2 + bj) * 64 + m * 16 + fr] = sq;
          }
      __syncthreads();
      {
        const int pw = wid ^ 1;
#pragma unroll
        for (int ai = 0; ai < 2; ++ai)
#pragma unroll
          for (int bj = 0; bj < 2; ++bj)
#pragma unroll
            for (int m = 0; m < 4; ++m)
              rinv[ai][bj][m] = rsqrtf((rinv[ai][bj][m] + part[((pw * 2 + ai) * 2 + bj) * 64 + m * 16 + fr]) * (1.f / 64.f) + 1e-6f);
      }
      const bool latt = mt >= 32;
      const float* gam = (nt < 4 ? p.c_g_q : p.c_g_k) + (wc & 1) * 32 + fq * 4;
      const float4 g0 = *(const float4*)(gam), g1 = *(const float4*)(gam + 16);
      float finv[4];
#pragma unroll
      for (int j = 0; j < 4; ++j) finv[j] = exp2f(-(float)(fq * 4 + j) * 0.8304820237218406f);
      bf16_t* qb = (bf16_t*)p.big2();
      bf16_t* kb = qb + (long)T * 1024;
      float* outk = p.xo() + (long)T * 1024;
      const float qs = nt < 4 ? 0.125f * LOG2E : 1.f;
#pragma unroll
      for (int ai = 0; ai < 2; ++ai)
#pragma unroll
        for (int m = 0; m < 4; ++m) {
          const int R = rb + ai * 128 + m * 16 + fr;
          float cs[4] = {1.f, 1.f, 1.f, 1.f}, sn[4] = {0.f, 0.f, 0.f, 0.f};
          if (latt) {
            const int sp = (R - TCTX) & 2047;
            const float pos = (float)((wc & 1) ? (sp & 63) : (sp >> 6));
#pragma unroll
            for (int j = 0; j < 4; ++j) { const float ang = pos * finv[j]; cs[j] = __cosf(ang); sn[j] = __sinf(ang); }
          }
#pragma unroll
          for (int bj = 0; bj < 2; ++bj) {
            const float r = rinv[ai][bj][m];
            const f32x4 av = acc[ai][bj][m][0], bv = acc[ai][bj][m][1];
            float a[4] = {av[0] * r * g0.x, av[1] * r * g0.y, av[2] * r * g0.z, av[3] * r * g0.w};
            float b[4] = {bv[0] * r * g1.x, bv[1] * r * g1.y, bv[2] * r * g1.z, bv[3] * r * g1.w};
#pragma unroll
            for (int j = 0; j < 4; ++j) { const float na = a[j] * cs[j] - b[j] * sn[j], nb = a[j] * sn[j] + b[j] * cs[j]; a[j] = na; b[j] = nb; }
            const int cl = bj * 128 + wc * 32 + fq * 4;
            uint2 oa, ob2;
            oa.x = pk_bf16(a[0] * qs, a[1] * qs); oa.y = pk_bf16(a[2] * qs, a[3] * qs);
            ob2.x = pk_bf16(b[0] * qs, b[1] * qs); ob2.y = pk_bf16(b[2] * qs, b[3] * qs);
            if (nt < 4) {
              bf16_t* dst = qb + (long)R * 1024 + nt * 256 + cl;
              *(uint2*)dst = oa; *(uint2*)(dst + 16) = ob2;
            } else {
              bf16_t* dst = kb + (long)R * 256 + cl;
              *(uint2*)dst = oa; *(uint2*)(dst + 16) = ob2;
              if (!latt) {
                float* od = outk + (long)R * 256 + cl;
                *(float4*)od = make_float4(a[0], a[1], a[2], a[3]); *(float4*)(od + 16) = make_float4(b[0], b[1], b[2], b[3]);
              }
            }
          }
          asm volatile("" ::: "memory");
        }
    } else {
      float* edge = (float*)(smem + 131072 + 16);
      const int ecol = wc * 32 + fq * 4;
      if (fr == 0 || fr == 15) {
#pragma unroll
        for (int ai = 0; ai < 2; ++ai)
#pragma unroll
          for (int n = 0; n < 2; ++n) {
            const f32x4 v = fr == 0 ? acc[ai][0][0][n] : acc[ai][0][3][n];
            *(float4*)(edge + ((ai * 2 + wr) * 2 + (fr == 0 ? 0 : 1)) * 128 + ecol + n * 16) = make_float4(v[0], v[1], v[2], v[3]);
          }
      }
      if (mt >= 32) {
        const int lt = mt - 32;
        if (wid < 4 && fr < 2) {
#pragma unroll
          for (int n = 0; n < 2; ++n) {
            const f32x4 v = acc[0][0][0][n];
            *(float4*)(p.ha() + ((long)(lt * 4 + fr)) * 2816 + nt * 128 + ecol + n * 16) = make_float4(v[0], v[1], v[2], v[3]);
            if (fr == 0) { const f32x4 uv = acc[0][1][0][n]; *(float4*)(p.hu() + ((long)(lt * 2 + 0)) * 2816 + nt * 128 + ecol + n * 16) = make_float4(uv[0], uv[1], uv[2], uv[3]); }
          }
        }
        if (wid >= 4 && fr >= 14) {
#pragma unroll
          for (int n = 0; n < 2; ++n) {
            const f32x4 v = acc[1][0][3][n];
            *(float4*)(p.ha() + ((long)(lt * 4 + 2 + (fr - 14))) * 2816 + nt * 128 + ecol + n * 16) = make_float4(v[0], v[1], v[2], v[3]);
            if (fr == 15) { const f32x4 uv = acc[1][1][3][n]; *(float4*)(p.hu() + ((long)(lt * 2 + 1)) * 2816 + nt * 128 + ecol + n * 16) = make_float4(uv[0], uv[1], uv[2], uv[3]); }
          }
        }
      }
      __syncthreads();
      bf16_t* gbuf = (bf16_t*)p.big2();
      const float* cwp = p.ffn_conv_w + (long)layer * 3 * 2816 + nt * 128 + ecol;
      const float* cbp = p.ffn_conv_b + (long)layer * 2816 + nt * 128 + ecol;
      const unsigned lo = (unsigned)(fr * 2816 + fq * 4);
#pragma unroll
      for (int n = 0; n < 2; ++n) {
        const float4 w0 = *(const float4*)(cwp + n * 16), w1 = *(const float4*)(cwp + 2816 + n * 16), w2 = *(const float4*)(cwp + 5632 + n * 16), bb = *(const float4*)(cbp + n * 16);
        const float w0a[4] = {w0.x, w0.y, w0.z, w0.w}, w1a[4] = {w1.x, w1.y, w1.z, w1.w}, w2a[4] = {w2.x, w2.y, w2.z, w2.w}, bba[4] = {bb.x, bb.y, bb.z, bb.w};
#pragma unroll
        for (int ai = 0; ai < 2; ++ai) {
          float4 ep = make_float4(0.f, 0.f, 0.f, 0.f), en = make_float4(0.f, 0.f, 0.f, 0.f);
          if (wr == 1) ep = *(const float4*)(edge + ((ai * 2 + 0) * 2 + 1) * 128 + ecol + n * 16);
          else if (ai == 1) ep = *(const float4*)(edge + ((0 * 2 + 1) * 2 + 1) * 128 + ecol + n * 16);
          if (wr == 0) en = *(const float4*)(edge + ((ai * 2 + 1) * 2 + 0) * 128 + ecol + n * 16);
          else if (ai == 0) en = *(const float4*)(edge + ((1 * 2 + 0) * 2 + 0) * 128 + ecol + n * 16);
          const float epa[4] = {ep.x, ep.y, ep.z, ep.w}, ena[4] = {en.x, en.y, en.z, en.w};
          float gq[4][4];
#pragma unroll
          for (int j = 0; j < 4; ++j) {
            float U[4], Dn[4];
#pragma unroll
            for (int m = 0; m < 4; ++m) { U[m] = row_ror1(acc[ai][0][m][n][j]); Dn[m] = row_ror15(acc[ai][0][m][n][j]); }
#pragma unroll
            for (int m = 0; m < 4; ++m) {
              const float prev = fr == 0 ? (m > 0 ? U[m > 0 ? m - 1 : 0] : epa[j]) : U[m];
              const float next = fr == 15 ? (m < 3 ? Dn[m < 3 ? m + 1 : 3] : ena[j]) : Dn[m];
              const float x = w0a[j] * prev + w1a[j] * acc[ai][0][m][n][j] + w2a[j] * next + bba[j];
              gq[m][j] = gelu_f(x) * acc[ai][1][m][n][j];
            }
          }
#pragma unroll
          for (int m = 0; m < 4; ++m) {
            bf16_t* sb = gbuf + (long)(rb + ai * 128 + m * 16) * 2816 + nt * 128 + wc * 32 + n * 16;
            uint2 o; o.x = pk_bf16(gq[m][0], gq[m][1]); o.y = pk_bf16(gq[m][2], gq[m][3]);
            *(uint2*)(sb + lo) = o;
          }
        }
      }
    }
    }
  }
}

__device__ void phase_spatial(const P& p, int j, char* smem) {
  const int tid = opaque_tid(), lane = tid & 63, w = __builtin_amdgcn_readfirstlane(tid >> 6), wm = w >> 1, wn = w & 1, l31 = lane & 31, hh = lane >> 5;
  const int c = tid & 7, r0 = tid >> 3;
  const bf16_t* u = (const bf16_t*)p.big1();
  const bf16_t* vT = u + (long)T * 2048;
  bf16_t* tt = (bf16_t*)p.big2();
  const float* vsq = p.vsq() + (long)j * T;
  for (int item = opaque_bid(); item < 96 * 8; item += gridDim.x) {
    const int g = item & 7, chunk = item >> 3;
    const float* ws = p.a_w_s + ((long)(j * 8 + g) * 128) * 128;
#pragma unroll 1
    for (int kt = 0; kt < 2; ++kt) {
      float rs[8];
      {
        const float4 q0 = *(const float4*)(vsq + chunk * 128 + kt * 64 + c * 8), q1 = *(const float4*)(vsq + chunk * 128 + kt * 64 + c * 8 + 4);
        rs[0] = rsqrtf(q0.x * (1.f / 2048.f) + 1e-6f); rs[1] = rsqrtf(q0.y * (1.f / 2048.f) + 1e-6f);
        rs[2] = rsqrtf(q0.z * (1.f / 2048.f) + 1e-6f); rs[3] = rsqrtf(q0.w * (1.f / 2048.f) + 1e-6f);
        rs[4] = rsqrtf(q1.x * (1.f / 2048.f) + 1e-6f); rs[5] = rsqrtf(q1.y * (1.f / 2048.f) + 1e-6f);
        rs[6] = rsqrtf(q1.z * (1.f / 2048.f) + 1e-6f); rs[7] = rsqrtf(q1.w * (1.f / 2048.f) + 1e-6f);
      }
#pragma unroll
      for (int i = 0; i < 2; ++i) {
        const int r = r0 + 64 * i;
        const float4 a = *(const float4*)(ws + r * 128 + kt * 64 + c * 8), b = *(const float4*)(ws + r * 128 + kt * 64 + c * 8 + 4);
        uint4 o;
        o.x = pk_bf16(a.x * rs[0], a.y * rs[1]); o.y = pk_bf16(a.z * rs[2], a.w * rs[3]);
        o.z = pk_bf16(b.x * rs[4], b.y * rs[5]); o.w = pk_bf16(b.z * rs[6], b.w * rs[7]);
        *(uint4*)(smem + kt * 16384 + tile_off(r, c)) = o;
      }
#pragma unroll
      for (int i = 0; i < 4; ++i) {
        const int r = r0 + 64 * i;
        const uint4 bv = *(const uint4*)(vT + (long)(g * 256 + r) * T + chunk * 128 + kt * 64 + c * 8);
        *(uint4*)(smem + 32768 + kt * 32768 + tile_off(r, c)) = bv;
      }
    }
    __syncthreads();
    f32x16 acc[2][2];
#pragma unroll
    for (int mb = 0; mb < 2; ++mb)
#pragma unroll
      for (int nb = 0; nb < 2; ++nb)
#pragma unroll
        for (int i = 0; i < 16; ++i) acc[mb][nb][i] = 0.f;
    compute_ktile<false>(smem + 32768, smem, acc, wm, wn, lane);
    compute_ktile<false>(smem + 65536, smem + 16384, acc, wm, wn, lane);
    __syncthreads();
    float* svt = (float*)smem;
#pragma unroll
    for (int nb = 0; nb < 2; ++nb) {
      const int tok = wn * 64 + nb * 32 + l31;
#pragma unroll
      for (int mb = 0; mb < 2; ++mb)
#pragma unroll
        for (int q = 0; q < 4; ++q)
          *(float4*)(svt + tok * 260 + wm * 64 + mb * 32 + 8 * q + 4 * hh) = make_float4(acc[mb][nb][4 * q], acc[mb][nb][4 * q + 1], acc[mb][nb][4 * q + 2], acc[mb][nb][4 * q + 3]);
    }
    __syncthreads();
    {
      const int ch8 = (tid & 31) * 8;
      const float4 gv0 = *(const float4*)(p.a_g_v + j * 2048 + g * 256 + ch8), gv1 = *(const float4*)(p.a_g_v + j * 2048 + g * 256 + ch8 + 4);
#pragma unroll
      for (int it = 0; it < 8; ++it) {
        const int tok = (tid >> 5) + 16 * it;
        const float bs = p.a_b_s[(j * 8 + g) * 128 + tok];
        const float4 s0 = *(const float4*)(svt + tok * 260 + ch8), s1 = *(const float4*)(svt + tok * 260 + ch8 + 4);
        const long ro = (long)(chunk * 128 + tok) * 2048 + g * 256 + ch8;
        const uint4 uu = *(const uint4*)(u + ro);
        uint4 o;
        o.x = pk_bf16(bflo(uu.x) * (gv0.x * s0.x + bs), bfhi(uu.x) * (gv0.y * s0.y + bs));
        o.y = pk_bf16(bflo(uu.y) * (gv0.z * s0.z + bs), bfhi(uu.y) * (gv0.w * s0.w + bs));
        o.z = pk_bf16(bflo(uu.z) * (gv1.x * s1.x + bs), bfhi(uu.z) * (gv1.y * s1.y + bs));
        o.w = pk_bf16(bflo(uu.w) * (gv1.z * s1.z + bs), bfhi(uu.w) * (gv1.w * s1.w + bs));
        *(uint4*)(tt + ro) = o;
      }
    }
    __syncthreads();
  }
}

__device__ __forceinline__ void attn_block_lds(const char* __restrict__ Ks, const char* __restrict__ Vs, bool masked, int kpos0, int qpos,
                                               const bf16x8 (&bq)[4], float& m, float& lsum, f32x16& o0, f32x16& o1, int l31, int hh) {
  f32x16 s[2];
#pragma unroll
  for (int sb = 0; sb < 2; ++sb) {
#pragma unroll
    for (int i = 0; i < 16; ++i) s[sb][i] = 0.f;
#pragma unroll
    for (int ks = 0; ks < 4; ++ks) {
      const bf16x8 a = *(const bf16x8*)(Ks + tile_off(sb * 32 + l31, ks * 2 + hh));
      s[sb] = __builtin_amdgcn_mfma_f32_32x32x16_bf16(a, bq[ks], s[sb], 0, 0, 0);
    }
  }
  if (masked) {
#pragma unroll
    for (int sb = 0; sb < 2; ++sb)
#pragma unroll
      for (int i = 0; i < 16; ++i) {
        int dlt = qpos - (kpos0 + sb * 32 + crow(i, hh));
        dlt = dlt < 0 ? -dlt : dlt;
        if (dlt > 128) s[sb][i] = -1e30f;
      }
  }
  float mx = s[0][0];
#pragma unroll
  for (int sb = 0; sb < 2; ++sb)
#pragma unroll
    for (int i = 0; i < 16; ++i) mx = fmaxf(mx, s[sb][i]);
  mx = fmaxf(mx, __shfl_xor(mx, 32));
  const float mnew = fmaxf(m, mx);
  const float alpha = __builtin_amdgcn_exp2f(m - mnew);
  m = mnew;
  float ps = 0.f;
#pragma unroll
  for (int sb = 0; sb < 2; ++sb)
#pragma unroll
    for (int i = 0; i < 16; ++i) { s[sb][i] = __builtin_amdgcn_exp2f(s[sb][i] - mnew); ps += s[sb][i]; }
  lsum = lsum * alpha + ps;
#pragma unroll
  for (int i = 0; i < 16; ++i) { o0[i] *= alpha; o1[i] *= alpha; }
  const int sw0 = (l31 >> 1) & 7;
#pragma unroll
  for (int sb = 0; sb < 2; ++sb)
#pragma unroll
    for (int st = 0; st < 2; ++st) {
      uint4 pw;
      pw.x = pk_bf16(s[sb][8 * st + 0], s[sb][8 * st + 1]); pw.y = pk_bf16(s[sb][8 * st + 2], s[sb][8 * st + 3]);
      pw.z = pk_bf16(s[sb][8 * st + 4], s[sb][8 * st + 5]); pw.w = pk_bf16(s[sb][8 * st + 6], s[sb][8 * st + 7]);
      const bf16x8 pb = __builtin_bit_cast(bf16x8, pw);
      const int c0 = 4 * sb + 2 * st;
      const char* v0 = Vs + l31 * 128 + 8 * hh;
      uint4 va;
      { const uint2 lo = *(const uint2*)(v0 + ((c0 ^ sw0) << 4)), hi = *(const uint2*)(v0 + (((c0 + 1) ^ sw0) << 4)); va.x = lo.x; va.y = lo.y; va.z = hi.x; va.w = hi.y; }
      o0 = __builtin_amdgcn_mfma_f32_32x32x16_bf16(__builtin_bit_cast(bf16x8, va), pb, o0, 0, 0, 0);
      { const uint2 lo = *(const uint2*)(v0 + 4096 + ((c0 ^ sw0) << 4)), hi = *(const uint2*)(v0 + 4096 + (((c0 + 1) ^ sw0) << 4)); va.x = lo.x; va.y = lo.y; va.z = hi.x; va.w = hi.y; }
      o1 = __builtin_amdgcn_mfma_f32_32x32x16_bf16(__builtin_bit_cast(bf16x8, va), pb, o1, 0, 0, 0);
    }
}

__device__ void phase_attn(const P& p, char* smem) {
  const int tid = opaque_tid(), lane = tid & 63, w = __builtin_amdgcn_readfirstlane(tid >> 6), l31 = lane & 31, hh = lane >> 5;
  const int kr = tid >> 3, kc = tid & 7;
  const bf16_t* qb = (const bf16_t*)p.big2();
  const bf16_t* kb = qb + (long)T * 1024;
  const bf16_t* vTa = kb + (long)T * 256;
  bf16_t* ob = (bf16_t*)(vTa + (long)256 * T);
  const int lo_off = tile_off(kr, kc);
  for (int item = opaque_bid(); item < 768; item += gridDim.x) {
    const bool lat = item >= 512;
    int tok0, head, qblk, b;
    if (!lat) { b = item >> 4; head = item & 15; qblk = 0; tok0 = b * 256; }
    else { const int it = item - 512; b = it >> 7; head = (it >> 3) & 15; qblk = it & 7; tok0 = TCTX + b * 2048; }
    const int kvh = head >> 2;
    const int qloc = qblk * 256 + w * 32;
    const long qrow = tok0 + qloc + l31;
    bf16x8 bq[4];
#pragma unroll
    for (int ks = 0; ks < 4; ++ks) bq[ks] = *(const bf16x8*)(qb + qrow * 1024 + head * 64 + ks * 16 + hh * 8);
    float m = p.c_sink[head] * LOG2E;
    float lsum = hh == 0 ? 1.f : 0.f;
    f32x16 o0, o1;
#pragma unroll
    for (int i = 0; i < 16; ++i) { o0[i] = 0.f; o1[i] = 0.f; }
    int wlo = 0, nwin = 4;
    if (lat) {
      wlo = qblk * 256 - 128; wlo = wlo < 0 ? 0 : wlo;
      int whi = qblk * 256 + 384; whi = whi > 2048 ? 2048 : whi;
      nwin = (whi - wlo) >> 6;
    }
    const int nblk = lat ? nwin + 4 : 4;
    const bf16_t* kwin = kb + (long)(tok0 + wlo + kr) * 256 + kvh * 64 + kc * 8;
    const bf16_t* vwin = vTa + (long)(kvh * 64 + kr) * T + tok0 + wlo + kc * 8;
    const bf16_t* kcach = p.ck() + (long)(b * 256 + kr) * 256 + kvh * 64 + kc * 8;
    const bf16_t* vcach = p.cvT() + (long)(b * 256 + kvh * 64 + kr) * 256 + kc * 8;
    uint4 rk, rv;
    rk = gld16(kwin); rv = gld16(vwin);
    asm volatile("s_waitcnt vmcnt(0)" ::: "memory");
    *(uint4*)(smem + lo_off) = rk; *(uint4*)(smem + 8192 + lo_off) = rv;
    __syncthreads();
    for (int bi = 0; bi < nblk; ++bi) {
      const bool more = bi + 1 < nblk;
      if (more) {
        const int nb = bi + 1;
        if (nb < nwin) { rk = gld16(kwin + (long)nb * 64 * 256); rv = gld16(vwin + nb * 64); }
        else { rk = gld16(kcach + (long)(nb - nwin) * 64 * 256); rv = gld16(vcach + (nb - nwin) * 64); }
      }
      const char* Ks = smem + (bi & 1) * 16384;
      if (bi < nwin) {
        const int k0 = wlo + 64 * bi;
        if (!lat) attn_block_lds(Ks, Ks + 8192, false, 0, 0, bq, m, lsum, o0, o1, l31, hh);
        else if (!(k0 + 63 < qloc - 128 || k0 > qloc + 31 + 128)) attn_block_lds(Ks, Ks + 8192, true, k0, qloc + l31, bq, m, lsum, o0, o1, l31, hh);
      } else {
        attn_block_lds(Ks, Ks + 8192, false, 0, 0, bq, m, lsum, o0, o1, l31, hh);
      }
      if (more) {
        asm volatile("s_waitcnt vmcnt(0)" ::: "memory");
        char* Kn = smem + ((bi + 1) & 1) * 16384;
        *(uint4*)(Kn + lo_off) = rk; *(uint4*)(Kn + 8192 + lo_off) = rv;
      }
      __syncthreads();
    }
    lsum += __shfl_xor(lsum, 32);
    const float inv = 1.f / lsum;
#pragma unroll
    for (int q = 0; q < 4; ++q) {
      uint2 v0, v1;
      v0.x = pk_bf16(o0[4 * q] * inv, o0[4 * q + 1] * inv); v0.y = pk_bf16(o0[4 * q + 2] * inv, o0[4 * q + 3] * inv);
      v1.x = pk_bf16(o1[4 * q] * inv, o1[4 * q + 1] * inv); v1.y = pk_bf16(o1[4 * q + 2] * inv, o1[4 * q + 3] * inv);
      *(uint2*)(ob + qrow * 1024 + head * 64 + 8 * q + 4 * hh) = v0;
      *(uint2*)(ob + qrow * 1024 + head * 64 + 32 + 8 * q + 4 * hh) = v1;
    }
  }
}

enum { OP_PREP, OP_FIRST, OP_NORM_MIX, OP_GMLP_IN, OP_SPATIAL, OP_GMLP_OUT, OP_FFN_IN, OP_FFN_FIX, OP_FFN_OUT, OP_POOL, OP_POOL_GEMM, OP_QKV, OP_QKPREP, OP_ATTN, OP_WO };
__constant__ unsigned char c_prog[NPH][2] = {
    {OP_PREP, 0}, {OP_FIRST, 0},
    {OP_GMLP_IN, 0}, {OP_SPATIAL, 0}, {OP_GMLP_OUT, 0}, {OP_FFN_IN, 0}, {OP_FFN_OUT, 0},
    {OP_POOL_GEMM, 1}, {OP_FFN_IN, 1}, {OP_FFN_OUT, 1},
    {OP_QKV, 2}, {OP_ATTN, 2}, {OP_WO, 2}, {OP_FFN_IN, 2}, {OP_FFN_OUT, 2},
    {OP_GMLP_IN, 3}, {OP_SPATIAL, 3}, {OP_GMLP_OUT, 3}, {OP_FFN_IN, 3}, {OP_FFN_OUT, 3}};

__device__ void run_phase(const P& p0, int ph, char* smem) {
  P p = p0;
  asm volatile("" : "+s"(p.ws), "+s"(p.out_g));
  const int op = c_prog[ph][0], layer = c_prog[ph][1];
  const int j = layer / 3;
  switch (op) {
    case OP_PREP: phase_prep(p, smem); break;
    case OP_FIRST: phase_norm(p, 0, 0, true); phase_shw(p, 0, 5632, 0, 0); break;
    case OP_NORM_MIX: phase_norm(p, layer, 0, false); break;
    case OP_GMLP_IN: {
      const int fx = layer == 0 ? -1 : 2 * layer;
      phase_gemm<G_GMLP_IN>(p, p.h(), 1024, p.wt_a_in() + (long)j * 4096 * 1024, 1024, 1024, 8, layer, j, fx, smem);
      phase_gemm<G_GMLP_V>(p, p.h(), 1024, p.wt_a_in() + (long)j * 4096 * 1024, 1024, 1024, 8, layer, j, fx, smem);
    } break;
    case OP_SPATIAL: phase_spatial(p, j, smem); break;
    case OP_GMLP_OUT: phase_gemm<G_RESID>(p, (const bf16_t*)p.big2(), 2048, p.wt_a_out() + (long)j * 1024 * 2048, 2048, 2048, 4, layer, 2048, 2 * layer + 1, smem); break;
    case OP_FFN_IN:
      phase_gemm<G_FFN_IN>(p, p.h(), 1024, p.wt_ffn_in() + (long)layer * 5632 * 1024, 1024, 1024, 22, layer, 0, 2 * layer + 1, smem);
      if (layer < 3) phase_filler(p, layer + 1, smem);
      break;
    case OP_FFN_OUT:
      phase_gemm<G_RESID>(p, (const bf16_t*)p.big2(), 2816, p.wt_ffn_out() + (long)layer * 1024 * 2816, 2816, 2816, 4, layer, 5120, layer <= 2 ? 2 * layer + 2 : -1, smem);
      if (layer == 0) phase_shw(p, 5632, 11264, 0, 0);
      else if (layer == 1) phase_shw(p, 11264, 16896, 22528, 24064);
      else if (layer == 2) phase_shw(p, 16896, 22528, 24064, 28160);
      break;
    case OP_POOL_GEMM: phase_gemm<G_POOL>(p, (const bf16_t*)p.big1(), 1024, p.wt_p(), 256, 256, 4, layer, 2048, 2 * layer + 1, smem); break;
    case OP_QKV:
      phase_gemm<G_QKV>(p, p.h(), 1024, p.wt_qkv(), 1024, 1024, 5, layer, 0, 2 * layer, smem);
      phase_gemm<G_QKV_V>(p, p.h(), 1024, p.wt_qkv(), 1024, 1024, 1, layer, 0, 2 * layer, smem);
      break;
    case OP_ATTN: phase_attn(p, smem); break;
    default: phase_gemm<G_RESID>(p, (const bf16_t*)p.big2() + (long)T * 1024 + (long)T * 256 + (long)256 * T, 1024, p.wt_o(), 1024, 1024, 4, layer, 2048, 2 * layer + 1, smem); break;
  }
}

#define XB_TMO      128
#define XB_XCNT(j)  (256  + 64 * (j))
#define XB_XSUB(j)  (1280 + 64 * (j))
#define XB_XGEN(j)  (2304 + 64 * (j))
#define XB_TOP      3328
#define XB_TOPGEN   3392
#define XCD_BAR_WORDS 3456
#define XB_SPIN_CAP (1u << 22)
#define LAS __attribute__((address_space(3)))
__device__ __forceinline__ unsigned xb_ld(unsigned* p) { return __hip_atomic_load(p, __ATOMIC_RELAXED, __HIP_MEMORY_SCOPE_AGENT); }
__device__ __forceinline__ unsigned xb_add(unsigned* p, unsigned v) { return __hip_atomic_fetch_add(p, v, __ATOMIC_RELAXED, __HIP_MEMORY_SCOPE_AGENT); }
__device__ __forceinline__ unsigned xb_xcc_id() { return (unsigned)__builtin_amdgcn_s_getreg((3 << 11) | 20) & 0xFu; }
#define XB_SPIN(cond, bar) do { unsigned _sp = 0; while (cond) { __builtin_amdgcn_s_sleep(1); \
    if ((++_sp & 255u) == 0u) { if (xb_ld(&(bar)[XB_TMO])) break; if (_sp > XB_SPIN_CAP) { atomicAdd(&(bar)[XB_TMO], 1u); break; } } } } while (0)
struct XcdBarrier { unsigned* bar; unsigned x; volatile LAS unsigned* st; };
__device__ __forceinline__ XcdBarrier xcd_barrier_post(unsigned* bar, volatile LAS unsigned* st) {
  XcdBarrier b; b.bar = bar; b.x = xb_xcc_id(); b.st = st;
  if (threadIdx.x == 0) (void)xb_add(&bar[XB_XCNT(b.x)], 1u);
  return b;
}
__device__ __forceinline__ void xcd_barrier_complete(unsigned* bar, unsigned x, unsigned& nloc, unsigned& nx) {
  const unsigned G = gridDim.x * gridDim.y * gridDim.z;
  unsigned sum, cnt, mine, sp = 0u;
  for (;;) {
    sum = 0u; cnt = 0u; mine = 0u;
#pragma unroll
    for (unsigned j = 0; j < 16; ++j) { const unsigned c = xb_ld(&bar[XB_XCNT(j)]); sum += c; cnt += (c > 0u) ? 1u : 0u; mine = (j == x) ? c : mine; }
    if (sum == G) break;
    __builtin_amdgcn_s_sleep(1);
    if ((++sp & 255u) == 0u) { if (xb_ld(&bar[XB_TMO])) break; if (sp > XB_SPIN_CAP) { atomicAdd(&bar[XB_TMO], 1u); break; } }
  }
  nloc = mine > 0u ? mine : 1u; nx = cnt > 0u ? cnt : 1u;
}
__device__ __forceinline__ void xcd_barrier(const XcdBarrier& b) {
  asm volatile("s_waitcnt vmcnt(0)" ::: "memory");
  __syncthreads();
  if (threadIdx.x == 0) {
    unsigned* bar = b.bar;
    __builtin_amdgcn_s_waitcnt(0);
    unsigned nloc = b.st[0], nx = b.st[1];
    if (nloc == 0u) { xcd_barrier_complete(bar, b.x, nloc, nx); b.st[0] = nloc; b.st[1] = nx; }
    const unsigned old = xb_add(&bar[XB_XSUB(b.x)], 1u);
    const unsigned gen = old / nloc;
    if (old + 1u == (gen + 1u) * nloc) {
      __builtin_amdgcn_fence(__ATOMIC_RELEASE, "agent");
      asm volatile("s_waitcnt vmcnt(0)" ::: "memory");
      const unsigned og = xb_add(&bar[XB_TOP], 1u);
      const unsigned tg = og / nx;
      if (og + 1u == (tg + 1u) * nx) xb_add(&bar[XB_TOPGEN], 1u);
      else XB_SPIN(xb_ld(&bar[XB_TOPGEN]) == tg, bar);
      __builtin_amdgcn_fence(__ATOMIC_ACQUIRE, "agent");
      xb_add(&bar[XB_XGEN(b.x)], 1u);
      asm volatile("s_waitcnt vmcnt(0)" ::: "memory");
    } else {
      XB_SPIN(xb_ld(&bar[XB_XGEN(b.x)]) == gen, bar);
      __builtin_amdgcn_fence(__ATOMIC_ACQUIRE, "agent");
      asm volatile("s_waitcnt vmcnt(0)" ::: "memory");
    }
  }
  __syncthreads();
}

__global__ void __launch_bounds__(512, 2) mega(P p, unsigned* bar, int lo, int hi) {
  __shared__ __attribute__((aligned(16))) char smem[131072 + 16 + 4096 + 8192 + 16];
  if (hi < 0) cg::this_grid().sync();
  volatile LAS unsigned* st = (volatile LAS unsigned*)(smem + 131072 + 16 + 4096 + 8192);
  if (threadIdx.x == 0) { st[0] = 0u; st[1] = 0u; }
  __syncthreads();
  XcdBarrier xb = xcd_barrier_post(bar, st);
  for (int ph = lo; ph < hi; ++ph) {
    if (ph > lo) xcd_barrier(xb);
    run_phase(p, ph, smem);
  }
}

extern "C" void kernel_launch(void* const* d_in, const int* in_sizes, int n_in, void* d_out, int out_size, void* d_ws, size_t ws_size, hipStream_t stream) {
  static int grid_blocks = 0;
  if (!grid_blocks) {
    int dev = 0, cus = 0, per_cu = 0;
    (void)hipGetDevice(&dev);
    (void)hipDeviceGetAttribute(&cus, hipDeviceAttributeMultiprocessorCount, dev);
    (void)hipOccupancyMaxActiveBlocksPerMultiprocessor(&per_cu, mega, 512, 0);
    if (per_cu > 1) per_cu = 1;
    if (per_cu < 1) per_cu = 1;
    grid_blocks = cus * per_cu;
  }
  P p{};
  const float* const* in = (const float* const*)d_in;
  p.x_prompt = in[0]; p.x_sample = in[1]; p.cache_k = in[2]; p.cache_v = in[3]; p.c = in[4]; p.c_ctx = in[5];
  p.w_ada = in[6]; p.b_ada = in[7]; p.g_mix = in[8]; p.g_ffn = in[9]; p.w_ffn_in = in[10]; p.ffn_conv_w = in[11]; p.ffn_conv_b = in[12]; p.w_ffn_out = in[13];
  p.a_w_in = in[14]; p.a_g_v = in[15]; p.a_w_s = in[16]; p.a_b_s = in[17]; p.a_w_out = in[18];
  p.p_w = in[19]; p.p_b = in[20]; p.p_scale = in[21];
  p.c_w_qkv = in[22]; p.c_g_q = in[23]; p.c_g_k = in[24]; p.c_sink = in[25]; p.c_w_o = in[26];
  p.out_g = (__attribute__((address_space(1))) float*)d_out;
  char* ws = (char*)d_ws;
  unsigned* bar = (unsigned*)ws;
  p.ws = (__attribute__((address_space(1))) char*)ws;
  if ((size_t)335869440ull > ws_size) { fprintf(stderr, "workspace too small: need %zu have %zu\n", (size_t)335869440ull, ws_size); return; }
#if ONE_LAUNCH
  int lo = 0, hi = NPH;
  (void)hipMemsetAsync(bar, 0, (size_t)XCD_BAR_WORDS * 4, stream);
  void* args[] = {&p, &bar, &lo, &hi};
  hipError_t e = hipLaunchCooperativeKernel((void*)mega, dim3(grid_blocks), dim3(512), args, 0, stream);
  if (e != hipSuccess) {
    fprintf(stderr, "cooperative launch failed: %s (grid %d); falling back to one launch per phase\n", hipGetErrorString(e), grid_blocks);
    (void)hipGetLastError();
    for (int ph = 0; ph < NPH; ++ph) mega<<<grid_blocks, 512, 0, stream>>>(p, bar, ph, ph + 1);
  }
#else
  for (int ph = 0; ph < NPH; ++ph) mega<<<grid_blocks, 512, 0, stream>>>(p, bar, ph, ph + 1);
#endif
}
```

```cpp
#include <hip/hip_runtime.h>
#include <hip/hip_cooperative_groups.h>
#include <cstdio>
#include <cstdint>
namespace cg = cooperative_groups;

#ifndef ONE_LAUNCH
#define ONE_LAUNCH 1
#endif

typedef unsigned short bf16_t;
typedef short bf16x8 __attribute__((ext_vector_type(8)));
typedef float f32x16 __attribute__((ext_vector_type(16)));
typedef __bf16 bf16x2_t __attribute__((ext_vector_type(2)));
typedef float f32x2_t __attribute__((ext_vector_type(2)));

constexpr int T = 12288;
constexpr int TCTX = 8192;
constexpr int NPH = 20;
constexpr float LOG2E = 1.4426950408889634f;

struct P {
  const float *x_prompt, *x_sample, *cache_k, *cache_v, *c, *c_ctx;
  const float *w_ada, *b_ada, *g_mix, *g_ffn, *w_ffn_in, *ffn_conv_w, *ffn_conv_b, *w_ffn_out;
  const float *a_w_in, *a_g_v, *a_w_s, *a_b_s, *a_w_out;
  const float *p_w, *p_b, *p_scale;
  const float *c_w_qkv, *c_g_q, *c_g_k, *c_sink, *c_w_o;
  __attribute__((address_space(1))) float* out_g;
  __device__ __forceinline__ float* xo() const { return (float*)out_g; }
  __attribute__((address_space(1))) char* ws;
  __device__ __forceinline__ float* mod() const { return (float*)(ws + 13824ull); }
  __device__ __forceinline__ float* vsq() const { return (float*)(ws + 308736ull); }
  __device__ __forceinline__ bf16_t* wt_ffn_in() const { return (bf16_t*)(ws + 407040ull); }
  __device__ __forceinline__ bf16_t* wt_ffn_out() const { return (bf16_t*)(ws + 46544384ull); }
  __device__ __forceinline__ bf16_t* wt_a_in() const { return (bf16_t*)(ws + 69613056ull); }
  __device__ __forceinline__ bf16_t* wt_a_out() const { return (bf16_t*)(ws + 86390272ull); }
  __device__ __forceinline__ bf16_t* wt_p() const { return (bf16_t*)(ws + 94778880ull); }
  __device__ __forceinline__ bf16_t* wt_qkv() const { return (bf16_t*)(ws + 95303168ull); }
  __device__ __forceinline__ bf16_t* wt_o() const { return (bf16_t*)(ws + 98448896ull); }
  __device__ __forceinline__ bf16_t* ck() const { return (bf16_t*)(ws + 100546048ull); }
  __device__ __forceinline__ bf16_t* cvT() const { return (bf16_t*)(ws + 100808192ull); }
  __device__ __forceinline__ bf16_t* h() const { return (bf16_t*)(ws + 101070336ull); }
  __device__ __forceinline__ char* big1() const { return (char*)(ws + 126236160ull); }
  __device__ __forceinline__ char* big2() const { return (char*)(ws + 264648192ull); }
  __device__ __forceinline__ float* ha() const { return (float*)(ws + 333854208ull); }
  __device__ __forceinline__ float* hu() const { return (float*)(ws + 334575104ull); }
  __device__ __forceinline__ float* rowsq() const { return (float*)(ws + 334935552ull); }
  __device__ __forceinline__ float* shw() const { return (float*)(ws + 335328768ull); }
};

__device__ __forceinline__ unsigned pk_bf16(float lo, float hi) {
  f32x2_t v = {lo, hi};
  bf16x2_t r = __builtin_convertvector(v, bf16x2_t);
  return __builtin_bit_cast(unsigned, r);
}
__device__ __forceinline__ bf16_t f2bf(float x) { return (bf16_t)(pk_bf16(x, 0.f) & 0xffffu); }
__device__ __forceinline__ float bf2f(bf16_t v) { return __uint_as_float(((unsigned)v) << 16); }
__device__ __forceinline__ float bflo(unsigned v) { return __uint_as_float(v << 16); }
__device__ __forceinline__ float bfhi(unsigned v) { return __uint_as_float(v & 0xffff0000u); }
__device__ __forceinline__ float gelu_f(float x) {
  const float t = __builtin_fmaf(x * x, -0.10294324284f, -2.3022081985f);
  const float e = __builtin_amdgcn_exp2f(x * t);
  return x * __builtin_amdgcn_rcpf(1.0f + e);
}
__device__ __forceinline__ float row_ror1(float v) { return __builtin_bit_cast(float, __builtin_amdgcn_update_dpp(0, __builtin_bit_cast(int, v), 0x121, 0xf, 0xf, true)); }
__device__ __forceinline__ float row_ror15(float v) { return __builtin_bit_cast(float, __builtin_amdgcn_update_dpp(0, __builtin_bit_cast(int, v), 0x12f, 0xf, 0xf, true)); }
__device__ __forceinline__ int opaque_tid() { int t = threadIdx.x; asm volatile("" : "+v"(t)); return t; }
__device__ __forceinline__ int opaque_bid() { int b = blockIdx.x; asm volatile("" : "+s"(b)); return b; }
__device__ __forceinline__ int cond_of_row(int row) { return row < 8192 ? 0 : (row < 10240 ? 1 : 2); }
__device__ __forceinline__ int crow(int i, int hh) { return (i & 3) + 8 * (i >> 2) + 4 * hh; }

__device__ __forceinline__ int tile_off(int r, int c) { return r * 128 + ((c ^ ((r >> 1) & 7)) << 4); }

__device__ __forceinline__ uint4 gld16(const void* p) {
  uint4 r;
  asm volatile("global_load_dwordx4 %0, %1, off" : "=v"(r) : "v"(p) : "memory");
  return r;
}

template <bool PAIRED>
__device__ __forceinline__ void compute_ktile(const char* sA, const char* sB, f32x16 (&acc)[2][2], int wm, int wn, int lane) {
  const int l31 = lane & 31, hh = lane >> 5;
#pragma unroll
  for (int ks = 0; ks < 4; ++ks) {
    bf16x8 a[2], b[2];
#pragma unroll
    for (int mb = 0; mb < 2; ++mb) { const int r = wm * 64 + mb * 32 + l31; a[mb] = *(const bf16x8*)(sA + tile_off(r, ks * 2 + hh)); }
#pragma unroll
    for (int nb = 0; nb < 2; ++nb) { const int r = (PAIRED ? nb * 64 + wn * 32 : wn * 64 + nb * 32) + l31; b[nb] = *(const bf16x8*)(sB + tile_off(r, ks * 2 + hh)); }
#pragma unroll
    for (int mb = 0; mb < 2; ++mb)
#pragma unroll
      for (int nb = 0; nb < 2; ++nb) acc[mb][nb] = __builtin_amdgcn_mfma_f32_32x32x16_bf16(a[mb], b[nb], acc[mb][nb], 0, 0, 0);
  }
}


typedef float f32x4 __attribute__((ext_vector_type(4)));
__device__ __forceinline__ int g8_lds_byte(int r, int c) {
  const int st = (r >> 4) * 2 + (c >> 5), rr = r & 15, cc = c & 31, ob = rr * 64 + cc * 2;
  return st * 1024 + (ob ^ (((ob >> 9) & 1) << 5));
}
__device__ __forceinline__ void g8_stage_rc(int b, int& R, int& C) {
  const int st = b / 1024, sb = b % 1024, swz = sb ^ (((sb >> 9) & 1) << 5);
  R = (st >> 1) * 16 + swz / 64; C = (st & 1) * 32 + (swz % 64) / 2;
}
template <bool TRANS, bool R192>
__device__ __forceinline__ void gemm256(const bf16_t* __restrict__ A0, const bf16_t* __restrict__ A1, int lda, const bf16_t* __restrict__ B0, const bf16_t* __restrict__ B1, int ldb,
                                        int nt, char* shm, f32x4 (&acc)[2][2][4][2], int tid, bool pre, bool has_next,
                                        const bf16_t* __restrict__ nA0, const bf16_t* __restrict__ nA1, const bf16_t* __restrict__ nB0, const bf16_t* __restrict__ nB1) {
#define G8LAS __attribute__((address_space(3)))
  constexpr int HTB = 16384;
  G8LAS unsigned char* lds = (G8LAS unsigned char*)shm;
  const int wid = __builtin_amdgcn_readfirstlane(tid >> 6), lane = tid & 63, wr = wid >> 2, wc = wid & 3, fr = lane & 15, fq = lane >> 4;
  unsigned voffA[2], voffB[2];
#pragma unroll
  for (int i = 0; i < 2; ++i) {
    int R, C;
    g8_stage_rc(tid * 16 + i * 8192, R, C);
    voffA[i] = (unsigned)(R * lda + C) * 2u; voffB[i] = (unsigned)(R * ldb + C) * 2u;
  }
  const unsigned ldsw = (unsigned)wid * 1024u;
  const int aoff = g8_lds_byte(wr * 64 + fr, fq * 8), boff = g8_lds_byte(wc * 32 + fr, fq * 8);
  const char* cA0 = (const char*)A0; const char* cA1 = (const char*)A1; const char* cB0 = (const char*)B0; const char* cB1 = (const char*)B1;
  const char* dA0 = (const char*)nA0; const char* dA1 = (const char*)nA1; const char* dB0 = (const char*)nB0; const char* dB1 = (const char*)nB1;
#define SA(b, h) (((b) * 2 + (h)) * HTB)
#define SB(b, h) ((4 + (b) * 2 + (h)) * HTB)
#define STAGE(bufoff, gbase, voff, kt)                                                                                 \
  {                                                                                                                    \
    const unsigned long long _b = (unsigned long long)(gbase) + (unsigned long long)(kt) * 128ull;                     \
    const unsigned _blo = __builtin_amdgcn_readfirstlane((unsigned)_b), _bhi = __builtin_amdgcn_readfirstlane((unsigned)(_b >> 32)); \
    const char* _sb = (const char*)(((unsigned long long)_bhi << 32) | (unsigned long long)_blo);                      \
    _Pragma("unroll") for (int _i = 0; _i < 2; ++_i)                                                                   \
        __builtin_amdgcn_global_load_lds((const unsigned*)(_sb + (voff)[_i]), (G8LAS unsigned*)(lds + (bufoff) + ldsw + _i * 8192), 16, 0, 0); \
  }
#define LDA(dst, b, h)                                                                                                 \
  _Pragma("unroll") for (int m = 0; m < 4; ++m) _Pragma("unroll") for (int k = 0; k < 2; ++k)                          \
      dst[m][k] = *(const G8LAS bf16x8*)(lds + SA(b, h) + aoff + m * 2048 + k * 1024)
#define LDB(dst, b, h)                                                                                                 \
  _Pragma("unroll") for (int n = 0; n < 2; ++n) _Pragma("unroll") for (int k = 0; k < 2; ++k)                          \
      dst[n][k] = *(const G8LAS bf16x8*)(lds + SB(b, h) + boff + n * 2048 + k * 1024)
#define MMA(ai, bj, At_, Bt_)                                                                                          \
  if (!(R192 && (ai) == 1) || wr == 0) {     \
    __builtin_amdgcn_s_setprio(1);                                                                                     \
    _Pragma("unroll") for (int m = 0; m < 4; ++m) _Pragma("unroll") for (int n = 0; n < 2; ++n) _Pragma("unroll") for (int k = 0; k < 2; ++k) \
        acc[ai][bj][m][n] = TRANS ? __builtin_amdgcn_mfma_f32_16x16x32_bf16(Bt_[n][k], At_[m][k], acc[ai][bj][m][n], 0, 0, 0)  \
                                  : __builtin_amdgcn_mfma_f32_16x16x32_bf16(At_[m][k], Bt_[n][k], acc[ai][bj][m][n], 0, 0, 0); \
    __builtin_amdgcn_s_setprio(0);                                                                                     \
  }
#define WAIT_V(n) asm volatile("s_waitcnt vmcnt(" #n ")" ::: "memory")
#define WAIT_L(n) asm volatile("s_waitcnt lgkmcnt(" #n ")" ::: "memory")
#define BAR __builtin_amdgcn_s_barrier()
#define SCHED __builtin_amdgcn_sched_barrier(0)
#pragma unroll
  for (int ai = 0; ai < 2; ++ai)
#pragma unroll
    for (int bj = 0; bj < 2; ++bj)
#pragma unroll
      for (int m = 0; m < 4; ++m)
#pragma unroll
        for (int n = 0; n < 2; ++n) acc[ai][bj][m][n] = (f32x4){0.f, 0.f, 0.f, 0.f};
  bf16x8 At[4][2], Bx0[2][2], Bx1[2][2];
  if (!pre) {
    STAGE(SB(0, 0), cB0, voffB, 0); STAGE(SA(0, 0), cA0, voffA, 0);
    STAGE(SB(0, 1), cB1, voffB, 0); STAGE(SA(0, 1), cA1, voffA, 0);
    if (wr == 1) BAR;
    WAIT_V(4); BAR;
    STAGE(SB(1, 0), cB0, voffB, 1); STAGE(SA(1, 0), cA0, voffA, 1); STAGE(SB(1, 1), cB1, voffB, 1);
    WAIT_V(6); BAR;
  } else {
    if (wr == 1) BAR;
    STAGE(SB(1, 1), cB1, voffB, 1);
    WAIT_V(2); BAR;
  }
  for (int t = 0; t < nt - 2; t += 2) {
    LDB(Bx0, 0, 0); SCHED; LDA(At, 0, 0); STAGE(SA(1, 1), cA1, voffA, t + 1);
    WAIT_L(8); BAR; WAIT_L(0); MMA(0, 0, At, Bx0); BAR; SCHED;
    LDB(Bx1, 0, 1); STAGE(SB(0, 0), cB0, voffB, t + 2);
    BAR; WAIT_L(0); MMA(0, 1, At, Bx1); BAR;
    LDA(At, 0, 1); STAGE(SA(0, 0), cA0, voffA, t + 2);
    BAR; WAIT_L(0); MMA(1, 0, At, Bx0); BAR; SCHED;
    STAGE(SB(0, 1), cB1, voffB, t + 2);
    WAIT_V(6); BAR; MMA(1, 1, At, Bx1); BAR;
    LDB(Bx0, 1, 0); SCHED; LDA(At, 1, 0); STAGE(SA(0, 1), cA1, voffA, t + 2);
    WAIT_L(8); BAR; WAIT_L(0); MMA(0, 0, At, Bx0); BAR; SCHED;
    LDB(Bx1, 1, 1); STAGE(SB(1, 0), cB0, voffB, t + 3);
    BAR; WAIT_L(0); MMA(0, 1, At, Bx1); BAR;
    LDA(At, 1, 1); STAGE(SA(1, 0), cA0, voffA, t + 3);
    BAR; WAIT_L(0); MMA(1, 0, At, Bx0); BAR; SCHED;
    STAGE(SB(1, 1), cB1, voffB, t + 3);
    WAIT_V(6); BAR; MMA(1, 1, At, Bx1); BAR;
  }
  {
    LDB(Bx0, 0, 0); LDA(At, 0, 0); STAGE(SA(1, 1), cA1, voffA, nt - 1);
    BAR; WAIT_L(0); MMA(0, 0, At, Bx0); BAR;
    LDB(Bx1, 0, 1); BAR; WAIT_L(0); MMA(0, 1, At, Bx1); BAR;
    LDA(At, 0, 1);
    if (has_next) { STAGE(SB(0, 0), dB0, voffB, 0); STAGE(SA(0, 0), dA0, voffA, 0); WAIT_V(8); } else { WAIT_V(4); }
    BAR; WAIT_L(0); MMA(1, 0, At, Bx0); MMA(1, 1, At, Bx1); BAR;
  }
  {
    LDB(Bx0, 1, 0); LDA(At, 1, 0);
    if (has_next) { STAGE(SB(0, 1), dB1, voffB, 0); WAIT_V(8); } else { WAIT_V(2); }
    BAR; WAIT_L(0); MMA(0, 0, At, Bx0); BAR;
    LDB(Bx1, 1, 1);
    if (has_next) { STAGE(SA(0, 1), dA1, voffA, 0); WAIT_V(8); } else { WAIT_V(0); }
    BAR; WAIT_L(0); MMA(0, 1, At, Bx1); BAR;
    LDA(At, 1, 1);
    if (has_next) { STAGE(SB(1, 0), dB0, voffB, 1); STAGE(SA(1, 0), dA0, voffA, 1); }
    BAR; WAIT_L(0); MMA(1, 0, At, Bx0); MMA(1, 1, At, Bx1); BAR;
  }
  if (wr == 0) BAR;
#undef SA
#undef SB
#undef STAGE
#undef LDA
#undef LDB
#undef MMA
#undef WAIT_V
#undef WAIT_L
#undef BAR
#undef SCHED
#undef G8LAS
}

#define TR_LOAD(SRC, NN, V0, V1, V2, V3, V4, V5, V6, V7)                                                     \
  {                                                                                                            \
    const float* _s = (SRC) + (long)(tid >> 5) * (NN) + (tid & 31) * 4;                                        \
    V0 = *(const float4*)(_s); V1 = *(const float4*)(_s + (long)16 * (NN)); V2 = *(const float4*)(_s + (long)32 * (NN)); V3 = *(const float4*)(_s + (long)48 * (NN)); \
    V4 = *(const float4*)(_s + (long)64 * (NN)); V5 = *(const float4*)(_s + (long)80 * (NN)); V6 = *(const float4*)(_s + (long)96 * (NN)); V7 = *(const float4*)(_s + (long)112 * (NN)); \
  }
__device__ __forceinline__ void tr_store(bf16_t* __restrict__ dst, int K, float4 v0, float4 v1, float4 v2, float4 v3, float4 v4, float4 v5, float4 v6, float4 v7, float* tile, int tid) {
  const float4 v[8] = {v0, v1, v2, v3, v4, v5, v6, v7};
#pragma unroll
  for (int i = 0; i < 8; ++i) *(float4*)(tile + ((tid >> 5) + 16 * i) * 132 + (tid & 31) * 4) = v[i];
  __syncthreads();
  const int nn = tid & 127, kg = tid >> 7;
  const float* col = tile + (kg * 32) * 132 + nn;
#pragma unroll
  for (int c = 0; c < 4; ++c) {
    uint4 o;
    o.x = pk_bf16(col[(c * 8 + 0) * 132], col[(c * 8 + 1) * 132]);
    o.y = pk_bf16(col[(c * 8 + 2) * 132], col[(c * 8 + 3) * 132]);
    o.z = pk_bf16(col[(c * 8 + 4) * 132], col[(c * 8 + 5) * 132]);
    o.w = pk_bf16(col[(c * 8 + 6) * 132], col[(c * 8 + 7) * 132]);
    *(uint4*)(dst + (long)nn * K + kg * 32 + c * 8) = o;
  }
  __syncthreads();
}

__device__ void ada_item(const P& p, int item, float* sm, int tid) {
  const int l = item / 48, chunk = item % 48;
  float* sc = sm;
  float* red = sm + 3072;
  for (int i = tid; i < 3072; i += 512) {
    const int cb = i >> 10, k = i & 1023;
    const float v = cb == 0 ? p.c_ctx[k] : p.c[(cb - 1) * 1024 + k];
    sc[i] = v / (1.f + __expf(-v));
  }
  __syncthreads();
  const int ng = tid & 31, kg = tid >> 5;
  const float* wp = p.w_ada + ((long)l * 1024 + kg * 64) * 6144 + chunk * 128 + ng * 4;
  float a0[4] = {0.f, 0.f, 0.f, 0.f}, a1[4] = {0.f, 0.f, 0.f, 0.f}, a2[4] = {0.f, 0.f, 0.f, 0.f};
#pragma unroll 8
  for (int k = 0; k < 64; ++k) {
    const float4 wv = *(const float4*)(wp + (long)k * 6144);
    const float s0 = sc[kg * 64 + k], s1 = sc[1024 + kg * 64 + k], s2 = sc[2048 + kg * 64 + k];
    a0[0] += s0 * wv.x; a0[1] += s0 * wv.y; a0[2] += s0 * wv.z; a0[3] += s0 * wv.w;
    a1[0] += s1 * wv.x; a1[1] += s1 * wv.y; a1[2] += s1 * wv.z; a1[3] += s1 * wv.w;
    a2[0] += s2 * wv.x; a2[1] += s2 * wv.y; a2[2] += s2 * wv.z; a2[3] += s2 * wv.w;
  }
#pragma unroll
  for (int j = 0; j < 4; ++j) {
    red[(kg * 3 + 0) * 128 + ng * 4 + j] = a0[j];
    red[(kg * 3 + 1) * 128 + ng * 4 + j] = a1[j];
    red[(kg * 3 + 2) * 128 + ng * 4 + j] = a2[j];
  }
  __syncthreads();
  if (tid < 384) {
    const int cb = tid >> 7, n = tid & 127;
    float s = p.b_ada[l * 6144 + chunk * 128 + n];
#pragma unroll
    for (int g = 0; g < 16; ++g) s += red[(g * 3 + cb) * 128 + n];
    p.mod()[((long)l * 3 + cb) * 6144 + chunk * 128 + n] = s;
  }
  __syncthreads();
}

__device__ __forceinline__ void tr_decode(const P& p, int t, const float*& osrc, bf16_t*& odst, int& oK, int& oN) {
  constexpr int t_ffn_in = 4 * 8 * 44, t_ffn_out = 4 * 22 * 8, t_a_in = 2 * 8 * 32, t_a_out = 2 * 16 * 8, t_p = 4 * 2 * 2, t_qkv = 8 * 12, t_o = 8 * 8;
  const float* src; bf16_t* dst; int K, N;
#define TR_OPAQUE asm volatile("" : "+s"(src), "+s"(dst));
  if (t < t_ffn_in) { src = p.w_ffn_in; dst = p.wt_ffn_in(); K = 1024; N = 5632; TR_OPAQUE }
  else if ((t -= t_ffn_in) < t_ffn_out) { src = p.w_ffn_out; dst = p.wt_ffn_out(); K = 2816; N = 1024; TR_OPAQUE }
  else if ((t -= t_ffn_out) < t_a_in) { src = p.a_w_in; dst = p.wt_a_in(); K = 1024; N = 4096; TR_OPAQUE }
  else if ((t -= t_a_in) < t_a_out) { src = p.a_w_out; dst = p.wt_a_out(); K = 2048; N = 1024; TR_OPAQUE }
  else if ((t -= t_a_out) < t_p) { src = p.p_w; dst = p.wt_p(); K = 256; N = 256; TR_OPAQUE }
  else if ((t -= t_p) < t_qkv) { src = p.c_w_qkv; dst = p.wt_qkv(); K = 1024; N = 1536; TR_OPAQUE }
  else if ((t -= t_qkv) < t_o) { src = p.c_w_o; dst = p.wt_o(); K = 1024; N = 1024; TR_OPAQUE }
  else { t -= t_o; src = p.cache_v; dst = p.cvT(); K = 256; N = 256; TR_OPAQUE }
  const int nkt = K >> 7, nnt = N >> 7, per = nkt * nnt;
  const int mat = t / per, r = t % per;
  const int nt = r % nnt, kt = r / nnt;
  osrc = src + (long)mat * K * N + (long)(kt * 128) * N + nt * 128;
  odst = dst + (long)mat * K * N + (long)(nt * 128) * K + kt * 128;
  oK = K; oN = N;
#undef TR_OPAQUE
}

__device__ __forceinline__ int tr_group_size(int g) { return g == 0 ? 920 : (g == 1 ? 544 : (g == 2 ? 688 : 912)); }
__device__ __forceinline__ int tr_group_map(int g, int i) {
  if (i < 352) return 352 * g + i;
  i -= 352;
  if (i < 176) return 1408 + 176 * g + i;
  i -= 176;
  if (g == 0) return i < 256 ? 2112 + i : (i < 384 ? 2624 + (i - 256) : 3056 + (i - 384));
  if (g == 1) return 2880 + i;
  if (g == 2) return i < 96 ? 2896 + i : 2992 + (i - 96);
  return i < 256 ? 2112 + 256 + i : 2624 + 128 + (i - 256);
}
__device__ void run_transposes(const P& p, int g, int first, int stride, float* sm, int tid) {
  const int n = tr_group_size(g);
  int t = first;
  if (t < n) {
    const float* csrc; bf16_t* cdst; int cK, cN;
    tr_decode(p, tr_group_map(g, t), csrc, cdst, cK, cN);
    float4 a0, a1, a2, a3, a4, a5, a6, a7;
    TR_LOAD(csrc, cN, a0, a1, a2, a3, a4, a5, a6, a7)
    while (true) {
      const int tn = t + stride;
      const bool more = tn < n;
      const float* nsrc; bf16_t* ndst; int nK, nN;
      tr_decode(p, tr_group_map(g, more ? tn : t), nsrc, ndst, nK, nN);
      float4 b0 = a0, b1 = a1, b2 = a2, b3 = a3, b4 = a4, b5 = a5, b6 = a6, b7 = a7;
      if (more) TR_LOAD(nsrc, nN, b0, b1, b2, b3, b4, b5, b6, b7)
      tr_store(cdst, cK, a0, a1, a2, a3, a4, a5, a6, a7, sm, tid);
      if (!more) break;
      a0 = b0; a1 = b1; a2 = b2; a3 = b3; a4 = b4; a5 = b5; a6 = b6; a7 = b7;
      cdst = ndst; cK = nK; t = tn;
    }
  }
}

__device__ void phase_prep(const P& p, char* smem) {
  float* sm = (float*)smem;
  const int tid = opaque_tid();
  constexpr int N_ADA = 192, N_CK = 32, N_Z = 6 + 24;
  constexpr int TR0 = N_ADA + N_CK + N_Z;
  for (int item = opaque_bid(); item < TR0; item += gridDim.x) {
    if (item < N_ADA) { ada_item(p, item, sm, tid); continue; }
    if (item < N_ADA + N_CK) {
      const int i0 = (item - N_ADA) * 4096 + tid * 8;
      const float4 a = *(const float4*)(p.cache_k + i0), b = *(const float4*)(p.cache_k + i0 + 4);
      uint4 o; o.x = pk_bf16(a.x, a.y); o.y = pk_bf16(a.z, a.w); o.z = pk_bf16(b.x, b.y); o.w = pk_bf16(b.z, b.w);
      *(uint4*)(p.ck() + i0) = o;
      continue;
    }
    const int zi = item - N_ADA - N_CK;
    float* zp = zi < 6 ? p.vsq() + zi * 4096 + tid * 8 : p.rowsq() + (zi - 6) * 4096 + tid * 8;
    *(float4*)(zp) = make_float4(0.f, 0.f, 0.f, 0.f);
    *(float4*)(zp + 4) = make_float4(0.f, 0.f, 0.f, 0.f);
  }
  run_transposes(p, 0, (int)(gridDim.x - 1 - opaque_bid()), (int)gridDim.x, sm, tid);
}

__device__ void phase_filler(const P& p, int g, char* smem) {
  const int bid = opaque_bid();
  if (bid < 32) return;
  const int tid = opaque_tid();
  const int fb = bid - 32, nf = (int)gridDim.x - 32;
  __syncthreads();
  run_transposes(p, g, nf - 1 - fb, nf, (float*)smem, tid);
}

__device__ void phase_norm(const P& p, int layer, int which, bool first) {
  const int tid = opaque_tid(), lane = tid & 63, w = tid >> 6;
  const float* g = (which ? p.g_ffn : p.g_mix) + layer * 1024;
  for (int item = opaque_bid(); item < T / 16; item += gridDim.x) {
    const int row0 = item * 16 + w * 2;
    float4 v[2][4];
    float ss[2] = {0.f, 0.f};
#pragma unroll
    for (int r = 0; r < 2; ++r) {
      const int row = row0 + r;
      const float* xr = first ? (row < TCTX ? p.x_prompt + (long)row * 1024 : p.x_sample + (long)(row - TCTX) * 1024) : p.xo() + (long)row * 1024;
#pragma unroll
      for (int i = 0; i < 4; ++i) {
        v[r][i] = *(const float4*)(xr + (i * 64 + lane) * 4);
        ss[r] += v[r][i].x * v[r][i].x + v[r][i].y * v[r][i].y + v[r][i].z * v[r][i].z + v[r][i].w * v[r][i].w;
      }
    }
#pragma unroll
    for (int o = 32; o; o >>= 1) { ss[0] += __shfl_xor(ss[0], o); ss[1] += __shfl_xor(ss[1], o); }
    const float* md = p.mod() + ((long)layer * 3 + cond_of_row(row0)) * 6144 + which * 3072;
#pragma unroll
    for (int i = 0; i < 4; ++i) {
      const int col = (i * 64 + lane) * 4;
      const float4 gg = *(const float4*)(g + col), sh = *(const float4*)(md + col), sc = *(const float4*)(md + 1024 + col);
#pragma unroll
      for (int r = 0; r < 2; ++r) {
        const float rstd = rsqrtf(ss[r] * (1.f / 1024.f) + 1e-6f);
        const float y0 = v[r][i].x * rstd * gg.x * (1.f + sc.x) + sh.x;
        const float y1 = v[r][i].y * rstd * gg.y * (1.f + sc.y) + sh.y;
        const float y2 = v[r][i].z * rstd * gg.z * (1.f + sc.z) + sh.z;
        const float y3 = v[r][i].w * rstd * gg.w * (1.f + sc.w) + sh.w;
        uint2 o; o.x = pk_bf16(y0, y1); o.y = pk_bf16(y2, y3);
        *(uint2*)(p.h() + (long)(row0 + r) * 1024 + col) = o;
        if (first) *(float4*)(p.xo() + (long)(row0 + r) * 1024 + col) = v[r][i];
      }
    }
  }
}

__device__ void phase_shw(const P& p, int ra0, int ra1, int rb0, int rb1, bool skip_lat) {
  const int tid = opaque_tid(), lane = tid & 63, w = tid >> 6;
  int rank = opaque_bid(), nblk = (int)gridDim.x;
  if (skip_lat) {
    const int mq = rank & 63;
    if (mq >= 42) return;
    rank = (rank >> 6) * 42 + mq; nblk = (nblk >> 6) * 42;
  }
  const int na = (ra1 - ra0) >> 6, nb = (rb1 - rb0) >> 6;
  for (int item = rank; item < na + nb; item += nblk) {
    int r = (item < na ? ra0 + item * 64 : rb0 + (item - na) * 64) + w * 8;
    int idx, n0; const bf16_t* wrow;
    if (r < 4 * 5632) { const int l = r / 5632; n0 = r - l * 5632; idx = 2 * l + 1; wrow = p.wt_ffn_in() + ((long)l * 5632 + n0) * 1024; }
    else if ((r -= 4 * 5632) < 1536) { n0 = r; idx = 4; wrow = p.wt_qkv() + (long)n0 * 1024; }
    else { n0 = r - 1536; idx = 6; wrow = p.wt_a_in() + ((long)4096 + n0) * 1024; }
    uint4 wv[8][2];
#pragma unroll
    for (int q = 0; q < 8; ++q) { wv[q][0] = *(const uint4*)(wrow + (long)q * 1024 + lane * 16); wv[q][1] = *(const uint4*)(wrow + (long)q * 1024 + lane * 16 + 8); }
    const float* shb = p.mod() + (long)(idx >> 1) * 3 * 6144 + ((idx & 1) ? 3072 : 0) + lane * 16;
    float sacc[8][3];
#pragma unroll
    for (int q = 0; q < 8; ++q) { sacc[q][0] = 0.f; sacc[q][1] = 0.f; sacc[q][2] = 0.f; }
#pragma unroll
    for (int cnd = 0; cnd < 3; ++cnd) {
      const float* sh = shb + cnd * 6144;
      const float4 s0 = *(const float4*)(sh), s1 = *(const float4*)(sh + 4), s2 = *(const float4*)(sh + 8), s3 = *(const float4*)(sh + 12);
#pragma unroll
      for (int q = 0; q < 8; ++q) {
        const uint4 a = wv[q][0], b = wv[q][1];
        sacc[q][cnd] = s0.x * bflo(a.x) + s0.y * bfhi(a.x) + s0.z * bflo(a.y) + s0.w * bfhi(a.y) + s1.x * bflo(a.z) + s1.y * bfhi(a.z) + s1.z * bflo(a.w) + s1.w * bfhi(a.w)
                     + s2.x * bflo(b.x) + s2.y * bfhi(b.x) + s2.z * bflo(b.y) + s2.w * bfhi(b.y) + s3.x * bflo(b.z) + s3.y * bfhi(b.z) + s3.z * bflo(b.w) + s3.w * bfhi(b.w);
      }
    }
#pragma unroll
    for (int o = 32; o; o >>= 1)
#pragma unroll
      for (int q = 0; q < 8; ++q) { sacc[q][0] += __shfl_xor(sacc[q][0], o); sacc[q][1] += __shfl_xor(sacc[q][1], o); sacc[q][2] += __shfl_xor(sacc[q][2], o); }
    if (lane < 24) {
      const int q = lane / 3, cnd = lane - q * 3;
      float v = 0.f;
#pragma unroll
      for (int qq = 0; qq < 8; ++qq)
#pragma unroll
        for (int cc = 0; cc < 3; ++cc) if (qq == q && cc == cnd) v = sacc[qq][cc];
      p.shw()[((long)idx * 3 + cnd) * 5632 + n0 + q] = v;
    }
  }
}

__device__ __forceinline__ void ffn_fix_rows(const P& p, int layer, int lo, int hi, int tid) {
  bf16_t* gbuf = (bf16_t*)p.big2();
  const float* cw = p.ffn_conv_w + (long)layer * 3 * 2816;
  const float* cb = p.ffn_conv_b + (long)layer * 2816;
  bool any = false;
  for (int q = 0; q < 32; ++q) {
    const int lt = q >> 1, e = q & 1;
    const int row = TCTX + lt * 256 + (e == 0 ? 0 : 255);
    if (row < lo || row >= hi) continue;
    if (e == 0 ? (lt & 7) == 0 : (lt & 7) == 7) continue;
    any = true;
    const float* ap = e == 0 ? p.ha() + (long)((lt - 1) * 4 + 3) * 2816 : p.ha() + (long)(lt * 4 + 2) * 2816;
    const float* ac = e == 0 ? p.ha() + (long)(lt * 4 + 0) * 2816 : p.ha() + (long)(lt * 4 + 3) * 2816;
    const float* an = e == 0 ? p.ha() + (long)(lt * 4 + 1) * 2816 : p.ha() + (long)((lt + 1) * 4 + 0) * 2816;
    const float* uu = p.hu() + (long)(lt * 2 + e) * 2816;
    for (int c = tid; c < 2816; c += 512) {
      const float x = cw[c] * ap[c] + cw[2816 + c] * ac[c] + cw[5632 + c] * an[c] + cb[c];
      gbuf[(long)row * 2816 + c] = f2bf(gelu_f(x) * uu[c]);
    }
  }
  if (any) { asm volatile("s_waitcnt vmcnt(0)" ::: "memory"); __syncthreads(); }
}

__device__ __forceinline__ void pool_tile(const P& p, int mt, int g, char* smem, int tid) {
  const int half = 1 << g;
  bf16_t* d = (bf16_t*)p.big1();
  const bf16_t* h = p.h();
  const int r0 = mt * 192;
  int lo0 = r0 - 8; lo0 = lo0 < 0 ? 0 : lo0;
  int hi0 = r0 + 192 + 7; hi0 = hi0 > T ? T : hi0;
  const int nch = (hi0 - lo0) * 32;
  const float* rq = p.rowsq() + (long)2 * T;
  for (int ci = tid; ci < nch; ci += 512) {
    const int row = lo0 + (ci >> 5), c8 = g * 256 + (ci & 31) * 8;
    const uint4 xv = *(const uint4*)(h + (long)row * 1024 + c8);
    const float r = rsqrtf(rq[row] * (1.f / 1024.f) + 1e-6f);
    const float* shp = p.mod() + ((long)1 * 3 + cond_of_row(row)) * 6144 + c8;
    const float4 s0 = *(const float4*)(shp), s1 = *(const float4*)(shp + 4);
    uint4 o;
    o.x = pk_bf16(r * bflo(xv.x) + s0.x, r * bfhi(xv.x) + s0.y); o.y = pk_bf16(r * bflo(xv.y) + s0.z, r * bfhi(xv.y) + s0.w);
    o.z = pk_bf16(r * bflo(xv.z) + s1.x, r * bfhi(xv.z) + s1.y); o.w = pk_bf16(r * bflo(xv.w) + s1.z, r * bfhi(xv.w) + s1.w);
    *(uint4*)(smem + ci * 16) = o;
  }
  __syncthreads();
  const int c4 = (tid & 63) * 4;
  for (int rr = tid >> 6; rr < 192; rr += 8) {
    const int row = r0 + rr;
    int s, S;
    if (row < TCTX) { s = row & 255; S = 256; } else { s = (row - TCTX) & 2047; S = 2048; }
    const int base = row - s;
    int lo = s - half; lo = lo < 0 ? 0 : lo;
    int hi = s + half - 1; hi = hi > S - 1 ? S - 1 : hi;
    float a0 = 0.f, a1 = 0.f, a2 = 0.f, a3 = 0.f;
    for (int q = lo; q <= hi; ++q) {
      const uint2 v = *(const uint2*)(smem + (base + q - lo0) * 512 + c4 * 2);
      a0 += bflo(v.x); a1 += bfhi(v.x); a2 += bflo(v.y); a3 += bfhi(v.y);
    }
    const float inv = 1.f / (float)(hi - lo + 1);
    const uint2 v = *(const uint2*)(smem + (row - lo0) * 512 + c4 * 2);
    uint2 o;
    o.x = pk_bf16(a0 * inv - bflo(v.x), a1 * inv - bfhi(v.x));
    o.y = pk_bf16(a2 * inv - bflo(v.y), a3 * inv - bfhi(v.y));
    *(uint2*)(d + (long)row * 1024 + g * 256 + c4) = o;
  }
  asm volatile("s_waitcnt vmcnt(0)" ::: "memory");
  __syncthreads();
}

enum { G_GMLP_IN = 0, G_RESID = 1, G_POOL = 2, G_QKV = 3, G_FFN_IN = 4, G_GMLP_V = 5, G_QKV_V = 6 };

template <int KIND>
__device__ void phase_gemm(const P& p, const bf16_t* __restrict__ A, int lda, const bf16_t* __restrict__ Bt, int ldb, int K, int ntn, int layer, int aux, int fx, char* smem) {
  constexpr bool R192 = (KIND == G_RESID || KIND == G_POOL);
  constexpr int MT = R192 ? 64 : 48, MROWS = R192 ? 192 : 256;
  constexpr int CHAIN_V = KIND == G_GMLP_IN ? 48 * 8 : (KIND == G_QKV ? 48 * 1 : 0);
  constexpr int CHAIN_VOFF = KIND == G_GMLP_IN ? 8 : 5;
  constexpr int PREV_CNT = KIND == G_GMLP_V ? 48 * 8 : (KIND == G_QKV_V ? 48 * 5 : 0);
  bool pre = PREV_CNT > 0 && opaque_bid() < PREV_CNT;
  for (int item = ((KIND == G_GMLP_V || KIND == G_QKV_V) ? (int)(gridDim.x - 1 - opaque_bid()) : opaque_bid()); item < MT * ntn; item += gridDim.x) {
    const int tid = opaque_tid();
    const int mt = item % MT, nt = item / MT + (KIND == G_GMLP_V ? 8 : (KIND == G_QKV_V ? 5 : 0));
    const bf16_t* At = A + (long)mt * MROWS * lda + (KIND == G_POOL ? nt * 256 : 0);
    const bf16_t* B0 = Bt + (long)nt * (KIND == G_FFN_IN ? 128 : 256) * ldb;
    const bf16_t* B1 = KIND == G_FFN_IN ? Bt + (long)(2816 + nt * 128) * ldb : B0 + (long)128 * ldb;
    const bool own_next = item + (int)gridDim.x < MT * ntn;
    const int vitem0 = (int)gridDim.x - 1 - opaque_bid();
    const bool chain = CHAIN_V > 0 && !own_next && vitem0 < CHAIN_V;
    const bool has_next = own_next || chain;
    const int nitem = own_next ? item + (int)gridDim.x : (chain ? vitem0 : item);
    const int nmt = nitem % MT, nnt = nitem / MT + (chain ? CHAIN_VOFF : (KIND == G_GMLP_V ? 8 : (KIND == G_QKV_V ? 5 : 0)));
    const bf16_t* nAt = A + (long)nmt * MROWS * lda + (KIND == G_POOL ? nnt * 256 : 0);
    const bf16_t* nB0 = Bt + (long)nnt * (KIND == G_FFN_IN ? 128 : 256) * ldb;
    const bf16_t* nB1 = KIND == G_FFN_IN ? Bt + (long)(2816 + nnt * 128) * ldb : nB0 + (long)128 * ldb;
    const bool was_pre = pre;
    pre = has_next;
    if constexpr (KIND == G_RESID) { if (aux == 5120) ffn_fix_rows(p, layer, mt * MROWS, mt * MROWS + MROWS, tid); }
    if constexpr (KIND == G_POOL) pool_tile(p, mt, nt, smem, tid);
    f32x4 acc[2][2][4][2];
#define EPI_IDS()                                                                                                     \
    const int te = opaque_tid(), lane = te & 63, wid = __builtin_amdgcn_readfirstlane(te >> 6), wr = wid >> 2, wc = wid & 3, fr = lane & 15, fq = lane >> 4; \
    const int rb = mt * MROWS + wr * 64, cb = nt * 256 + wc * 32;
    if constexpr (KIND == G_GMLP_V || KIND == G_QKV_V) {
      gemm256<false, false>(At, At + (long)128 * lda, lda, B0, B1, ldb, K >> 6, smem, acc, tid, was_pre, has_next, nAt, nAt + (long)128 * lda, nB0, nB1);
      EPI_IDS()
      const unsigned lo = (unsigned)(fr * T + fq * 4);
      if (fx >= 0) {
        const float* rq = p.rowsq() + (long)fx * T + rb + fq * 4;
        const float* sw = p.shw() + ((long)fx * 3 + cond_of_row(mt * 256)) * 5632 + cb + fr;
#pragma unroll
        for (int ai = 0; ai < 2; ++ai)
#pragma unroll
          for (int m = 0; m < 4; ++m) {
            const float4 q = *(const float4*)(rq + ai * 128 + m * 16);
            const float r0 = rsqrtf(q.x * (1.f / 1024.f) + 1e-6f), r1 = rsqrtf(q.y * (1.f / 1024.f) + 1e-6f), r2 = rsqrtf(q.z * (1.f / 1024.f) + 1e-6f), r3 = rsqrtf(q.w * (1.f / 1024.f) + 1e-6f);
#pragma unroll
            for (int bj = 0; bj < 2; ++bj)
#pragma unroll
              for (int n = 0; n < 2; ++n) {
                const float sv = sw[bj * 128 + n * 16];
                f32x4 v = acc[ai][bj][m][n];
                v[0] = r0 * v[0] + sv; v[1] = r1 * v[1] + sv; v[2] = r2 * v[2] + sv; v[3] = r3 * v[3] + sv;
                acc[ai][bj][m][n] = v;
              }
          }
      }
      if constexpr (KIND == G_QKV_V) {
        bf16_t* vTa = (bf16_t*)p.big2() + (long)T * 1024 + (long)T * 256;
        float* outv = p.xo() + (long)T * 1024 + (long)TCTX * 256;
#pragma unroll
        for (int ai = 0; ai < 2; ++ai)
#pragma unroll
          for (int m = 0; m < 4; ++m)
#pragma unroll
            for (int bj = 0; bj < 2; ++bj)
#pragma unroll
              for (int n = 0; n < 2; ++n) {
                const int c0 = wc * 32 + bj * 128 + n * 16, r0 = rb + ai * 128 + m * 16;
                const f32x4 v = acc[ai][bj][m][n];
                uint2 o; o.x = pk_bf16(v[0], v[1]); o.y = pk_bf16(v[2], v[3]);
                *(uint2*)(vTa + (long)c0 * T + r0 + lo) = o;
                if (mt < 32) {
                  float* ov = outv + (long)(r0 + fq * 4) * 256 + c0 + fr;
                  ov[0] = v[0]; ov[256] = v[1]; ov[512] = v[2]; ov[768] = v[3];
                }
                if (bj == 1 && n == 1) asm volatile("" ::: "memory");
              }
      } else {
      bf16_t* vT = (bf16_t*)p.big1() + (long)T * 2048;
      float* vsq = p.vsq() + (long)aux * T;
#pragma unroll
      for (int ai = 0; ai < 2; ++ai)
#pragma unroll
        for (int m = 0; m < 4; ++m) {
          float sq[4] = {0.f, 0.f, 0.f, 0.f};
#pragma unroll
          for (int bj = 0; bj < 2; ++bj)
#pragma unroll
            for (int n = 0; n < 2; ++n) {
              float z0 = gelu_f(acc[ai][bj][m][n][0]), z1 = gelu_f(acc[ai][bj][m][n][1]), z2 = gelu_f(acc[ai][bj][m][n][2]), z3 = gelu_f(acc[ai][bj][m][n][3]);
              sq[0] += z0 * z0; sq[1] += z1 * z1; sq[2] += z2 * z2; sq[3] += z3 * z3;
              uint2 o; o.x = pk_bf16(z0, z1); o.y = pk_bf16(z2, z3);
              bf16_t* sb = vT + (long)(cb - 2048 + bj * 128 + n * 16) * T + rb + ai * 128 + m * 16;
              *(uint2*)(sb + lo) = o;
            }
#pragma unroll
          for (int j = 0; j < 4; ++j) {
            float s = sq[j];
            s += __shfl_xor(s, 1); s += __shfl_xor(s, 2); s += __shfl_xor(s, 4); s += __shfl_xor(s, 8);
            if (fr == 0) atomicAdd(vsq + rb + ai * 128 + m * 16 + fq * 4 + j, s);
          }
          asm volatile("" ::: "memory");
        }
      }
    } else {
    gemm256<true, R192>(At, At + (long)128 * lda, lda, B0, B1, ldb, K >> 6, smem, acc, tid, was_pre, has_next, nAt, nAt + (long)128 * lda, nB0, nB1);
    EPI_IDS()
    if constexpr (KIND == G_GMLP_IN || KIND == G_QKV || KIND == G_FFN_IN) {
      if (fx >= 0) {
        const float* rq = p.rowsq() + (long)fx * T + rb + fr;
        const float* sw = p.shw() + ((long)fx * 3 + cond_of_row(mt * 256)) * 5632 + (KIND == G_FFN_IN ? nt * 128 + wc * 32 : cb) + fq * 4;
        float rr[2][4];
#pragma unroll
        for (int ai = 0; ai < 2; ++ai)
#pragma unroll
          for (int m = 0; m < 4; ++m) rr[ai][m] = rsqrtf(rq[ai * 128 + m * 16] * (1.f / 1024.f) + 1e-6f);
#pragma unroll
        for (int bj = 0; bj < 2; ++bj)
#pragma unroll
          for (int n = 0; n < 2; ++n) {
            const float4 sv = *(const float4*)(sw + (KIND == G_FFN_IN ? bj * 2816 : bj * 128) + n * 16);
#pragma unroll
            for (int ai = 0; ai < 2; ++ai)
#pragma unroll
              for (int m = 0; m < 4; ++m) {
                f32x4 v = acc[ai][bj][m][n];
                const float r = rr[ai][m];
                v[0] = r * v[0] + sv.x; v[1] = r * v[1] + sv.y; v[2] = r * v[2] + sv.z; v[3] = r * v[3] + sv.w;
                acc[ai][bj][m][n] = v;
              }
          }
      }
    }
    if constexpr (KIND == G_RESID || KIND == G_POOL) {
      const unsigned lo = (unsigned)(fr * 1024 + fq * 4);
      const bool fz = fx >= 0;
      const float* gvec = ((fx & 1) ? p.g_ffn : p.g_mix) + (fx >> 1) * 1024;
      const int nai = wr == 0 ? 2 : 1;
      const unsigned voffx = lo * 4u;
      float4 gvq[4];
#pragma unroll
      for (int q = 0; q < 4; ++q) gvq[q] = fz ? *(const float4*)(gvec + cb + fq * 4 + (q >> 1) * 128 + (q & 1) * 16) : make_float4(0.f, 0.f, 0.f, 0.f);
#pragma unroll
      for (int ai = 0; ai < 2; ++ai) {
        if (ai < nai) {
          f32x4 xr[4][4];
#pragma unroll
          for (int m = 0; m < 4; ++m)
#pragma unroll
            for (int q = 0; q < 4; ++q) {
              const float* bp = p.xo() + (long)(rb + ai * 128 + m * 16) * 1024 + cb + (q >> 1) * 128 + (q & 1) * 16;
              asm volatile("global_load_dwordx4 %0, %1, %2" : "=v"(xr[m][q]) : "v"(voffx), "s"(bp) : "memory");
            }
          asm volatile("s_waitcnt vmcnt(0)" ::: "memory");
#pragma unroll
          for (int m = 0; m < 4; ++m) {
            const int row = rb + ai * 128 + m * 16 + fr;
            const int cnd = cond_of_row(rb + ai * 128 + m * 16);
            const float* gate = p.mod() + ((long)layer * 3 + cnd) * 6144 + aux + cb + fq * 4;
            const float* scv = p.mod() + ((long)(fx >> 1) * 3 + cnd) * 6144 + ((fx & 1) ? 4096 : 1024) + cb + fq * 4;
            float rsum = 0.f;
#pragma unroll
            for (int bj = 0; bj < 2; ++bj)
#pragma unroll
              for (int n = 0; n < 2; ++n) {
                const int co = bj * 128 + n * 16;
                const float4 g = *(const float4*)(gate + co);
                float4 pb = make_float4(0.f, 0.f, 0.f, 0.f), ps = make_float4(1.f, 1.f, 1.f, 1.f);
                if constexpr (KIND == G_POOL) { pb = *(const float4*)(p.p_b + cb + fq * 4 + co); ps = *(const float4*)(p.p_scale + cb + fq * 4 + co); }
                const long eo = (long)(rb + ai * 128 + m * 16) * 1024 + cb + co;
                float4* xp = (float4*)(p.xo() + eo + lo);
                const f32x4 xl = xr[m][bj * 2 + n];
                float4 x = make_float4(xl[0], xl[1], xl[2], xl[3]);
                const f32x4 v = acc[ai][bj][m][n];
                x.x += g.x * ((v[0] + pb.x) * ps.x); x.y += g.y * ((v[1] + pb.y) * ps.y);
                x.z += g.z * ((v[2] + pb.z) * ps.z); x.w += g.w * ((v[3] + pb.w) * ps.w);
                *xp = x;
                if (fz) {
                  const float4 gv = gvq[bj * 2 + n], sc = *(const float4*)(scv + co);
                  rsum += x.x * x.x + x.y * x.y + x.z * x.z + x.w * x.w;
                  uint2 o; o.x = pk_bf16(x.x * gv.x * (1.f + sc.x), x.y * gv.y * (1.f + sc.y)); o.y = pk_bf16(x.z * gv.z * (1.f + sc.z), x.w * gv.w * (1.f + sc.w));
                  *(uint2*)(p.h() + eo + lo) = o;
                }
              }
            if (fz) {
              rsum += __shfl_xor(rsum, 16); rsum += __shfl_xor(rsum, 32);
              if (fq == 0) atomicAdd(p.rowsq() + (long)fx * T + row, rsum);
            }
            asm volatile("" ::: "memory");
          }
        }
      }
    } else if constexpr (KIND == G_GMLP_IN) {
      bf16_t* u = (bf16_t*)p.big1();
      const unsigned lo = (unsigned)(fr * 2048 + fq * 4);
#pragma unroll
      for (int ai = 0; ai < 2; ++ai)
#pragma unroll
        for (int m = 0; m < 4; ++m)
#pragma unroll
          for (int bj = 0; bj < 2; ++bj)
#pragma unroll
            for (int n = 0; n < 2; ++n) {
              bf16_t* sb = u + (long)(rb + ai * 128 + m * 16) * 2048 + cb + bj * 128 + n * 16;
              const f32x4 v = acc[ai][bj][m][n];
              uint2 o; o.x = pk_bf16(gelu_f(v[0]), gelu_f(v[1])); o.y = pk_bf16(gelu_f(v[2]), gelu_f(v[3]));
              *(uint2*)(sb + lo) = o;
              if (bj == 1 && n == 1) asm volatile("" ::: "memory");
            }
    } else if constexpr (KIND == G_QKV) {
      float* part = (float*)(smem + 131072 + 16 + 4096);
      float rinv[2][2][4];
#pragma unroll
      for (int ai = 0; ai < 2; ++ai)
#pragma unroll
        for (int bj = 0; bj < 2; ++bj)
#pragma unroll
          for (int m = 0; m < 4; ++m) {
            const f32x4 a = acc[ai][bj][m][0], b = acc[ai][bj][m][1];
            float sq = a[0] * a[0] + a[1] * a[1] + a[2] * a[2] + a[3] * a[3] + b[0] * b[0] + b[1] * b[1] + b[2] * b[2] + b[3] * b[3];
            sq += __shfl_xor(sq, 16); sq += __shfl_xor(sq, 32);
            rinv[ai][bj][m] = sq;
            if (fq == 0) part[((wid * 2 + ai) * 2 + bj) * 64 + m * 16 + fr] = sq;
          }
      __syncthreads();
      {
        const int pw = wid ^ 1;
#pragma unroll
        for (int ai = 0; ai < 2; ++ai)
#pragma unroll
          for (int bj = 0; bj < 2; ++bj)
#pragma unroll
            for (int m = 0; m < 4; ++m)
              rinv[ai][bj][m] = rsqrtf((rinv[ai][bj][m] + part[((pw * 2 + ai) * 2 + bj) * 64 + m * 16 + fr]) * (1.f / 64.f) + 1e-6f);
      }
      const bool latt = mt >= 32;
      const float* gam = (nt < 4 ? p.c_g_q : p.c_g_k) + (wc & 1) * 32 + fq * 4;
      const float4 g0 = *(const float4*)(gam), g1 = *(const float4*)(gam + 16);
      float finv[4];
#pragma unroll
      for (int j = 0; j < 4; ++j) finv[j] = exp2f(-(float)(fq * 4 + j) * 0.8304820237218406f);
      bf16_t* qb = (bf16_t*)p.big2();
      bf16_t* kb = qb + (long)T * 1024;
      float* outk = p.xo() + (long)T * 1024;
      const float qs = nt < 4 ? 0.125f * LOG2E : 1.f;
#pragma unroll
      for (int ai = 0; ai < 2; ++ai)
#pragma unroll
        for (int m = 0; m < 4; ++m) {
          const int R = rb + ai * 128 + m * 16 + fr;
          float cs[4] = {1.f, 1.f, 1.f, 1.f}, sn[4] = {0.f, 0.f, 0.f, 0.f};
          if (latt) {
            const int sp = (R - TCTX) & 2047;
            const float pos = (float)((wc & 1) ? (sp & 63) : (sp >> 6));
#pragma unroll
            for (int j = 0; j < 4; ++j) { const float ang = pos * finv[j]; cs[j] = __cosf(ang); sn[j] = __sinf(ang); }
          }
#pragma unroll
          for (int bj = 0; bj < 2; ++bj) {
            const float r = rinv[ai][bj][m];
            const f32x4 av = acc[ai][bj][m][0], bv = acc[ai][bj][m][1];
            float a[4] = {av[0] * r * g0.x, av[1] * r * g0.y, av[2] * r * g0.z, av[3] * r * g0.w};
            float b[4] = {bv[0] * r * g1.x, bv[1] * r * g1.y, bv[2] * r * g1.z, bv[3] * r * g1.w};
#pragma unroll
            for (int j = 0; j < 4; ++j) { const float na = a[j] * cs[j] - b[j] * sn[j], nb = a[j] * sn[j] + b[j] * cs[j]; a[j] = na; b[j] = nb; }
            const int cl = bj * 128 + wc * 32 + fq * 4;
            uint2 oa, ob2;
            oa.x = pk_bf16(a[0] * qs, a[1] * qs); oa.y = pk_bf16(a[2] * qs, a[3] * qs);
            ob2.x = pk_bf16(b[0] * qs, b[1] * qs); ob2.y = pk_bf16(b[2] * qs, b[3] * qs);
            if (nt < 4) {
              bf16_t* dst = qb + (long)R * 1024 + nt * 256 + cl;
              *(uint2*)dst = oa; *(uint2*)(dst + 16) = ob2;
            } else {
              bf16_t* dst = kb + (long)R * 256 + cl;
              *(uint2*)dst = oa; *(uint2*)(dst + 16) = ob2;
              if (!latt) {
                float* od = outk + (long)R * 256 + cl;
                *(float4*)od = make_float4(a[0], a[1], a[2], a[3]); *(float4*)(od + 16) = make_float4(b[0], b[1], b[2], b[3]);
              }
            }
          }
          asm volatile("" ::: "memory");
        }
    } else {
      float* edge = (float*)(smem + 131072 + 16);
      const int ecol = wc * 32 + fq * 4;
      if (fr == 0 || fr == 15) {
#pragma unroll
        for (int ai = 0; ai < 2; ++ai)
#pragma unroll
          for (int n = 0; n < 2; ++n) {
            const f32x4 v = fr == 0 ? acc[ai][0][0][n] : acc[ai][0][3][n];
            *(float4*)(edge + ((ai * 2 + wr) * 2 + (fr == 0 ? 0 : 1)) * 128 + ecol + n * 16) = make_float4(v[0], v[1], v[2], v[3]);
          }
      }
      if (mt >= 32) {
        const int lt = mt - 32;
        if (wid < 4 && fr < 2) {
#pragma unroll
          for (int n = 0; n < 2; ++n) {
            const f32x4 v = acc[0][0][0][n];
            *(float4*)(p.ha() + ((long)(lt * 4 + fr)) * 2816 + nt * 128 + ecol + n * 16) = make_float4(v[0], v[1], v[2], v[3]);
            if (fr == 0) { const f32x4 uv = acc[0][1][0][n]; *(float4*)(p.hu() + ((long)(lt * 2 + 0)) * 2816 + nt * 128 + ecol + n * 16) = make_float4(uv[0], uv[1], uv[2], uv[3]); }
          }
        }
        if (wid >= 4 && fr >= 14) {
#pragma unroll
          for (int n = 0; n < 2; ++n) {
            const f32x4 v = acc[1][0][3][n];
            *(float4*)(p.ha() + ((long)(lt * 4 + 2 + (fr - 14))) * 2816 + nt * 128 + ecol + n * 16) = make_float4(v[0], v[1], v[2], v[3]);
            if (fr == 15) { const f32x4 uv = acc[1][1][3][n]; *(float4*)(p.hu() + ((long)(lt * 2 + 1)) * 2816 + nt * 128 + ecol + n * 16) = make_float4(uv[0], uv[1], uv[2], uv[3]); }
          }
        }
      }
      __syncthreads();
      bf16_t* gbuf = (bf16_t*)p.big2();
      const float* cwp = p.ffn_conv_w + (long)layer * 3 * 2816 + nt * 128 + ecol;
      const float* cbp = p.ffn_conv_b + (long)layer * 2816 + nt * 128 + ecol;
      const unsigned lo = (unsigned)(fr * 2816 + fq * 4);
#pragma unroll
      for (int n = 0; n < 2; ++n) {
        const float4 w0 = *(const float4*)(cwp + n * 16), w1 = *(const float4*)(cwp + 2816 + n * 16), w2 = *(const float4*)(cwp + 5632 + n * 16), bb = *(const float4*)(cbp + n * 16);
        const float w0a[4] = {w0.x, w0.y, w0.z, w0.w}, w1a[4] = {w1.x, w1.y, w1.z, w1.w}, w2a[4] = {w2.x, w2.y, w2.z, w2.w}, bba[4] = {bb.x, bb.y, bb.z, bb.w};
#pragma unroll
        for (int ai = 0; ai < 2; ++ai) {
          float4 ep = make_float4(0.f, 0.f, 0.f, 0.f), en = make_float4(0.f, 0.f, 0.f, 0.f);
          if (wr == 1) ep = *(const float4*)(edge + ((ai * 2 + 0) * 2 + 1) * 128 + ecol + n * 16);
          else if (ai == 1) ep = *(const float4*)(edge + ((0 * 2 + 1) * 2 + 1) * 128 + ecol + n * 16);
          if (wr == 0) en = *(const float4*)(edge + ((ai * 2 + 1) * 2 + 0) * 128 + ecol + n * 16);
          else if (ai == 0) en = *(const float4*)(edge + ((1 * 2 + 0) * 2 + 0) * 128 + ecol + n * 16);
          const float epa[4] = {ep.x, ep.y, ep.z, ep.w}, ena[4] = {en.x, en.y, en.z, en.w};
          float gq[4][4];
#pragma unroll
          for (int j = 0; j < 4; ++j) {
            float U[4], Dn[4];
#pragma unroll
            for (int m = 0; m < 4; ++m) { U[m] = row_ror1(acc[ai][0][m][n][j]); Dn[m] = row_ror15(acc[ai][0][m][n][j]); }
#pragma unroll
            for (int m = 0; m < 4; ++m) {
              const float prev = fr == 0 ? (m > 0 ? U[m > 0 ? m - 1 : 0] : epa[j]) : U[m];
              const float next = fr == 15 ? (m < 3 ? Dn[m < 3 ? m + 1 : 3] : ena[j]) : Dn[m];
              const float x = w0a[j] * prev + w1a[j] * acc[ai][0][m][n][j] + w2a[j] * next + bba[j];
              gq[m][j] = gelu_f(x) * acc[ai][1][m][n][j];
            }
          }
#pragma unroll
          for (int m = 0; m < 4; ++m) {
            bf16_t* sb = gbuf + (long)(rb + ai * 128 + m * 16) * 2816 + nt * 128 + wc * 32 + n * 16;
            uint2 o; o.x = pk_bf16(gq[m][0], gq[m][1]); o.y = pk_bf16(gq[m][2], gq[m][3]);
            *(uint2*)(sb + lo) = o;
          }
        }
      }
    }
    }
  }
}

__device__ void phase_spatial(const P& p, int j, char* smem) {
  const int tid = opaque_tid(), lane = tid & 63, w = __builtin_amdgcn_readfirstlane(tid >> 6), wm = w >> 1, wn = w & 1, l31 = lane & 31, hh = lane >> 5;
  const int c = tid & 7, r0 = tid >> 3;
  const bf16_t* u = (const bf16_t*)p.big1();
  const bf16_t* vT = u + (long)T * 2048;
  bf16_t* tt = (bf16_t*)p.big2();
  const float* vsq = p.vsq() + (long)j * T;
  for (int item = opaque_bid(); item < 96 * 8; item += gridDim.x) {
    const int g = item & 7, chunk = item >> 3;
    const float* ws = p.a_w_s + ((long)(j * 8 + g) * 128) * 128;
#pragma unroll 1
    for (int kt = 0; kt < 2; ++kt) {
      float rs[8];
      {
        const float4 q0 = *(const float4*)(vsq + chunk * 128 + kt * 64 + c * 8), q1 = *(const float4*)(vsq + chunk * 128 + kt * 64 + c * 8 + 4);
        rs[0] = rsqrtf(q0.x * (1.f / 2048.f) + 1e-6f); rs[1] = rsqrtf(q0.y * (1.f / 2048.f) + 1e-6f);
        rs[2] = rsqrtf(q0.z * (1.f / 2048.f) + 1e-6f); rs[3] = rsqrtf(q0.w * (1.f / 2048.f) + 1e-6f);
        rs[4] = rsqrtf(q1.x * (1.f / 2048.f) + 1e-6f); rs[5] = rsqrtf(q1.y * (1.f / 2048.f) + 1e-6f);
        rs[6] = rsqrtf(q1.z * (1.f / 2048.f) + 1e-6f); rs[7] = rsqrtf(q1.w * (1.f / 2048.f) + 1e-6f);
      }
#pragma unroll
      for (int i = 0; i < 2; ++i) {
        const int r = r0 + 64 * i;
        const float4 a = *(const float4*)(ws + r * 128 + kt * 64 + c * 8), b = *(const float4*)(ws + r * 128 + kt * 64 + c * 8 + 4);
        uint4 o;
        o.x = pk_bf16(a.x * rs[0], a.y * rs[1]); o.y = pk_bf16(a.z * rs[2], a.w * rs[3]);
        o.z = pk_bf16(b.x * rs[4], b.y * rs[5]); o.w = pk_bf16(b.z * rs[6], b.w * rs[7]);
        *(uint4*)(smem + kt * 16384 + tile_off(r, c)) = o;
      }
#pragma unroll
      for (int i = 0; i < 4; ++i) {
        const int r = r0 + 64 * i;
        const uint4 bv = *(const uint4*)(vT + (long)(g * 256 + r) * T + chunk * 128 + kt * 64 + c * 8);
        *(uint4*)(smem + 32768 + kt * 32768 + tile_off(r, c)) = bv;
      }
    }
    __syncthreads();
    f32x16 acc[2][2];
#pragma unroll
    for (int mb = 0; mb < 2; ++mb)
#pragma unroll
      for (int nb = 0; nb < 2; ++nb)
#pragma unroll
        for (int i = 0; i < 16; ++i) acc[mb][nb][i] = 0.f;
    compute_ktile<false>(smem + 32768, smem, acc, wm, wn, lane);
    compute_ktile<false>(smem + 65536, smem + 16384, acc, wm, wn, lane);
    __syncthreads();
    float* svt = (float*)smem;
#pragma unroll
    for (int nb = 0; nb < 2; ++nb) {
      const int tok = wn * 64 + nb * 32 + l31;
#pragma unroll
      for (int mb = 0; mb < 2; ++mb)
#pragma unroll
        for (int q = 0; q < 4; ++q)
          *(float4*)(svt + tok * 260 + wm * 64 + mb * 32 + 8 * q + 4 * hh) = make_float4(acc[mb][nb][4 * q], acc[mb][nb][4 * q + 1], acc[mb][nb][4 * q + 2], acc[mb][nb][4 * q + 3]);
    }
    __syncthreads();
    {
      const int ch8 = (tid & 31) * 8;
      const float4 gv0 = *(const float4*)(p.a_g_v + j * 2048 + g * 256 + ch8), gv1 = *(const float4*)(p.a_g_v + j * 2048 + g * 256 + ch8 + 4);
#pragma unroll
      for (int it = 0; it < 8; ++it) {
        const int tok = (tid >> 5) + 16 * it;
        const float bs = p.a_b_s[(j * 8 + g) * 128 + tok];
        const float4 s0 = *(const float4*)(svt + tok * 260 + ch8), s1 = *(const float4*)(svt + tok * 260 + ch8 + 4);
        const long ro = (long)(chunk * 128 + tok) * 2048 + g * 256 + ch8;
        const uint4 uu = *(const uint4*)(u + ro);
        uint4 o;
        o.x = pk_bf16(bflo(uu.x) * (gv0.x * s0.x + bs), bfhi(uu.x) * (gv0.y * s0.y + bs));
        o.y = pk_bf16(bflo(uu.y) * (gv0.z * s0.z + bs), bfhi(uu.y) * (gv0.w * s0.w + bs));
        o.z = pk_bf16(bflo(uu.z) * (gv1.x * s1.x + bs), bfhi(uu.z) * (gv1.y * s1.y + bs));
        o.w = pk_bf16(bflo(uu.w) * (gv1.z * s1.z + bs), bfhi(uu.w) * (gv1.w * s1.w + bs));
        *(uint4*)(tt + ro) = o;
      }
    }
    __syncthreads();
  }
}

__device__ __forceinline__ void attn_block_lds(const char* __restrict__ Ks, const char* __restrict__ Vs, bool masked, int kpos0, int qpos,
                                               const bf16x8 (&bq)[4], float& m, float& lsum, f32x16& o0, f32x16& o1, int l31, int hh) {
  f32x16 s[2];
#pragma unroll
  for (int sb = 0; sb < 2; ++sb) {
#pragma unroll
    for (int i = 0; i < 16; ++i) s[sb][i] = 0.f;
#pragma unroll
    for (int ks = 0; ks < 4; ++ks) {
      const bf16x8 a = *(const bf16x8*)(Ks + tile_off(sb * 32 + l31, ks * 2 + hh));
      s[sb] = __builtin_amdgcn_mfma_f32_32x32x16_bf16(a, bq[ks], s[sb], 0, 0, 0);
    }
  }
  if (masked) {
#pragma unroll
    for (int sb = 0; sb < 2; ++sb)
#pragma unroll
      for (int i = 0; i < 16; ++i) {
        int dlt = qpos - (kpos0 + sb * 32 + crow(i, hh));
        dlt = dlt < 0 ? -dlt : dlt;
        if (dlt > 128) s[sb][i] = -1e30f;
      }
  }
  float mx = s[0][0];
#pragma unroll
  for (int sb = 0; sb < 2; ++sb)
#pragma unroll
    for (int i = 0; i < 16; ++i) mx = fmaxf(mx, s[sb][i]);
  mx = fmaxf(mx, __shfl_xor(mx, 32));
  const float mnew = fmaxf(m, mx);
  const float alpha = __builtin_amdgcn_exp2f(m - mnew);
  m = mnew;
  float ps = 0.f;
#pragma unroll
  for (int sb = 0; sb < 2; ++sb)
#pragma unroll
    for (int i = 0; i < 16; ++i) { s[sb][i] = __builtin_amdgcn_exp2f(s[sb][i] - mnew); ps += s[sb][i]; }
  lsum = lsum * alpha + ps;
#pragma unroll
  for (int i = 0; i < 16; ++i) { o0[i] *= alpha; o1[i] *= alpha; }
  const int sw0 = (l31 >> 1) & 7;
#pragma unroll
  for (int sb = 0; sb < 2; ++sb)
#pragma unroll
    for (int st = 0; st < 2; ++st) {
      uint4 pw;
      pw.x = pk_bf16(s[sb][8 * st + 0], s[sb][8 * st + 1]); pw.y = pk_bf16(s[sb][8 * st + 2], s[sb][8 * st + 3]);
      pw.z = pk_bf16(s[sb][8 * st + 4], s[sb][8 * st + 5]); pw.w = pk_bf16(s[sb][8 * st + 6], s[sb][8 * st + 7]);
      const bf16x8 pb = __builtin_bit_cast(bf16x8, pw);
      const int c0 = 4 * sb + 2 * st;
      const char* v0 = Vs + l31 * 128 + 8 * hh;
      uint4 va;
      { const uint2 lo = *(const uint2*)(v0 + ((c0 ^ sw0) << 4)), hi = *(const uint2*)(v0 + (((c0 + 1) ^ sw0) << 4)); va.x = lo.x; va.y = lo.y; va.z = hi.x; va.w = hi.y; }
      o0 = __builtin_amdgcn_mfma_f32_32x32x16_bf16(__builtin_bit_cast(bf16x8, va), pb, o0, 0, 0, 0);
      { const uint2 lo = *(const uint2*)(v0 + 4096 + ((c0 ^ sw0) << 4)), hi = *(const uint2*)(v0 + 4096 + (((c0 + 1) ^ sw0) << 4)); va.x = lo.x; va.y = lo.y; va.z = hi.x; va.w = hi.y; }
      o1 = __builtin_amdgcn_mfma_f32_32x32x16_bf16(__builtin_bit_cast(bf16x8, va), pb, o1, 0, 0, 0);
    }
}

__device__ void phase_attn(const P& p, char* smem) {
  const int tid = opaque_tid(), lane = tid & 63, w = __builtin_amdgcn_readfirstlane(tid >> 6), l31 = lane & 31, hh = lane >> 5;
  const int kr = tid >> 3, kc = tid & 7;
  const bf16_t* qb = (const bf16_t*)p.big2();
  const bf16_t* kb = qb + (long)T * 1024;
  const bf16_t* vTa = kb + (long)T * 256;
  bf16_t* ob = (bf16_t*)(vTa + (long)256 * T);
  const int lo_off = tile_off(kr, kc);
  for (int item = opaque_bid(); item < 768; item += gridDim.x) {
    const bool lat = item >= 512;
    int tok0, head, qblk, b;
    if (!lat) { b = item >> 4; head = item & 15; qblk = 0; tok0 = b * 256; }
    else { const int it = item - 512; b = it >> 7; head = (it >> 3) & 15; qblk = it & 7; tok0 = TCTX + b * 2048; }
    const int kvh = head >> 2;
    const int qloc = qblk * 256 + w * 32;
    const long qrow = tok0 + qloc + l31;
    bf16x8 bq[4];
#pragma unroll
    for (int ks = 0; ks < 4; ++ks) bq[ks] = *(const bf16x8*)(qb + qrow * 1024 + head * 64 + ks * 16 + hh * 8);
    float m = p.c_sink[head] * LOG2E;
    float lsum = hh == 0 ? 1.f : 0.f;
    f32x16 o0, o1;
#pragma unroll
    for (int i = 0; i < 16; ++i) { o0[i] = 0.f; o1[i] = 0.f; }
    int wlo = 0, nwin = 4;
    if (lat) {
      wlo = qblk * 256 - 128; wlo = wlo < 0 ? 0 : wlo;
      int whi = qblk * 256 + 384; whi = whi > 2048 ? 2048 : whi;
      nwin = (whi - wlo) >> 6;
    }
    const int nblk = lat ? nwin + 4 : 4;
    const bf16_t* kwin = kb + (long)(tok0 + wlo + kr) * 256 + kvh * 64 + kc * 8;
    const bf16_t* vwin = vTa + (long)(kvh * 64 + kr) * T + tok0 + wlo + kc * 8;
    const bf16_t* kcach = p.ck() + (long)(b * 256 + kr) * 256 + kvh * 64 + kc * 8;
    const bf16_t* vcach = p.cvT() + (long)(b * 256 + kvh * 64 + kr) * 256 + kc * 8;
    uint4 rk, rv;
    rk = gld16(kwin); rv = gld16(vwin);
    asm volatile("s_waitcnt vmcnt(0)" ::: "memory");
    *(uint4*)(smem + lo_off) = rk; *(uint4*)(smem + 8192 + lo_off) = rv;
    __syncthreads();
    for (int bi = 0; bi < nblk; ++bi) {
      const bool more = bi + 1 < nblk;
      if (more) {
        const int nb = bi + 1;
        if (nb < nwin) { rk = gld16(kwin + (long)nb * 64 * 256); rv = gld16(vwin + nb * 64); }
        else { rk = gld16(kcach + (long)(nb - nwin) * 64 * 256); rv = gld16(vcach + (nb - nwin) * 64); }
      }
      const char* Ks = smem + (bi & 1) * 16384;
      if (bi < nwin) {
        const int k0 = wlo + 64 * bi;
        if (!lat) attn_block_lds(Ks, Ks + 8192, false, 0, 0, bq, m, lsum, o0, o1, l31, hh);
        else if (!(k0 + 63 < qloc - 128 || k0 > qloc + 31 + 128)) attn_block_lds(Ks, Ks + 8192, true, k0, qloc + l31, bq, m, lsum, o0, o1, l31, hh);
      } else {
        attn_block_lds(Ks, Ks + 8192, false, 0, 0, bq, m, lsum, o0, o1, l31, hh);
      }
      if (more) {
        asm volatile("s_waitcnt vmcnt(0)" ::: "memory");
        char* Kn = smem + ((bi + 1) & 1) * 16384;
        *(uint4*)(Kn + lo_off) = rk; *(uint4*)(Kn + 8192 + lo_off) = rv;
      }
      __syncthreads();
    }
    lsum += __shfl_xor(lsum, 32);
    const float inv = 1.f / lsum;
#pragma unroll
    for (int q = 0; q < 4; ++q) {
      uint2 v0, v1;
      v0.x = pk_bf16(o0[4 * q] * inv, o0[4 * q + 1] * inv); v0.y = pk_bf16(o0[4 * q + 2] * inv, o0[4 * q + 3] * inv);
      v1.x = pk_bf16(o1[4 * q] * inv, o1[4 * q + 1] * inv); v1.y = pk_bf16(o1[4 * q + 2] * inv, o1[4 * q + 3] * inv);
      *(uint2*)(ob + qrow * 1024 + head * 64 + 8 * q + 4 * hh) = v0;
      *(uint2*)(ob + qrow * 1024 + head * 64 + 32 + 8 * q + 4 * hh) = v1;
    }
  }
}

enum { OP_PREP, OP_FIRST, OP_NORM_MIX, OP_GMLP_IN, OP_SPATIAL, OP_GMLP_OUT, OP_FFN_IN, OP_FFN_FIX, OP_FFN_OUT, OP_POOL, OP_POOL_GEMM, OP_QKV, OP_QKPREP, OP_ATTN, OP_WO };
__constant__ unsigned char c_prog[NPH][2] = {
    {OP_PREP, 0}, {OP_FIRST, 0},
    {OP_GMLP_IN, 0}, {OP_SPATIAL, 0}, {OP_GMLP_OUT, 0}, {OP_FFN_IN, 0}, {OP_FFN_OUT, 0},
    {OP_POOL_GEMM, 1}, {OP_FFN_IN, 1}, {OP_FFN_OUT, 1},
    {OP_QKV, 2}, {OP_ATTN, 2}, {OP_WO, 2}, {OP_FFN_IN, 2}, {OP_FFN_OUT, 2},
    {OP_GMLP_IN, 3}, {OP_SPATIAL, 3}, {OP_GMLP_OUT, 3}, {OP_FFN_IN, 3}, {OP_FFN_OUT, 3}};

__device__ void run_phase(const P& p0, int ph, char* smem) {
  P p = p0;
  asm volatile("" : "+s"(p.ws), "+s"(p.out_g));
  const int op = c_prog[ph][0], layer = c_prog[ph][1];
  const int j = layer / 3;
  switch (op) {
    case OP_PREP: phase_prep(p, smem); break;
    case OP_FIRST: phase_norm(p, 0, 0, true); phase_shw(p, 0, 5632, 0, 0, false); break;
    case OP_NORM_MIX: phase_norm(p, layer, 0, false); break;
    case OP_GMLP_IN: {
      const int fx = layer == 0 ? -1 : 2 * layer;
      phase_gemm<G_GMLP_IN>(p, p.h(), 1024, p.wt_a_in() + (long)j * 4096 * 1024, 1024, 1024, 8, layer, j, fx, smem);
      phase_gemm<G_GMLP_V>(p, p.h(), 1024, p.wt_a_in() + (long)j * 4096 * 1024, 1024, 1024, 8, layer, j, fx, smem);
    } break;
    case OP_SPATIAL: phase_spatial(p, j, smem); break;
    case OP_GMLP_OUT: phase_gemm<G_RESID>(p, (const bf16_t*)p.big2(), 2048, p.wt_a_out() + (long)j * 1024 * 2048, 2048, 2048, 4, layer, 2048, 2 * layer + 1, smem); break;
    case OP_FFN_IN:
      phase_gemm<G_FFN_IN>(p, p.h(), 1024, p.wt_ffn_in() + (long)layer * 5632 * 1024, 1024, 1024, 22, layer, 0, 2 * layer + 1, smem);
      if (layer < 3) phase_filler(p, layer + 1, smem);
      break;
    case OP_FFN_OUT:
      phase_gemm<G_RESID>(p, (const bf16_t*)p.big2(), 2816, p.wt_ffn_out() + (long)layer * 1024 * 2816, 2816, 2816, 4, layer, 5120, layer <= 2 ? 2 * layer + 2 : -1, smem);
      if (layer == 0) phase_shw(p, 5632, 11264, 0, 0, true);
      else if (layer == 1) phase_shw(p, 11264, 16896, 22528, 24064, true);
      else if (layer == 2) phase_shw(p, 16896, 22528, 24064, 28160, true);
      break;
    case OP_POOL_GEMM: phase_gemm<G_POOL>(p, (const bf16_t*)p.big1(), 1024, p.wt_p(), 256, 256, 4, layer, 2048, 2 * layer + 1, smem); break;
    case OP_QKV:
      phase_gemm<G_QKV>(p, p.h(), 1024, p.wt_qkv(), 1024, 1024, 5, layer, 0, 2 * layer, smem);
      phase_gemm<G_QKV_V>(p, p.h(), 1024, p.wt_qkv(), 1024, 1024, 1, layer, 0, 2 * layer, smem);
      break;
    case OP_ATTN: phase_attn(p, smem); break;
    default: phase_gemm<G_RESID>(p, (const bf16_t*)p.big2() + (long)T * 1024 + (long)T * 256 + (long)256 * T, 1024, p.wt_o(), 1024, 1024, 4, layer, 2048, 2 * layer + 1, smem); break;
  }
}

#define XB_TMO      128
#define XB_XCNT(j)  (256  + 64 * (j))
#define XB_XSUB(j)  (1280 + 64 * (j))
#define XB_XGEN(j)  (2304 + 64 * (j))
#define XB_TOP      3328
#define XB_TOPGEN   3392
#define XCD_BAR_WORDS 3456
#define XB_SPIN_CAP (1u << 22)
#define LAS __attribute__((address_space(3)))
__device__ __forceinline__ unsigned xb_ld(unsigned* p) { return __hip_atomic_load(p, __ATOMIC_RELAXED, __HIP_MEMORY_SCOPE_AGENT); }
__device__ __forceinline__ unsigned xb_add(unsigned* p, unsigned v) { return __hip_atomic_fetch_add(p, v, __ATOMIC_RELAXED, __HIP_MEMORY_SCOPE_AGENT); }
__device__ __forceinline__ unsigned xb_xcc_id() { return (unsigned)__builtin_amdgcn_s_getreg((3 << 11) | 20) & 0xFu; }
#define XB_SPIN(cond, bar) do { unsigned _sp = 0; while (cond) { __builtin_amdgcn_s_sleep(1); \
    if ((++_sp & 255u) == 0u) { if (xb_ld(&(bar)[XB_TMO])) break; if (_sp > XB_SPIN_CAP) { atomicAdd(&(bar)[XB_TMO], 1u); break; } } } } while (0)
struct XcdBarrier { unsigned* bar; unsigned x; volatile LAS unsigned* st; };
__device__ __forceinline__ XcdBarrier xcd_barrier_post(unsigned* bar, volatile LAS unsigned* st) {
  XcdBarrier b; b.bar = bar; b.x = xb_xcc_id(); b.st = st;
  if (threadIdx.x == 0) (void)xb_add(&bar[XB_XCNT(b.x)], 1u);
  return b;
}
__device__ __forceinline__ void xcd_barrier_complete(unsigned* bar, unsigned x, unsigned& nloc, unsigned& nx) {
  const unsigned G = gridDim.x * gridDim.y * gridDim.z;
  unsigned sum, cnt, mine, sp = 0u;
  for (;;) {
    sum = 0u; cnt = 0u; mine = 0u;
#pragma unroll
    for (unsigned j = 0; j < 16; ++j) { const unsigned c = xb_ld(&bar[XB_XCNT(j)]); sum += c; cnt += (c > 0u) ? 1u : 0u; mine = (j == x) ? c : mine; }
    if (sum == G) break;
    __builtin_amdgcn_s_sleep(1);
    if ((++sp & 255u) == 0u) { if (xb_ld(&bar[XB_TMO])) break; if (sp > XB_SPIN_CAP) { atomicAdd(&bar[XB_TMO], 1u); break; } }
  }
  nloc = mine > 0u ? mine : 1u; nx = cnt > 0u ? cnt : 1u;
}
__device__ __forceinline__ void xcd_barrier(const XcdBarrier& b) {
  asm volatile("s_waitcnt vmcnt(0)" ::: "memory");
  __syncthreads();
  if (threadIdx.x == 0) {
    unsigned* bar = b.bar;
    __builtin_amdgcn_s_waitcnt(0);
    unsigned nloc = b.st[0], nx = b.st[1];
    if (nloc == 0u) { xcd_barrier_complete(bar, b.x, nloc, nx); b.st[0] = nloc; b.st[1] = nx; }
    const unsigned old = xb_add(&bar[XB_XSUB(b.x)], 1u);
    const unsigned gen = old / nloc;
    if (old + 1u == (gen + 1u) * nloc) {
      __builtin_amdgcn_fence(__ATOMIC_RELEASE, "agent");
      asm volatile("s_waitcnt vmcnt(0)" ::: "memory");
      const unsigned og = xb_add(&bar[XB_TOP], 1u);
      const unsigned tg = og / nx;
      if (og + 1u == (tg + 1u) * nx) xb_add(&bar[XB_TOPGEN], 1u);
      else XB_SPIN(xb_ld(&bar[XB_TOPGEN]) == tg, bar);
      __builtin_amdgcn_fence(__ATOMIC_ACQUIRE, "agent");
      xb_add(&bar[XB_XGEN(b.x)], 1u);
      asm volatile("s_waitcnt vmcnt(0)" ::: "memory");
    } else {
      XB_SPIN(xb_ld(&bar[XB_XGEN(b.x)]) == gen, bar);
      __builtin_amdgcn_fence(__ATOMIC_ACQUIRE, "agent");
      asm volatile("s_waitcnt vmcnt(0)" ::: "memory");
    }
  }
  __syncthreads();
}

__global__ void __launch_bounds__(512, 2) mega(P p, unsigned* bar, int lo, int hi) {
  __shared__ __attribute__((aligned(16))) char smem[131072 + 16 + 4096 + 8192 + 16];
  if (hi < 0) cg::this_grid().sync();
  volatile LAS unsigned* st = (volatile LAS unsigned*)(smem + 131072 + 16 + 4096 + 8192);
  if (threadIdx.x == 0) { st[0] = 0u; st[1] = 0u; }
  __syncthreads();
  XcdBarrier xb = xcd_barrier_post(bar, st);
  for (int ph = lo; ph < hi; ++ph) {
    if (ph > lo) xcd_barrier(xb);
    run_phase(p, ph, smem);
  }
}

extern "C" void kernel_launch(void* const* d_in, const int* in_sizes, int n_in, void* d_out, int out_size, void* d_ws, size_t ws_size, hipStream_t stream) {
  static int grid_blocks = 0;
  if (!grid_blocks) {
    int dev = 0, cus = 0, per_cu = 0;
    (void)hipGetDevice(&dev);
    (void)hipDeviceGetAttribute(&cus, hipDeviceAttributeMultiprocessorCount, dev);
    (void)hipOccupancyMaxActiveBlocksPerMultiprocessor(&per_cu, mega, 512, 0);
    if (per_cu > 1) per_cu = 1;
    if (per_cu < 1) per_cu = 1;
    grid_blocks = cus * per_cu;
  }
  P p{};
  const float* const* in = (const float* const*)d_in;
  p.x_prompt = in[0]; p.x_sample = in[1]; p.cache_k = in[2]; p.cache_v = in[3]; p.c = in[4]; p.c_ctx = in[5];
  p.w_ada = in[6]; p.b_ada = in[7]; p.g_mix = in[8]; p.g_ffn = in[9]; p.w_ffn_in = in[10]; p.ffn_conv_w = in[11]; p.ffn_conv_b = in[12]; p.w_ffn_out = in[13];
  p.a_w_in = in[14]; p.a_g_v = in[15]; p.a_w_s = in[16]; p.a_b_s = in[17]; p.a_w_out = in[18];
  p.p_w = in[19]; p.p_b = in[20]; p.p_scale = in[21];
  p.c_w_qkv = in[22]; p.c_g_q = in[23]; p.c_g_k = in[24]; p.c_sink = in[25]; p.c_w_o = in[26];
  p.out_g = (__attribute__((address_space(1))) float*)d_out;
  char* ws = (char*)d_ws;
  unsigned* bar = (unsigned*)ws;
  p.ws = (__attribute__((address_space(1))) char*)ws;
  if ((size_t)335869440ull > ws_size) { fprintf(stderr, "workspace too small: need %zu have %zu\n", (size_t)335869440ull, ws_size); return; }
#if ONE_LAUNCH
  int lo = 0, hi = NPH;
  (void)hipMemsetAsync(bar, 0, (size_t)XCD_BAR_WORDS * 4, stream);
  void* args[] = {&p, &bar, &lo, &hi};
  hipError_t e = hipLaunchCooperativeKernel((void*)mega, dim3(grid_blocks), dim3(512), args, 0, stream);
  if (e != hipSuccess) {
    fprintf(stderr, "cooperative launch failed: %s (grid %d); falling back to one launch per phase\n", hipGetErrorString(e), grid_blocks);
    (void)hipGetLastError();
    for (int ph = 0; ph < NPH; ++ph) mega<<<grid_blocks, 512, 0, stream>>>(p, bar, ph, ph + 1);
  }
#else
  for (int ph = 0; ph < NPH; ++ph) mega<<<grid_blocks, 512, 0, stream>>>(p, bar, ph, ph + 1);
#endif
}
```

```cpp
#include <hip/hip_runtime.h>
#include <hip/hip_cooperative_groups.h>
#include <cstdio>
#include <cstdint>
namespace cg = cooperative_groups;

#ifndef ONE_LAUNCH
#define ONE_LAUNCH 1
#endif

typedef unsigned short bf16_t;
typedef short bf16x8 __attribute__((ext_vector_type(8)));
typedef float f32x16 __attribute__((ext_vector_type(16)));
typedef __bf16 bf16x2_t __attribute__((ext_vector_type(2)));
typedef float f32x2_t __attribute__((ext_vector_type(2)));

constexpr int T = 12288;
constexpr int TCTX = 8192;
constexpr int NPH = 20;
constexpr float LOG2E = 1.4426950408889634f;

struct P {
  const float *x_prompt, *x_sample, *cache_k, *cache_v, *c, *c_ctx;
  const float *w_ada, *b_ada, *g_mix, *g_ffn, *w_ffn_in, *ffn_conv_w, *ffn_conv_b, *w_ffn_out;
  const float *a_w_in, *a_g_v, *a_w_s, *a_b_s, *a_w_out;
  const float *p_w, *p_b, *p_scale;
  const float *c_w_qkv, *c_g_q, *c_g_k, *c_sink, *c_w_o;
  __attribute__((address_space(1))) float* out_g;
  __device__ __forceinline__ float* xo() const { return (float*)out_g; }
  __attribute__((address_space(1))) char* ws;
  __device__ __forceinline__ float* mod() const { return (float*)(ws + 13824ull); }
  __device__ __forceinline__ float* vsq() const { return (float*)(ws + 308736ull); }
  __device__ __forceinline__ bf16_t* wt_ffn_in() const { return (bf16_t*)(ws + 407040ull); }
  __device__ __forceinline__ bf16_t* wt_ffn_out() const { return (bf16_t*)(ws + 46544384ull); }
  __device__ __forceinline__ bf16_t* wt_a_in() const { return (bf16_t*)(ws + 69613056ull); }
  __device__ __forceinline__ bf16_t* wt_a_out() const { return (bf16_t*)(ws + 86390272ull); }
  __device__ __forceinline__ bf16_t* wt_p() const { return (bf16_t*)(ws + 94778880ull); }
  __device__ __forceinline__ bf16_t* wt_qkv() const { return (bf16_t*)(ws + 95303168ull); }
  __device__ __forceinline__ bf16_t* wt_o() const { return (bf16_t*)(ws + 98448896ull); }
  __device__ __forceinline__ bf16_t* ck() const { return (bf16_t*)(ws + 100546048ull); }
  __device__ __forceinline__ bf16_t* cvT() const { return (bf16_t*)(ws + 100808192ull); }
  __device__ __forceinline__ bf16_t* h() const { return (bf16_t*)(ws + 101070336ull); }
  __device__ __forceinline__ char* big1() const { return (char*)(ws + 126236160ull); }
  __device__ __forceinline__ char* big2() const { return (char*)(ws + 264648192ull); }
  __device__ __forceinline__ float* ha() const { return (float*)(ws + 333854208ull); }
  __device__ __forceinline__ float* hu() const { return (float*)(ws + 334575104ull); }
  __device__ __forceinline__ float* rowsq() const { return (float*)(ws + 334935552ull); }
  __device__ __forceinline__ float* shw() const { return (float*)(ws + 335328768ull); }
};

__device__ __forceinline__ unsigned pk_bf16(float lo, float hi) {
  f32x2_t v = {lo, hi};
  bf16x2_t r = __builtin_convertvector(v, bf16x2_t);
  return __builtin_bit_cast(unsigned, r);
}
__device__ __forceinline__ bf16_t f2bf(float x) { return (bf16_t)(pk_bf16(x, 0.f) & 0xffffu); }
__device__ __forceinline__ float bf2f(bf16_t v) { return __uint_as_float(((unsigned)v) << 16); }
__device__ __forceinline__ float bflo(unsigned v) { return __uint_as_float(v << 16); }
__device__ __forceinline__ float bfhi(unsigned v) { return __uint_as_float(v & 0xffff0000u); }
__device__ __forceinline__ float gelu_f(float x) {
  const float t = __builtin_fmaf(x * x, -0.10294324284f, -2.3022081985f);
  const float e = __builtin_amdgcn_exp2f(x * t);
  return x * __builtin_amdgcn_rcpf(1.0f + e);
}
__device__ __forceinline__ float row_ror1(float v) { return __builtin_bit_cast(float, __builtin_amdgcn_update_dpp(0, __builtin_bit_cast(int, v), 0x121, 0xf, 0xf, true)); }
__device__ __forceinline__ float row_ror15(float v) { return __builtin_bit_cast(float, __builtin_amdgcn_update_dpp(0, __builtin_bit_cast(int, v), 0x12f, 0xf, 0xf, true)); }
__device__ __forceinline__ int opaque_tid() { int t = threadIdx.x; asm volatile("" : "+v"(t)); return t; }
__device__ __forceinline__ int opaque_bid() { int b = blockIdx.x; asm volatile("" : "+s"(b)); return b; }
__device__ __forceinline__ int cond_of_row(int row) { return row < 8192 ? 0 : (row < 10240 ? 1 : 2); }
__device__ __forceinline__ int crow(int i, int hh) { return (i & 3) + 8 * (i >> 2) + 4 * hh; }

__device__ __forceinline__ int tile_off(int r, int c) { return r * 128 + ((c ^ ((r >> 1) & 7)) << 4); }

__device__ __forceinline__ uint4 gld16(const void* p) {
  uint4 r;
  asm volatile("global_load_dwordx4 %0, %1, off" : "=v"(r) : "v"(p) : "memory");
  return r;
}

template <bool PAIRED>
__device__ __forceinline__ void compute_ktile(const char* sA, const char* sB, f32x16 (&acc)[2][2], int wm, int wn, int lane) {
  const int l31 = lane & 31, hh = lane >> 5;
#pragma unroll
  for (int ks = 0; ks < 4; ++ks) {
    bf16x8 a[2], b[2];
#pragma unroll
    for (int mb = 0; mb < 2; ++mb) { const int r = wm * 64 + mb * 32 + l31; a[mb] = *(const bf16x8*)(sA + tile_off(r, ks * 2 + hh)); }
#pragma unroll
    for (int nb = 0; nb < 2; ++nb) { const int r = (PAIRED ? nb * 64 + wn * 32 : wn * 64 + nb * 32) + l31; b[nb] = *(const bf16x8*)(sB + tile_off(r, ks * 2 + hh)); }
#pragma unroll
    for (int mb = 0; mb < 2; ++mb)
#pragma unroll
      for (int nb = 0; nb < 2; ++nb) acc[mb][nb] = __builtin_amdgcn_mfma_f32_32x32x16_bf16(a[mb], b[nb], acc[mb][nb], 0, 0, 0);
  }
}


typedef float f32x4 __attribute__((ext_vector_type(4)));
__device__ __forceinline__ int g8_lds_byte(int r, int c) {
  const int st = (r >> 4) * 2 + (c >> 5), rr = r & 15, cc = c & 31, ob = rr * 64 + cc * 2;
  return st * 1024 + (ob ^ (((ob >> 9) & 1) << 5));
}
__device__ __forceinline__ void g8_stage_rc(int b, int& R, int& C) {
  const int st = b / 1024, sb = b % 1024, swz = sb ^ (((sb >> 9) & 1) << 5);
  R = (st >> 1) * 16 + swz / 64; C = (st & 1) * 32 + (swz % 64) / 2;
}
template <bool TRANS, bool R192>
__device__ __forceinline__ void gemm256(const bf16_t* __restrict__ A0, const bf16_t* __restrict__ A1, int lda, const bf16_t* __restrict__ B0, const bf16_t* __restrict__ B1, int ldb,
                                        int nt, char* shm, f32x4 (&acc)[2][2][4][2], int tid, bool pre, bool has_next,
                                        const bf16_t* __restrict__ nA0, const bf16_t* __restrict__ nA1, const bf16_t* __restrict__ nB0, const bf16_t* __restrict__ nB1) {
#define G8LAS __attribute__((address_space(3)))
  constexpr int HTB = 16384;
  G8LAS unsigned char* lds = (G8LAS unsigned char*)shm;
  const int wid = __builtin_amdgcn_readfirstlane(tid >> 6), lane = tid & 63, wr = wid >> 2, wc = wid & 3, fr = lane & 15, fq = lane >> 4;
  unsigned voffA[2], voffB[2];
#pragma unroll
  for (int i = 0; i < 2; ++i) {
    int R, C;
    g8_stage_rc(tid * 16 + i * 8192, R, C);
    voffA[i] = (unsigned)(R * lda + C) * 2u; voffB[i] = (unsigned)(R * ldb + C) * 2u;
  }
  const unsigned ldsw = (unsigned)wid * 1024u;
  const int aoff = g8_lds_byte(wr * 64 + fr, fq * 8), boff = g8_lds_byte(wc * 32 + fr, fq * 8);
  const char* cA0 = (const char*)A0; const char* cA1 = (const char*)A1; const char* cB0 = (const char*)B0; const char* cB1 = (const char*)B1;
  const char* dA0 = (const char*)nA0; const char* dA1 = (const char*)nA1; const char* dB0 = (const char*)nB0; const char* dB1 = (const char*)nB1;
#define SA(b, h) (((b) * 2 + (h)) * HTB)
#define SB(b, h) ((4 + (b) * 2 + (h)) * HTB)
#define STAGE(bufoff, gbase, voff, kt)                                                                                 \
  {                                                                                                                    \
    const unsigned long long _b = (unsigned long long)(gbase) + (unsigned long long)(kt) * 128ull;                     \
    const unsigned _blo = __builtin_amdgcn_readfirstlane((unsigned)_b), _bhi = __builtin_amdgcn_readfirstlane((unsigned)(_b >> 32)); \
    const char* _sb = (const char*)(((unsigned long long)_bhi << 32) | (unsigned long long)_blo);                      \
    _Pragma("unroll") for (int _i = 0; _i < 2; ++_i)                                                                   \
        __builtin_amdgcn_global_load_lds((const unsigned*)(_sb + (voff)[_i]), (G8LAS unsigned*)(lds + (bufoff) + ldsw + _i * 8192), 16, 0, 0); \
  }
#define LDA(dst, b, h)                                                                                                 \
  _Pragma("unroll") for (int m = 0; m < 4; ++m) _Pragma("unroll") for (int k = 0; k < 2; ++k)                          \
      dst[m][k] = *(const G8LAS bf16x8*)(lds + SA(b, h) + aoff + m * 2048 + k * 1024)
#define LDB(dst, b, h)                                                                                                 \
  _Pragma("unroll") for (int n = 0; n < 2; ++n) _Pragma("unroll") for (int k = 0; k < 2; ++k)                          \
      dst[n][k] = *(const G8LAS bf16x8*)(lds + SB(b, h) + boff + n * 2048 + k * 1024)
#define MMA(ai, bj, At_, Bt_)                                                                                          \
  if (!(R192 && (ai) == 1) || wr == 0) {     \
    __builtin_amdgcn_s_setprio(1);                                                                                     \
    _Pragma("unroll") for (int m = 0; m < 4; ++m) _Pragma("unroll") for (int n = 0; n < 2; ++n) _Pragma("unroll") for (int k = 0; k < 2; ++k) \
        acc[ai][bj][m][n] = TRANS ? __builtin_amdgcn_mfma_f32_16x16x32_bf16(Bt_[n][k], At_[m][k], acc[ai][bj][m][n], 0, 0, 0)  \
                                  : __builtin_amdgcn_mfma_f32_16x16x32_bf16(At_[m][k], Bt_[n][k], acc[ai][bj][m][n], 0, 0, 0); \
    __builtin_amdgcn_s_setprio(0);                                                                                     \
  }
#define WAIT_V(n) asm volatile("s_waitcnt vmcnt(" #n ")" ::: "memory")
#define WAIT_L(n) asm volatile("s_waitcnt lgkmcnt(" #n ")" ::: "memory")
#define BAR __builtin_amdgcn_s_barrier()
#define SCHED __builtin_amdgcn_sched_barrier(0)
#pragma unroll
  for (int ai = 0; ai < 2; ++ai)
#pragma unroll
    for (int bj = 0; bj < 2; ++bj)
#pragma unroll
      for (int m = 0; m < 4; ++m)
#pragma unroll
        for (int n = 0; n < 2; ++n) acc[ai][bj][m][n] = (f32x4){0.f, 0.f, 0.f, 0.f};
  bf16x8 At[4][2], Bx0[2][2], Bx1[2][2];
  if (!pre) {
    STAGE(SB(0, 0), cB0, voffB, 0); STAGE(SA(0, 0), cA0, voffA, 0);
    STAGE(SB(0, 1), cB1, voffB, 0); STAGE(SA(0, 1), cA1, voffA, 0);
    if (wr == 1) BAR;
    WAIT_V(4); BAR;
    STAGE(SB(1, 0), cB0, voffB, 1); STAGE(SA(1, 0), cA0, voffA, 1); STAGE(SB(1, 1), cB1, voffB, 1);
    WAIT_V(6); BAR;
  } else {
    if (wr == 1) BAR;
    STAGE(SB(1, 1), cB1, voffB, 1);
    WAIT_V(2); BAR;
  }
  for (int t = 0; t < nt - 2; t += 2) {
    LDB(Bx0, 0, 0); SCHED; LDA(At, 0, 0); STAGE(SA(1, 1), cA1, voffA, t + 1);
    WAIT_L(8); BAR; WAIT_L(0); MMA(0, 0, At, Bx0); BAR; SCHED;
    LDB(Bx1, 0, 1); STAGE(SB(0, 0), cB0, voffB, t + 2);
    BAR; WAIT_L(0); MMA(0, 1, At, Bx1); BAR;
    LDA(At, 0, 1); STAGE(SA(0, 0), cA0, voffA, t + 2);
    BAR; WAIT_L(0); MMA(1, 0, At, Bx0); BAR; SCHED;
    STAGE(SB(0, 1), cB1, voffB, t + 2);
    WAIT_V(6); BAR; MMA(1, 1, At, Bx1); BAR;
    LDB(Bx0, 1, 0); SCHED; LDA(At, 1, 0); STAGE(SA(0, 1), cA1, voffA, t + 2);
    WAIT_L(8); BAR; WAIT_L(0); MMA(0, 0, At, Bx0); BAR; SCHED;
    LDB(Bx1, 1, 1); STAGE(SB(1, 0), cB0, voffB, t + 3);
    BAR; WAIT_L(0); MMA(0, 1, At, Bx1); BAR;
    LDA(At, 1, 1); STAGE(SA(1, 0), cA0, voffA, t + 3);
    BAR; WAIT_L(0); MMA(1, 0, At, Bx0); BAR; SCHED;
    STAGE(SB(1, 1), cB1, voffB, t + 3);
    WAIT_V(6); BAR; MMA(1, 1, At, Bx1); BAR;
  }
  {
    LDB(Bx0, 0, 0); LDA(At, 0, 0); STAGE(SA(1, 1), cA1, voffA, nt - 1);
    BAR; WAIT_L(0); MMA(0, 0, At, Bx0); BAR;
    LDB(Bx1, 0, 1); BAR; WAIT_L(0); MMA(0, 1, At, Bx1); BAR;
    LDA(At, 0, 1);
    if (has_next) { STAGE(SB(0, 0), dB0, voffB, 0); STAGE(SA(0, 0), dA0, voffA, 0); WAIT_V(8); } else { WAIT_V(4); }
    BAR; WAIT_L(0); MMA(1, 0, At, Bx0); MMA(1, 1, At, Bx1); BAR;
  }
  {
    LDB(Bx0, 1, 0); LDA(At, 1, 0);
    if (has_next) { STAGE(SB(0, 1), dB1, voffB, 0); WAIT_V(8); } else { WAIT_V(2); }
    BAR; WAIT_L(0); MMA(0, 0, At, Bx0); BAR;
    LDB(Bx1, 1, 1);
    if (has_next) { STAGE(SA(0, 1), dA1, voffA, 0); WAIT_V(8); } else { WAIT_V(0); }
    BAR; WAIT_L(0); MMA(0, 1, At, Bx1); BAR;
    LDA(At, 1, 1);
    if (has_next) { STAGE(SB(1, 0), dB0, voffB, 1); STAGE(SA(1, 0), dA0, voffA, 1); }
    BAR; WAIT_L(0); MMA(1, 0, At, Bx0); MMA(1, 1, At, Bx1); BAR;
  }
  if (wr == 0) BAR;
#undef SA
#undef SB
#undef STAGE
#undef LDA
#undef LDB
#undef MMA
#undef WAIT_V
#undef WAIT_L
#undef BAR
#undef SCHED
#undef G8LAS
}

#define TR_LOAD(SRC, NN, V0, V1, V2, V3, V4, V5, V6, V7)                                                     \
  {                                                                                                            \
    const float* _s = (SRC) + (long)(tid >> 5) * (NN) + (tid & 31) * 4;                                        \
    V0 = *(const float4*)(_s); V1 = *(const float4*)(_s + (long)16 * (NN)); V2 = *(const float4*)(_s + (long)32 * (NN)); V3 = *(const float4*)(_s + (long)48 * (NN)); \
    V4 = *(const float4*)(_s + (long)64 * (NN)); V5 = *(const float4*)(_s + (long)80 * (NN)); V6 = *(const float4*)(_s + (long)96 * (NN)); V7 = *(const float4*)(_s + (long)112 * (NN)); \
  }
__device__ __forceinline__ void tr_store(bf16_t* __restrict__ dst, int K, float4 v0, float4 v1, float4 v2, float4 v3, float4 v4, float4 v5, float4 v6, float4 v7, float* tile, int tid) {
  const float4 v[8] = {v0, v1, v2, v3, v4, v5, v6, v7};
#pragma unroll
  for (int i = 0; i < 8; ++i) *(float4*)(tile + ((tid >> 5) + 16 * i) * 132 + (tid & 31) * 4) = v[i];
  __syncthreads();
  const int nn = tid & 127, kg = tid >> 7;
  const float* col = tile + (kg * 32) * 132 + nn;
#pragma unroll
  for (int c = 0; c < 4; ++c) {
    uint4 o;
    o.x = pk_bf16(col[(c * 8 + 0) * 132], col[(c * 8 + 1) * 132]);
    o.y = pk_bf16(col[(c * 8 + 2) * 132], col[(c * 8 + 3) * 132]);
    o.z = pk_bf16(col[(c * 8 + 4) * 132], col[(c * 8 + 5) * 132]);
    o.w = pk_bf16(col[(c * 8 + 6) * 132], col[(c * 8 + 7) * 132]);
    *(uint4*)(dst + (long)nn * K + kg * 32 + c * 8) = o;
  }
  __syncthreads();
}

__device__ void ada_item(const P& p, int item, float* sm, int tid) {
  const int l = item / 48, chunk = item % 48;
  float* sc = sm;
  float* red = sm + 3072;
  for (int i = tid; i < 3072; i += 512) {
    const int cb = i >> 10, k = i & 1023;
    const float v = cb == 0 ? p.c_ctx[k] : p.c[(cb - 1) * 1024 + k];
    sc[i] = v / (1.f + __expf(-v));
  }
  __syncthreads();
  const int ng = tid & 31, kg = tid >> 5;
  const float* wp = p.w_ada + ((long)l * 1024 + kg * 64) * 6144 + chunk * 128 + ng * 4;
  float a0[4] = {0.f, 0.f, 0.f, 0.f}, a1[4] = {0.f, 0.f, 0.f, 0.f}, a2[4] = {0.f, 0.f, 0.f, 0.f};
#pragma unroll 8
  for (int k = 0; k < 64; ++k) {
    const float4 wv = *(const float4*)(wp + (long)k * 6144);
    const float s0 = sc[kg * 64 + k], s1 = sc[1024 + kg * 64 + k], s2 = sc[2048 + kg * 64 + k];
    a0[0] += s0 * wv.x; a0[1] += s0 * wv.y; a0[2] += s0 * wv.z; a0[3] += s0 * wv.w;
    a1[0] += s1 * wv.x; a1[1] += s1 * wv.y; a1[2] += s1 * wv.z; a1[3] += s1 * wv.w;
    a2[0] += s2 * wv.x; a2[1] += s2 * wv.y; a2[2] += s2 * wv.z; a2[3] += s2 * wv.w;
  }
#pragma unroll
  for (int j = 0; j < 4; ++j) {
    red[(kg * 3 + 0) * 128 + ng * 4 + j] = a0[j];
    red[(kg * 3 + 1) * 128 + ng * 4 + j] = a1[j];
    red[(kg * 3 + 2) * 128 + ng * 4 + j] = a2[j];
  }
  __syncthreads();
  if (tid < 384) {
    const int cb = tid >> 7, n = tid & 127;
    float s = p.b_ada[l * 6144 + chunk * 128 + n];
#pragma unroll
    for (int g = 0; g < 16; ++g) s += red[(g * 3 + cb) * 128 + n];
    p.mod()[((long)l * 3 + cb) * 6144 + chunk * 128 + n] = s;
  }
  __syncthreads();
}

__device__ __forceinline__ void tr_decode(const P& p, int t, const float*& osrc, bf16_t*& odst, int& oK, int& oN) {
  constexpr int t_ffn_in = 4 * 8 * 44, t_ffn_out = 4 * 22 * 8, t_a_in = 2 * 8 * 32, t_a_out = 2 * 16 * 8, t_p = 4 * 2 * 2, t_qkv = 8 * 12, t_o = 8 * 8;
  const float* src; bf16_t* dst; int K, N;
#define TR_OPAQUE asm volatile("" : "+s"(src), "+s"(dst));
  if (t < t_ffn_in) { src = p.w_ffn_in; dst = p.wt_ffn_in(); K = 1024; N = 5632; TR_OPAQUE }
  else if ((t -= t_ffn_in) < t_ffn_out) { src = p.w_ffn_out; dst = p.wt_ffn_out(); K = 2816; N = 1024; TR_OPAQUE }
  else if ((t -= t_ffn_out) < t_a_in) { src = p.a_w_in; dst = p.wt_a_in(); K = 1024; N = 4096; TR_OPAQUE }
  else if ((t -= t_a_in) < t_a_out) { src = p.a_w_out; dst = p.wt_a_out(); K = 2048; N = 1024; TR_OPAQUE }
  else if ((t -= t_a_out) < t_p) { src = p.p_w; dst = p.wt_p(); K = 256; N = 256; TR_OPAQUE }
  else if ((t -= t_p) < t_qkv) { src = p.c_w_qkv; dst = p.wt_qkv(); K = 1024; N = 1536; TR_OPAQUE }
  else if ((t -= t_qkv) < t_o) { src = p.c_w_o; dst = p.wt_o(); K = 1024; N = 1024; TR_OPAQUE }
  else { t -= t_o; src = p.cache_v; dst = p.cvT(); K = 256; N = 256; TR_OPAQUE }
  const int nkt = K >> 7, nnt = N >> 7, per = nkt * nnt;
  const int mat = t / per, r = t % per;
  const int nt = r % nnt, kt = r / nnt;
  osrc = src + (long)mat * K * N + (long)(kt * 128) * N + nt * 128;
  odst = dst + (long)mat * K * N + (long)(nt * 128) * K + kt * 128;
  oK = K; oN = N;
#undef TR_OPAQUE
}

__device__ __forceinline__ int tr_group_size(int g) { return g == 0 ? 920 : (g == 1 ? 544 : (g == 2 ? 688 : 912)); }
__device__ __forceinline__ int tr_group_map(int g, int i) {
  if (i < 352) return 352 * g + i;
  i -= 352;
  if (i < 176) return 1408 + 176 * g + i;
  i -= 176;
  if (g == 0) return i < 256 ? 2112 + i : (i < 384 ? 2624 + (i - 256) : 3056 + (i - 384));
  if (g == 1) return 2880 + i;
  if (g == 2) return i < 96 ? 2896 + i : 2992 + (i - 96);
  return i < 256 ? 2112 + 256 + i : 2624 + 128 + (i - 256);
}
__device__ void run_transposes(const P& p, int g, int first, int stride, float* sm, int tid, int n_end = -1) {
  const int n = n_end >= 0 ? n_end : tr_group_size(g);
  int t = first;
  if (t < n) {
    const float* csrc; bf16_t* cdst; int cK, cN;
    tr_decode(p, tr_group_map(g, t), csrc, cdst, cK, cN);
    float4 a0, a1, a2, a3, a4, a5, a6, a7;
    TR_LOAD(csrc, cN, a0, a1, a2, a3, a4, a5, a6, a7)
    while (true) {
      const int tn = t + stride;
      const bool more = tn < n;
      const float* nsrc; bf16_t* ndst; int nK, nN;
      tr_decode(p, tr_group_map(g, more ? tn : t), nsrc, ndst, nK, nN);
      float4 b0 = a0, b1 = a1, b2 = a2, b3 = a3, b4 = a4, b5 = a5, b6 = a6, b7 = a7;
      if (more) TR_LOAD(nsrc, nN, b0, b1, b2, b3, b4, b5, b6, b7)
      tr_store(cdst, cK, a0, a1, a2, a3, a4, a5, a6, a7, sm, tid);
      if (!more) break;
      a0 = b0; a1 = b1; a2 = b2; a3 = b3; a4 = b4; a5 = b5; a6 = b6; a7 = b7;
      cdst = ndst; cK = nK; t = tn;
    }
  }
}

__device__ void phase_prep(const P& p, char* smem) {
  float* sm = (float*)smem;
  const int tid = opaque_tid();
  constexpr int N_ADA = 192, N_CK = 32, N_Z = 6 + 24;
  constexpr int TR0 = N_ADA + N_CK + N_Z;
  for (int item = opaque_bid(); item < TR0; item += gridDim.x) {
    if (item < N_ADA) { ada_item(p, item, sm, tid); continue; }
    if (item < N_ADA + N_CK) {
      const int i0 = (item - N_ADA) * 4096 + tid * 8;
      const float4 a = *(const float4*)(p.cache_k + i0), b = *(const float4*)(p.cache_k + i0 + 4);
      uint4 o; o.x = pk_bf16(a.x, a.y); o.y = pk_bf16(a.z, a.w); o.z = pk_bf16(b.x, b.y); o.w = pk_bf16(b.z, b.w);
      *(uint4*)(p.ck() + i0) = o;
      continue;
    }
    const int zi = item - N_ADA - N_CK;
    float* zp = zi < 6 ? p.vsq() + zi * 4096 + tid * 8 : p.rowsq() + (zi - 6) * 4096 + tid * 8;
    *(float4*)(zp) = make_float4(0.f, 0.f, 0.f, 0.f);
    *(float4*)(zp + 4) = make_float4(0.f, 0.f, 0.f, 0.f);
  }
  {
    const int b = opaque_bid(), G = (int)gridDim.x;
    if (G == 256) {
      if (b >= 192) run_transposes(p, 0, b - 192, 64, sm, tid, 448);
      else run_transposes(p, 0, 448 + b, 192, sm, tid, 920);
    } else {
      run_transposes(p, 0, G - 1 - b, G, sm, tid);
    }
  }
}

__device__ void phase_filler(const P& p, int g, char* smem) {
  const int bid = opaque_bid();
  if (bid < 32) return;
  const int tid = opaque_tid();
  const int fb = bid - 32, nf = (int)gridDim.x - 32;
  __syncthreads();
  run_transposes(p, g, nf - 1 - fb, nf, (float*)smem, tid);
}

__device__ void phase_norm(const P& p, int layer, int which, bool first) {
  const int tid = opaque_tid(), lane = tid & 63, w = tid >> 6;
  const float* g = (which ? p.g_ffn : p.g_mix) + layer * 1024;
  for (int item = opaque_bid(); item < T / 16; item += gridDim.x) {
    const int row0 = item * 16 + w * 2;
    float4 v[2][4];
    float ss[2] = {0.f, 0.f};
#pragma unroll
    for (int r = 0; r < 2; ++r) {
      const int row = row0 + r;
      const float* xr = first ? (row < TCTX ? p.x_prompt + (long)row * 1024 : p.x_sample + (long)(row - TCTX) * 1024) : p.xo() + (long)row * 1024;
#pragma unroll
      for (int i = 0; i < 4; ++i) {
        v[r][i] = *(const float4*)(xr + (i * 64 + lane) * 4);
        ss[r] += v[r][i].x * v[r][i].x + v[r][i].y * v[r][i].y + v[r][i].z * v[r][i].z + v[r][i].w * v[r][i].w;
      }
    }
#pragma unroll
    for (int o = 32; o; o >>= 1) { ss[0] += __shfl_xor(ss[0], o); ss[1] += __shfl_xor(ss[1], o); }
    const float* md = p.mod() + ((long)layer * 3 + cond_of_row(row0)) * 6144 + which * 3072;
#pragma unroll
    for (int i = 0; i < 4; ++i) {
      const int col = (i * 64 + lane) * 4;
      const float4 gg = *(const float4*)(g + col), sh = *(const float4*)(md + col), sc = *(const float4*)(md + 1024 + col);
#pragma unroll
      for (int r = 0; r < 2; ++r) {
        const float rstd = rsqrtf(ss[r] * (1.f / 1024.f) + 1e-6f);
        const float y0 = v[r][i].x * rstd * gg.x * (1.f + sc.x) + sh.x;
        const float y1 = v[r][i].y * rstd * gg.y * (1.f + sc.y) + sh.y;
        const float y2 = v[r][i].z * rstd * gg.z * (1.f + sc.z) + sh.z;
        const float y3 = v[r][i].w * rstd * gg.w * (1.f + sc.w) + sh.w;
        uint2 o; o.x = pk_bf16(y0, y1); o.y = pk_bf16(y2, y3);
        *(uint2*)(p.h() + (long)(row0 + r) * 1024 + col) = o;
        if (first) *(float4*)(p.xo() + (long)(row0 + r) * 1024 + col) = v[r][i];
      }
    }
  }
}

__device__ void phase_shw(const P& p, int ra0, int ra1, int rb0, int rb1, bool skip_lat) {
  const int tid = opaque_tid(), lane = tid & 63, w = tid >> 6;
  int rank = opaque_bid(), nblk = (int)gridDim.x;
  if (skip_lat) {
    const int mq = rank & 63;
    if (mq >= 42) return;
    rank = (rank >> 6) * 42 + mq; nblk = (nblk >> 6) * 42;
  }
  const int na = (ra1 - ra0) >> 6, nb = (rb1 - rb0) >> 6;
  for (int item = rank; item < na + nb; item += nblk) {
    int r = (item < na ? ra0 + item * 64 : rb0 + (item - na) * 64) + w * 8;
    int idx, n0; const bf16_t* wrow;
    if (r < 4 * 5632) { const int l = r / 5632; n0 = r - l * 5632; idx = 2 * l + 1; wrow = p.wt_ffn_in() + ((long)l * 5632 + n0) * 1024; }
    else if ((r -= 4 * 5632) < 1536) { n0 = r; idx = 4; wrow = p.wt_qkv() + (long)n0 * 1024; }
    else { n0 = r - 1536; idx = 6; wrow = p.wt_a_in() + ((long)4096 + n0) * 1024; }
    uint4 wv[8][2];
#pragma unroll
    for (int q = 0; q < 8; ++q) { wv[q][0] = *(const uint4*)(wrow + (long)q * 1024 + lane * 16); wv[q][1] = *(const uint4*)(wrow + (long)q * 1024 + lane * 16 + 8); }
    const float* shb = p.mod() + (long)(idx >> 1) * 3 * 6144 + ((idx & 1) ? 3072 : 0) + lane * 16;
    float sacc[8][3];
#pragma unroll
    for (int q = 0; q < 8; ++q) { sacc[q][0] = 0.f; sacc[q][1] = 0.f; sacc[q][2] = 0.f; }
#pragma unroll
    for (int cnd = 0; cnd < 3; ++cnd) {
      const float* sh = shb + cnd * 6144;
      const float4 s0 = *(const float4*)(sh), s1 = *(const float4*)(sh + 4), s2 = *(const float4*)(sh + 8), s3 = *(const float4*)(sh + 12);
#pragma unroll
      for (int q = 0; q < 8; ++q) {
        const uint4 a = wv[q][0], b = wv[q][1];
        sacc[q][cnd] = s0.x * bflo(a.x) + s0.y * bfhi(a.x) + s0.z * bflo(a.y) + s0.w * bfhi(a.y) + s1.x * bflo(a.z) + s1.y * bfhi(a.z) + s1.z * bflo(a.w) + s1.w * bfhi(a.w)
                     + s2.x * bflo(b.x) + s2.y * bfhi(b.x) + s2.z * bflo(b.y) + s2.w * bfhi(b.y) + s3.x * bflo(b.z) + s3.y * bfhi(b.z) + s3.z * bflo(b.w) + s3.w * bfhi(b.w);
      }
    }
#pragma unroll
    for (int o = 32; o; o >>= 1)
#pragma unroll
      for (int q = 0; q < 8; ++q) { sacc[q][0] += __shfl_xor(sacc[q][0], o); sacc[q][1] += __shfl_xor(sacc[q][1], o); sacc[q][2] += __shfl_xor(sacc[q][2], o); }
    if (lane < 24) {
      const int q = lane / 3, cnd = lane - q * 3;
      float v = 0.f;
#pragma unroll
      for (int qq = 0; qq < 8; ++qq)
#pragma unroll
        for (int cc = 0; cc < 3; ++cc) if (qq == q && cc == cnd) v = sacc[qq][cc];
      p.shw()[((long)idx * 3 + cnd) * 5632 + n0 + q] = v;
    }
  }
}

__device__ __forceinline__ void ffn_fix_rows(const P& p, int layer, int lo, int hi, int tid) {
  bf16_t* gbuf = (bf16_t*)p.big2();
  const float* cw = p.ffn_conv_w + (long)layer * 3 * 2816;
  const float* cb = p.ffn_conv_b + (long)layer * 2816;
  bool any = false;
  for (int q = 0; q < 32; ++q) {
    const int lt = q >> 1, e = q & 1;
    const int row = TCTX + lt * 256 + (e == 0 ? 0 : 255);
    if (row < lo || row >= hi) continue;
    if (e == 0 ? (lt & 7) == 0 : (lt & 7) == 7) continue;
    any = true;
    const float* ap = e == 0 ? p.ha() + (long)((lt - 1) * 4 + 3) * 2816 : p.ha() + (long)(lt * 4 + 2) * 2816;
    const float* ac = e == 0 ? p.ha() + (long)(lt * 4 + 0) * 2816 : p.ha() + (long)(lt * 4 + 3) * 2816;
    const float* an = e == 0 ? p.ha() + (long)(lt * 4 + 1) * 2816 : p.ha() + (long)((lt + 1) * 4 + 0) * 2816;
    const float* uu = p.hu() + (long)(lt * 2 + e) * 2816;
    for (int c = tid; c < 2816; c += 512) {
      const float x = cw[c] * ap[c] + cw[2816 + c] * ac[c] + cw[5632 + c] * an[c] + cb[c];
      gbuf[(long)row * 2816 + c] = f2bf(gelu_f(x) * uu[c]);
    }
  }
  if (any) { asm volatile("s_waitcnt vmcnt(0)" ::: "memory"); __syncthreads(); }
}

__device__ __forceinline__ void pool_tile(const P& p, int mt, int g, char* smem, int tid) {
  const int half = 1 << g;
  bf16_t* d = (bf16_t*)p.big1();
  const bf16_t* h = p.h();
  const int r0 = mt * 192;
  int lo0 = r0 - 8; lo0 = lo0 < 0 ? 0 : lo0;
  int hi0 = r0 + 192 + 7; hi0 = hi0 > T ? T : hi0;
  const int nch = (hi0 - lo0) * 32;
  const float* rq = p.rowsq() + (long)2 * T;
  for (int ci = tid; ci < nch; ci += 512) {
    const int row = lo0 + (ci >> 5), c8 = g * 256 + (ci & 31) * 8;
    const uint4 xv = *(const uint4*)(h + (long)row * 1024 + c8);
    const float r = rsqrtf(rq[row] * (1.f / 1024.f) + 1e-6f);
    const float* shp = p.mod() + ((long)1 * 3 + cond_of_row(row)) * 6144 + c8;
    const float4 s0 = *(const float4*)(shp), s1 = *(const float4*)(shp + 4);
    uint4 o;
    o.x = pk_bf16(r * bflo(xv.x) + s0.x, r * bfhi(xv.x) + s0.y); o.y = pk_bf16(r * bflo(xv.y) + s0.z, r * bfhi(xv.y) + s0.w);
    o.z = pk_bf16(r * bflo(xv.z) + s1.x, r * bfhi(xv.z) + s1.y); o.w = pk_bf16(r * bflo(xv.w) + s1.z, r * bfhi(xv.w) + s1.w);
    *(uint4*)(smem + ci * 16) = o;
  }
  __syncthreads();
  const int c4 = (tid & 63) * 4;
  for (int rr = tid >> 6; rr < 192; rr += 8) {
    const int row = r0 + rr;
    int s, S;
    if (row < TCTX) { s = row & 255; S = 256; } else { s = (row - TCTX) & 2047; S = 2048; }
    const int base = row - s;
    int lo = s - half; lo = lo < 0 ? 0 : lo;
    int hi = s + half - 1; hi = hi > S - 1 ? S - 1 : hi;
    float a0 = 0.f, a1 = 0.f, a2 = 0.f, a3 = 0.f;
    for (int q = lo; q <= hi; ++q) {
      const uint2 v = *(const uint2*)(smem + (base + q - lo0) * 512 + c4 * 2);
      a0 += bflo(v.x); a1 += bfhi(v.x); a2 += bflo(v.y); a3 += bfhi(v.y);
    }
    const float inv = 1.f / (float)(hi - lo + 1);
    const uint2 v = *(const uint2*)(smem + (row - lo0) * 512 + c4 * 2);
    uint2 o;
    o.x = pk_bf16(a0 * inv - bflo(v.x), a1 * inv - bfhi(v.x));
    o.y = pk_bf16(a2 * inv - bflo(v.y), a3 * inv - bfhi(v.y));
    *(uint2*)(d + (long)row * 1024 + g * 256 + c4) = o;
  }
  asm volatile("s_waitcnt vmcnt(0)" ::: "memory");
  __syncthreads();
}

enum { G_GMLP_IN = 0, G_RESID = 1, G_POOL = 2, G_QKV = 3, G_FFN_IN = 4, G_GMLP_V = 5, G_QKV_V = 6 };

template <int KIND>
__device__ void phase_gemm(const P& p, const bf16_t* __restrict__ A, int lda, const bf16_t* __restrict__ Bt, int ldb, int K, int ntn, int layer, int aux, int fx, char* smem) {
  constexpr bool R192 = (KIND == G_RESID || KIND == G_POOL);
  constexpr int MT = R192 ? 64 : 48, MROWS = R192 ? 192 : 256;
  constexpr int CHAIN_V = KIND == G_GMLP_IN ? 48 * 8 : (KIND == G_QKV ? 48 * 1 : 0);
  constexpr int CHAIN_VOFF = KIND == G_GMLP_IN ? 8 : 5;
  constexpr int PREV_CNT = KIND == G_GMLP_V ? 48 * 8 : (KIND == G_QKV_V ? 48 * 5 : 0);
  bool pre = PREV_CNT > 0 && opaque_bid() < PREV_CNT;
  for (int item = ((KIND == G_GMLP_V || KIND == G_QKV_V) ? (int)(gridDim.x - 1 - opaque_bid()) : opaque_bid()); item < MT * ntn; item += gridDim.x) {
    const int tid = opaque_tid();
    const int mt = item % MT, nt = item / MT + (KIND == G_GMLP_V ? 8 : (KIND == G_QKV_V ? 5 : 0));
    const bf16_t* At = A + (long)mt * MROWS * lda + (KIND == G_POOL ? nt * 256 : 0);
    const bf16_t* B0 = Bt + (long)nt * (KIND == G_FFN_IN ? 128 : 256) * ldb;
    const bf16_t* B1 = KIND == G_FFN_IN ? Bt + (long)(2816 + nt * 128) * ldb : B0 + (long)128 * ldb;
    const bool own_next = item + (int)gridDim.x < MT * ntn;
    const int vitem0 = (int)gridDim.x - 1 - opaque_bid();
    const bool chain = CHAIN_V > 0 && !own_next && vitem0 < CHAIN_V;
    const bool has_next = own_next || chain;
    const int nitem = own_next ? item + (int)gridDim.x : (chain ? vitem0 : item);
    const int nmt = nitem % MT, nnt = nitem / MT + (chain ? CHAIN_VOFF : (KIND == G_GMLP_V ? 8 : (KIND == G_QKV_V ? 5 : 0)));
    const bf16_t* nAt = A + (long)nmt * MROWS * lda + (KIND == G_POOL ? nnt * 256 : 0);
    const bf16_t* nB0 = Bt + (long)nnt * (KIND == G_FFN_IN ? 128 : 256) * ldb;
    const bf16_t* nB1 = KIND == G_FFN_IN ? Bt + (long)(2816 + nnt * 128) * ldb : nB0 + (long)128 * ldb;
    const bool was_pre = pre;
    pre = has_next;
    if constexpr (KIND == G_RESID) { if (aux == 5120) ffn_fix_rows(p, layer, mt * MROWS, mt * MROWS + MROWS, tid); }
    if constexpr (KIND == G_POOL) pool_tile(p, mt, nt, smem, tid);
    f32x4 acc[2][2][4][2];
#define EPI_IDS()                                                                                                     \
    const int te = opaque_tid(), lane = te & 63, wid = __builtin_amdgcn_readfirstlane(te >> 6), wr = wid >> 2, wc = wid & 3, fr = lane & 15, fq = lane >> 4; \
    const int rb = mt * MROWS + wr * 64, cb = nt * 256 + wc * 32;
    if constexpr (KIND == G_GMLP_V || KIND == G_QKV_V) {
      gemm256<false, false>(At, At + (long)128 * lda, lda, B0, B1, ldb, K >> 6, smem, acc, tid, was_pre, has_next, nAt, nAt + (long)128 * lda, nB0, nB1);
      EPI_IDS()
      const unsigned lo = (unsigned)(fr * T + fq * 4);
      if (fx >= 0) {
        const float* rq = p.rowsq() + (long)fx * T + rb + fq * 4;
        const float* sw = p.shw() + ((long)fx * 3 + cond_of_row(mt * 256)) * 5632 + cb + fr;
#pragma unroll
        for (int ai = 0; ai < 2; ++ai)
#pragma unroll
          for (int m = 0; m < 4; ++m) {
            const float4 q = *(const float4*)(rq + ai * 128 + m * 16);
            const float r0 = rsqrtf(q.x * (1.f / 1024.f) + 1e-6f), r1 = rsqrtf(q.y * (1.f / 1024.f) + 1e-6f), r2 = rsqrtf(q.z * (1.f / 1024.f) + 1e-6f), r3 = rsqrtf(q.w * (1.f / 1024.f) + 1e-6f);
#pragma unroll
            for (int bj = 0; bj < 2; ++bj)
#pragma unroll
              for (int n = 0; n < 2; ++n) {
                const float sv = sw[bj * 128 + n * 16];
                f32x4 v = acc[ai][bj][m][n];
                v[0] = r0 * v[0] + sv; v[1] = r1 * v[1] + sv; v[2] = r2 * v[2] + sv; v[3] = r3 * v[3] + sv;
                acc[ai][bj][m][n] = v;
              }
          }
      }
      if constexpr (KIND == G_QKV_V) {
        bf16_t* vTa = (bf16_t*)p.big2() + (long)T * 1024 + (long)T * 256;
        float* outv = p.xo() + (long)T * 1024 + (long)TCTX * 256;
#pragma unroll
        for (int ai = 0; ai < 2; ++ai)
#pragma unroll
          for (int m = 0; m < 4; ++m)
#pragma unroll
            for (int bj = 0; bj < 2; ++bj)
#pragma unroll
              for (int n = 0; n < 2; ++n) {
                const int c0 = wc * 32 + bj * 128 + n * 16, r0 = rb + ai * 128 + m * 16;
                const f32x4 v = acc[ai][bj][m][n];
                uint2 o; o.x = pk_bf16(v[0], v[1]); o.y = pk_bf16(v[2], v[3]);
                *(uint2*)(vTa + (long)c0 * T + r0 + lo) = o;
                if (mt < 32) {
                  float* ov = outv + (long)(r0 + fq * 4) * 256 + c0 + fr;
                  ov[0] = v[0]; ov[256] = v[1]; ov[512] = v[2]; ov[768] = v[3];
                }
                if (bj == 1 && n == 1) asm volatile("" ::: "memory");
              }
      } else {
      bf16_t* vT = (bf16_t*)p.big1() + (long)T * 2048;
      float* vsq = p.vsq() + (long)aux * T;
#pragma unroll
      for (int ai = 0; ai < 2; ++ai)
#pragma unroll
        for (int m = 0; m < 4; ++m) {
          float sq[4] = {0.f, 0.f, 0.f, 0.f};
#pragma unroll
          for (int bj = 0; bj < 2; ++bj)
#pragma unroll
            for (int n = 0; n < 2; ++n) {
              float z0 = gelu_f(acc[ai][bj][m][n][0]), z1 = gelu_f(acc[ai][bj][m][n][1]), z2 = gelu_f(acc[ai][bj][m][n][2]), z3 = gelu_f(acc[ai][bj][m][n][3]);
              sq[0] += z0 * z0; sq[1] += z1 * z1; sq[2] += z2 * z2; sq[3] += z3 * z3;
              uint2 o; o.x = pk_bf16(z0, z1); o.y = pk_bf16(z2, z3);
              bf16_t* sb = vT + (long)(cb - 2048 + bj * 128 + n * 16) * T + rb + ai * 128 + m * 16;
              *(uint2*)(sb + lo) = o;
            }
#pragma unroll
          for (int j = 0; j < 4; ++j) {
            float s = sq[j];
            s += __shfl_xor(s, 1); s += __shfl_xor(s, 2); s += __shfl_xor(s, 4); s += __shfl_xor(s, 8);
            if (fr == 0) atomicAdd(vsq + rb + ai * 128 + m * 16 + fq * 4 + j, s);
          }
          asm volatile("" ::: "memory");
        }
      }
    } else {
    gemm256<true, R192>(At, At + (long)128 * lda, lda, B0, B1, ldb, K >> 6, smem, acc, tid, was_pre, has_next, nAt, nAt + (long)128 * lda, nB0, nB1);
    EPI_IDS()
    if constexpr (KIND == G_GMLP_IN || KIND == G_QKV || KIND == G_FFN_IN) {
      if (fx >= 0) {
        const float* rq = p.rowsq() + (long)fx * T + rb + fr;
        const float* sw = p.shw() + ((long)fx * 3 + cond_of_row(mt * 256)) * 5632 + (KIND == G_FFN_IN ? nt * 128 + wc * 32 : cb) + fq * 4;
        float rr[2][4];
#pragma unroll
        for (int ai = 0; ai < 2; ++ai)
#pragma unroll
          for (int m = 0; m < 4; ++m) rr[ai][m] = rsqrtf(rq[ai * 128 + m * 16] * (1.f / 1024.f) + 1e-6f);
#pragma unroll
        for (int bj = 0; bj < 2; ++bj)
#pragma unroll
          for (int n = 0; n < 2; ++n) {
            const float4 sv = *(const float4*)(sw + (KIND == G_FFN_IN ? bj * 2816 : bj * 128) + n * 16);
#pragma unroll
            for (int ai = 0; ai < 2; ++ai)
#pragma unroll
              for (int m = 0; m < 4; ++m) {
                f32x4 v = acc[ai][bj][m][n];
                const float r = rr[ai][m];
                v[0] = r * v[0] + sv.x; v[1] = r * v[1] + sv.y; v[2] = r * v[2] + sv.z; v[3] = r * v[3] + sv.w;
                acc[ai][bj][m][n] = v;
              }
          }
      }
    }
    if constexpr (KIND == G_RESID || KIND == G_POOL) {
      const unsigned lo = (unsigned)(fr * 1024 + fq * 4);
      const bool fz = fx >= 0;
      const float* gvec = ((fx & 1) ? p.g_ffn : p.g_mix) + (fx >> 1) * 1024;
      const int nai = wr == 0 ? 2 : 1;
      const unsigned voffx = lo * 4u;
      float4 gvq[4];
#pragma unroll
      for (int q = 0; q < 4; ++q) gvq[q] = fz ? *(const float4*)(gvec + cb + fq * 4 + (q >> 1) * 128 + (q & 1) * 16) : make_float4(0.f, 0.f, 0.f, 0.f);
#pragma unroll
      for (int ai = 0; ai < 2; ++ai) {
        if (ai < nai) {
          f32x4 xr[4][4];
#pragma unroll
          for (int m = 0; m < 4; ++m)
#pragma unroll
            for (int q = 0; q < 4; ++q) {
              const float* bp = p.xo() + (long)(rb + ai * 128 + m * 16) * 1024 + cb + (q >> 1) * 128 + (q & 1) * 16;
              asm volatile("global_load_dwordx4 %0, %1, %2" : "=v"(xr[m][q]) : "v"(voffx), "s"(bp) : "memory");
            }
          asm volatile("s_waitcnt vmcnt(0)" ::: "memory");
#pragma unroll
          for (int m = 0; m < 4; ++m) {
            const int row = rb + ai * 128 + m * 16 + fr;
            const int cnd = cond_of_row(rb + ai * 128 + m * 16);
            const float* gate = p.mod() + ((long)layer * 3 + cnd) * 6144 + aux + cb + fq * 4;
            const float* scv = p.mod() + ((long)(fx >> 1) * 3 + cnd) * 6144 + ((fx & 1) ? 4096 : 1024) + cb + fq * 4;
            float rsum = 0.f;
#pragma unroll
            for (int bj = 0; bj < 2; ++bj)
#pragma unroll
              for (int n = 0; n < 2; ++n) {
                const int co = bj * 128 + n * 16;
                const float4 g = *(const float4*)(gate + co);
                float4 pb = make_float4(0.f, 0.f, 0.f, 0.f), ps = make_float4(1.f, 1.f, 1.f, 1.f);
                if constexpr (KIND == G_POOL) { pb = *(const float4*)(p.p_b + cb + fq * 4 + co); ps = *(const float4*)(p.p_scale + cb + fq * 4 + co); }
                const long eo = (long)(rb + ai * 128 + m * 16) * 1024 + cb + co;
                float4* xp = (float4*)(p.xo() + eo + lo);
                const f32x4 xl = xr[m][bj * 2 + n];
                float4 x = make_float4(xl[0], xl[1], xl[2], xl[3]);
                const f32x4 v = acc[ai][bj][m][n];
                x.x += g.x * ((v[0] + pb.x) * ps.x); x.y += g.y * ((v[1] + pb.y) * ps.y);
                x.z += g.z * ((v[2] + pb.z) * ps.z); x.w += g.w * ((v[3] + pb.w) * ps.w);
                *xp = x;
                if (fz) {
                  const float4 gv = gvq[bj * 2 + n], sc = *(const float4*)(scv + co);
                  rsum += x.x * x.x + x.y * x.y + x.z * x.z + x.w * x.w;
                  uint2 o; o.x = pk_bf16(x.x * gv.x * (1.f + sc.x), x.y * gv.y * (1.f + sc.y)); o.y = pk_bf16(x.z * gv.z * (1.f + sc.z), x.w * gv.w * (1.f + sc.w));
                  *(uint2*)(p.h() + eo + lo) = o;
                }
              }
            if (fz) {
              rsum += __shfl_xor(rsum, 16); rsum += __shfl_xor(rsum, 32);
              if (fq == 0) atomicAdd(p.rowsq() + (long)fx * T + row, rsum);
            }
            asm volatile("" ::: "memory");
          }
        }
      }
    } else if constexpr (KIND == G_GMLP_IN) {
      bf16_t* u = (bf16_t*)p.big1();
      const unsigned lo = (unsigned)(fr * 2048 + fq * 4);
#pragma unroll
      for (int ai = 0; ai < 2; ++ai)
#pragma unroll
        for (int m = 0; m < 4; ++m)
#pragma unroll
          for (int bj = 0; bj < 2; ++bj)
#pragma unroll
            for (int n = 0; n < 2; ++n) {
              bf16_t* sb = u + (long)(rb + ai * 128 + m * 16) * 2048 + cb + bj * 128 + n * 16;
              const f32x4 v = acc[ai][bj][m][n];
              uint2 o; o.x = pk_bf16(gelu_f(v[0]), gelu_f(v[1])); o.y = pk_bf16(gelu_f(v[2]), gelu_f(v[3]));
              *(uint2*)(sb + lo) = o;
              if (bj == 1 && n == 1) asm volatile("" ::: "memory");
            }
    } else if constexpr (KIND == G_QKV) {
      float* part = (float*)(smem + 131072 + 16 + 4096);
      float rinv[2][2][4];
#pragma unroll
      for (int ai = 0; ai < 2; ++ai)
#pragma unroll
        for (int bj = 0; bj < 2; ++bj)
#pragma unroll
          for (int m = 0; m < 4; ++m) {
            const f32x4 a = acc[ai][bj][m][0], b = acc[ai][bj][m][1];
            float sq = a[0] * a[0] + a[1] * a[1] + a[2] * a[2] + a[3] * a[3] + b[0] * b[0] + b[1] * b[1] + b[2] * b[2] + b[3] * b[3];
            sq += __shfl_xor(sq, 16); sq += __shfl_xor(sq, 32);
            rinv[ai][bj][m] = sq;
            if (fq == 0) part[((wid * 2 + ai) * 2 + bj) * 64 + m * 16 + fr] = sq;
          }
      __syncthreads();
      {
        const int pw = wid ^ 1;
#pragma unroll
        for (int ai = 0; ai < 2; ++ai)
#pragma unroll
          for (int bj = 0; bj < 2; ++bj)
#pragma unroll
            for (int m = 0; m < 4; ++m)
              rinv[ai][bj][m] = rsqrtf((rinv[ai][bj][m] + part[((pw * 2 + ai) * 2 + bj) * 64 + m * 16 + fr]) * (1.f / 64.f) + 1e-6f);
      }
      const bool latt = mt >= 32;
      const float* gam = (nt < 4 ? p.c_g_q : p.c_g_k) + (wc & 1) * 32 + fq * 4;
      const float4 g0 = *(const float4*)(gam), g1 = *(const float4*)(gam + 16);
      float finv[4];
#pragma unroll
      for (int j = 0; j < 4; ++j) finv[j] = exp2f(-(float)(fq * 4 + j) * 0.8304820237218406f);
      bf16_t* qb = (bf16_t*)p.big2();
      bf16_t* kb = qb + (long)T * 1024;
      float* outk = p.xo() + (long)T * 1024;
      const float qs = nt < 4 ? 0.125f * LOG2E : 1.f;
#pragma unroll
      for (int ai = 0; ai < 2; ++ai)
#pragma unroll
        for (int m = 0; m < 4; ++m) {
          const int R = rb + ai * 128 + m * 16 + fr;
          float cs[4] = {1.f, 1.f, 1.f, 1.f}, sn[4] = {0.f, 0.f, 0.f, 0.f};
          if (latt) {
            const int sp = (R - TCTX) & 2047;
            const float pos = (float)((wc & 1) ? (sp & 63) : (sp >> 6));
#pragma unroll
            for (int j = 0; j < 4; ++j) { const float ang = pos * finv[j]; cs[j] = __cosf(ang); sn[j] = __sinf(ang); }
          }
#pragma unroll
          for (int bj = 0; bj < 2; ++bj) {
            const float r = rinv[ai][bj][m];
            const f32x4 av = acc[ai][bj][m][0], bv = acc[ai][bj][m][1];
            float a[4] = {av[0] * r * g0.x, av[1] * r * g0.y, av[2] * r * g0.z, av[3] * r * g0.w};
            float b[4] = {bv[0] * r * g1.x, bv[1] * r * g1.y, bv[2] * r * g1.z, bv[3] * r * g1.w};
#pragma unroll
            for (int j = 0; j < 4; ++j) { const float na = a[j] * cs[j] - b[j] * sn[j], nb = a[j] * sn[j] + b[j] * cs[j]; a[j] = na; b[j] = nb; }
            const int cl = bj * 128 + wc * 32 + fq * 4;
            uint2 oa, ob2;
            oa.x = pk_bf16(a[0] * qs, a[1] * qs); oa.y = pk_bf16(a[2] * qs, a[3] * qs);
            ob2.x = pk_bf16(b[0] * qs, b[1] * qs); ob2.y = pk_bf16(b[2] * qs, b[3] * qs);
            if (nt < 4) {
              bf16_t* dst = qb + (long)R * 1024 + nt * 256 + cl;
              *(uint2*)dst = oa; *(uint2*)(dst + 16) = ob2;
            } else {
              bf16_t* dst = kb + (long)R * 256 + cl;
              *(uint2*)dst = oa; *(uint2*)(dst + 16) = ob2;
              if (!latt) {
                float* od = outk + (long)R * 256 + cl;
                *(float4*)od = make_float4(a[0], a[1], a[2], a[3]); *(float4*)(od + 16) = make_float4(b[0], b[1], b[2], b[3]);
              }
            }
          }
          asm volatile("" ::: "memory");
        }
    } else {
      float* edge = (float*)(smem + 131072 + 16);
      const int ecol = wc * 32 + fq * 4;
      if (fr == 0 || fr == 15) {
#pragma unroll
        for (int ai = 0; ai < 2; ++ai)
#pragma unroll
          for (int n = 0; n < 2; ++n) {
            const f32x4 v = fr == 0 ? acc[ai][0][0][n] : acc[ai][0][3][n];
            *(float4*)(edge + ((ai * 2 + wr) * 2 + (fr == 0 ? 0 : 1)) * 128 + ecol + n * 16) = make_float4(v[0], v[1], v[2], v[3]);
          }
      }
      if (mt >= 32) {
        const int lt = mt - 32;
        if (wid < 4 && fr < 2) {
#pragma unroll
          for (int n = 0; n < 2; ++n) {
            const f32x4 v = acc[0][0][0][n];
            *(float4*)(p.ha() + ((long)(lt * 4 + fr)) * 2816 + nt * 128 + ecol + n * 16) = make_float4(v[0], v[1], v[2], v[3]);
            if (fr == 0) { const f32x4 uv = acc[0][1][0][n]; *(float4*)(p.hu() + ((long)(lt * 2 + 0)) * 2816 + nt * 128 + ecol + n * 16) = make_float4(uv[0], uv[1], uv[2], uv[3]); }
          }
        }
        if (wid >= 4 && fr >= 14) {
#pragma unroll
          for (int n = 0; n < 2; ++n) {
            const f32x4 v = acc[1][0][3][n];
            *(float4*)(p.ha() + ((long)(lt * 4 + 2 + (fr - 14))) * 2816 + nt * 128 + ecol + n * 16) = make_float4(v[0], v[1], v[2], v[3]);
            if (fr == 15) { const f32x4 uv = acc[1][1][3][n]; *(float4*)(p.hu() + ((long)(lt * 2 + 1)) * 2816 + nt * 128 + ecol + n * 16) = make_float4(uv[0], uv[1], uv[2], uv[3]); }
          }
        }
      }
      __syncthreads();
      bf16_t* gbuf = (bf16_t*)p.big2();
      const float* cwp = p.ffn_conv_w + (long)layer * 3 * 2816 + nt * 128 + ecol;
      const float* cbp = p.ffn_conv_b + (long)layer * 2816 + nt * 128 + ecol;
      const unsigned lo = (unsigned)(fr * 2816 + fq * 4);
#pragma unroll
      for (int n = 0; n < 2; ++n) {
        const float4 w0 = *(const float4*)(cwp + n * 16), w1 = *(const float4*)(cwp + 2816 + n * 16), w2 = *(const float4*)(cwp + 5632 + n * 16), bb = *(const float4*)(cbp + n * 16);
        const float w0a[4] = {w0.x, w0.y, w0.z, w0.w}, w1a[4] = {w1.x, w1.y, w1.z, w1.w}, w2a[4] = {w2.x, w2.y, w2.z, w2.w}, bba[4] = {bb.x, bb.y, bb.z, bb.w};
#pragma unroll
        for (int ai = 0; ai < 2; ++ai) {
          float4 ep = make_float4(0.f, 0.f, 0.f, 0.f), en = make_float4(0.f, 0.f, 0.f, 0.f);
          if (wr == 1) ep = *(const float4*)(edge + ((ai * 2 + 0) * 2 + 1) * 128 + ecol + n * 16);
          else if (ai == 1) ep = *(const float4*)(edge + ((0 * 2 + 1) * 2 + 1) * 128 + ecol + n * 16);
          if (wr == 0) en = *(const float4*)(edge + ((ai * 2 + 1) * 2 + 0) * 128 + ecol + n * 16);
          else if (ai == 0) en = *(const float4*)(edge + ((1 * 2 + 0) * 2 + 0) * 128 + ecol + n * 16);
          const float epa[4] = {ep.x, ep.y, ep.z, ep.w}, ena[4] = {en.x, en.y, en.z, en.w};
          float gq[4][4];
#pragma unroll
          for (int j = 0; j < 4; ++j) {
            float U[4], Dn[4];
#pragma unroll
            for (int m = 0; m < 4; ++m) { U[m] = row_ror1(acc[ai][0][m][n][j]); Dn[m] = row_ror15(acc[ai][0][m][n][j]); }
#pragma unroll
            for (int m = 0; m < 4; ++m) {
              const float prev = fr == 0 ? (m > 0 ? U[m > 0 ? m - 1 : 0] : epa[j]) : U[m];
              const float next = fr == 15 ? (m < 3 ? Dn[m < 3 ? m + 1 : 3] : ena[j]) : Dn[m];
              const float x = w0a[j] * prev + w1a[j] * acc[ai][0][m][n][j] + w2a[j] * next + bba[j];
              gq[m][j] = gelu_f(x) * acc[ai][1][m][n][j];
            }
          }
#pragma unroll
          for (int m = 0; m < 4; ++m) {
            bf16_t* sb = gbuf + (long)(rb + ai * 128 + m * 16) * 2816 + nt * 128 + wc * 32 + n * 16;
            uint2 o; o.x = pk_bf16(gq[m][0], gq[m][1]); o.y = pk_bf16(gq[m][2], gq[m][3]);
            *(uint2*)(sb + lo) = o;
          }
        }
      }
    }
    }
  }
}

__device__ void phase_spatial(const P& p, int j, char* smem) {
  const int tid = opaque_tid(), lane = tid & 63, w = __builtin_amdgcn_readfirstlane(tid >> 6), wm = w >> 1, wn = w & 1, l31 = lane & 31, hh = lane >> 5;
  const int c = tid & 7, r0 = tid >> 3;
  const bf16_t* u = (const bf16_t*)p.big1();
  const bf16_t* vT = u + (long)T * 2048;
  bf16_t* tt = (bf16_t*)p.big2();
  const float* vsq = p.vsq() + (long)j * T;
  for (int item = opaque_bid(); item < 96 * 8; item += gridDim.x) {
    const int g = item & 7, chunk = item >> 3;
    const float* ws = p.a_w_s + ((long)(j * 8 + g) * 128) * 128;
#pragma unroll 1
    for (int kt = 0; kt < 2; ++kt) {
      float rs[8];
      {
        const float4 q0 = *(const float4*)(vsq + chunk * 128 + kt * 64 + c * 8), q1 = *(const float4*)(vsq + chunk * 128 + kt * 64 + c * 8 + 4);
        rs[0] = rsqrtf(q0.x * (1.f / 2048.f) + 1e-6f); rs[1] = rsqrtf(q0.y * (1.f / 2048.f) + 1e-6f);
        rs[2] = rsqrtf(q0.z * (1.f / 2048.f) + 1e-6f); rs[3] = rsqrtf(q0.w * (1.f / 2048.f) + 1e-6f);
        rs[4] = rsqrtf(q1.x * (1.f / 2048.f) + 1e-6f); rs[5] = rsqrtf(q1.y * (1.f / 2048.f) + 1e-6f);
        rs[6] = rsqrtf(q1.z * (1.f / 2048.f) + 1e-6f); rs[7] = rsqrtf(q1.w * (1.f / 2048.f) + 1e-6f);
      }
#pragma unroll
      for (int i = 0; i < 2; ++i) {
        const int r = r0 + 64 * i;
        const float4 a = *(const float4*)(ws + r * 128 + kt * 64 + c * 8), b = *(const float4*)(ws + r * 128 + kt * 64 + c * 8 + 4);
        uint4 o;
        o.x = pk_bf16(a.x * rs[0], a.y * rs[1]); o.y = pk_bf16(a.z * rs[2], a.w * rs[3]);
        o.z = pk_bf16(b.x * rs[4], b.y * rs[5]); o.w = pk_bf16(b.z * rs[6], b.w * rs[7]);
        *(uint4*)(smem + kt * 16384 + tile_off(r, c)) = o;
      }
#pragma unroll
      for (int i = 0; i < 4; ++i) {
        const int r = r0 + 64 * i;
        const uint4 bv = *(const uint4*)(vT + (long)(g * 256 + r) * T + chunk * 128 + kt * 64 + c * 8);
        *(uint4*)(smem + 32768 + kt * 32768 + tile_off(r, c)) = bv;
      }
    }
    __syncthreads();
    f32x16 acc[2][2];
#pragma unroll
    for (int mb = 0; mb < 2; ++mb)
#pragma unroll
      for (int nb = 0; nb < 2; ++nb)
#pragma unroll
        for (int i = 0; i < 16; ++i) acc[mb][nb][i] = 0.f;
    compute_ktile<false>(smem + 32768, smem, acc, wm, wn, lane);
    compute_ktile<false>(smem + 65536, smem + 16384, acc, wm, wn, lane);
    __syncthreads();
    float* svt = (float*)smem;
#pragma unroll
    for (int nb = 0; nb < 2; ++nb) {
      const int tok = wn * 64 + nb * 32 + l31;
#pragma unroll
      for (int mb = 0; mb < 2; ++mb)
#pragma unroll
        for (int q = 0; q < 4; ++q)
          *(float4*)(svt + tok * 260 + wm * 64 + mb * 32 + 8 * q + 4 * hh) = make_float4(acc[mb][nb][4 * q], acc[mb][nb][4 * q + 1], acc[mb][nb][4 * q + 2], acc[mb][nb][4 * q + 3]);
    }
    __syncthreads();
    {
      const int ch8 = (tid & 31) * 8;
      const float4 gv0 = *(const float4*)(p.a_g_v + j * 2048 + g * 256 + ch8), gv1 = *(const float4*)(p.a_g_v + j * 2048 + g * 256 + ch8 + 4);
#pragma unroll
      for (int it = 0; it < 8; ++it) {
        const int tok = (tid >> 5) + 16 * it;
        const float bs = p.a_b_s[(j * 8 + g) * 128 + tok];
        const float4 s0 = *(const float4*)(svt + tok * 260 + ch8), s1 = *(const float4*)(svt + tok * 260 + ch8 + 4);
        const long ro = (long)(chunk * 128 + tok) * 2048 + g * 256 + ch8;
        const uint4 uu = *(const uint4*)(u + ro);
        uint4 o;
        o.x = pk_bf16(bflo(uu.x) * (gv0.x * s0.x + bs), bfhi(uu.x) * (gv0.y * s0.y + bs));
        o.y = pk_bf16(bflo(uu.y) * (gv0.z * s0.z + bs), bfhi(uu.y) * (gv0.w * s0.w + bs));
        o.z = pk_bf16(bflo(uu.z) * (gv1.x * s1.x + bs), bfhi(uu.z) * (gv1.y * s1.y + bs));
        o.w = pk_bf16(bflo(uu.w) * (gv1.z * s1.z + bs), bfhi(uu.w) * (gv1.w * s1.w + bs));
        *(uint4*)(tt + ro) = o;
      }
    }
    __syncthreads();
  }
}

__device__ __forceinline__ void attn_block_lds(const char* __restrict__ Ks, const char* __restrict__ Vs, bool masked, int kpos0, int qpos,
                                               const bf16x8 (&bq)[4], float& m, float& lsum, f32x16& o0, f32x16& o1, int l31, int hh) {
  f32x16 s[2];
#pragma unroll
  for (int sb = 0; sb < 2; ++sb) {
#pragma unroll
    for (int i = 0; i < 16; ++i) s[sb][i] = 0.f;
#pragma unroll
    for (int ks = 0; ks < 4; ++ks) {
      const bf16x8 a = *(const bf16x8*)(Ks + tile_off(sb * 32 + l31, ks * 2 + hh));
      s[sb] = __builtin_amdgcn_mfma_f32_32x32x16_bf16(a, bq[ks], s[sb], 0, 0, 0);
    }
  }
  if (masked) {
#pragma unroll
    for (int sb = 0; sb < 2; ++sb)
#pragma unroll
      for (int i = 0; i < 16; ++i) {
        int dlt = qpos - (kpos0 + sb * 32 + crow(i, hh));
        dlt = dlt < 0 ? -dlt : dlt;
        if (dlt > 128) s[sb][i] = -1e30f;
      }
  }
  float mx = s[0][0];
#pragma unroll
  for (int sb = 0; sb < 2; ++sb)
#pragma unroll
    for (int i = 0; i < 16; ++i) mx = fmaxf(mx, s[sb][i]);
  mx = fmaxf(mx, __shfl_xor(mx, 32));
  const float mnew = fmaxf(m, mx);
  const float alpha = __builtin_amdgcn_exp2f(m - mnew);
  m = mnew;
  float ps = 0.f;
#pragma unroll
  for (int sb = 0; sb < 2; ++sb)
#pragma unroll
    for (int i = 0; i < 16; ++i) { s[sb][i] = __builtin_amdgcn_exp2f(s[sb][i] - mnew); ps += s[sb][i]; }
  lsum = lsum * alpha + ps;
#pragma unroll
  for (int i = 0; i < 16; ++i) { o0[i] *= alpha; o1[i] *= alpha; }
  const int sw0 = (l31 >> 1) & 7;
#pragma unroll
  for (int sb = 0; sb < 2; ++sb)
#pragma unroll
    for (int st = 0; st < 2; ++st) {
      uint4 pw;
      pw.x = pk_bf16(s[sb][8 * st + 0], s[sb][8 * st + 1]); pw.y = pk_bf16(s[sb][8 * st + 2], s[sb][8 * st + 3]);
      pw.z = pk_bf16(s[sb][8 * st + 4], s[sb][8 * st + 5]); pw.w = pk_bf16(s[sb][8 * st + 6], s[sb][8 * st + 7]);
      const bf16x8 pb = __builtin_bit_cast(bf16x8, pw);
      const int c0 = 4 * sb + 2 * st;
      const char* v0 = Vs + l31 * 128 + 8 * hh;
      uint4 va;
      { const uint2 lo = *(const uint2*)(v0 + ((c0 ^ sw0) << 4)), hi = *(const uint2*)(v0 + (((c0 + 1) ^ sw0) << 4)); va.x = lo.x; va.y = lo.y; va.z = hi.x; va.w = hi.y; }
      o0 = __builtin_amdgcn_mfma_f32_32x32x16_bf16(__builtin_bit_cast(bf16x8, va), pb, o0, 0, 0, 0);
      { const uint2 lo = *(const uint2*)(v0 + 4096 + ((c0 ^ sw0) << 4)), hi = *(const uint2*)(v0 + 4096 + (((c0 + 1) ^ sw0) << 4)); va.x = lo.x; va.y = lo.y; va.z = hi.x; va.w = hi.y; }
      o1 = __builtin_amdgcn_mfma_f32_32x32x16_bf16(__builtin_bit_cast(bf16x8, va), pb, o1, 0, 0, 0);
    }
}

__device__ void phase_attn(const P& p, char* smem) {
  const int tid = opaque_tid(), lane = tid & 63, w = __builtin_amdgcn_readfirstlane(tid >> 6), l31 = lane & 31, hh = lane >> 5;
  const int kr = tid >> 3, kc = tid & 7;
  const bf16_t* qb = (const bf16_t*)p.big2();
  const bf16_t* kb = qb + (long)T * 1024;
  const bf16_t* vTa = kb + (long)T * 256;
  bf16_t* ob = (bf16_t*)(vTa + (long)256 * T);
  const int lo_off = tile_off(kr, kc);
  for (int item = opaque_bid(); item < 768; item += gridDim.x) {
    const bool lat = item >= 512;
    int tok0, head, qblk, b;
    if (!lat) { b = item >> 4; head = item & 15; qblk = 0; tok0 = b * 256; }
    else { const int it = item - 512; b = it >> 7; head = (it >> 3) & 15; qblk = it & 7; tok0 = TCTX + b * 2048; }
    const int kvh = head >> 2;
    const int qloc = qblk * 256 + w * 32;
    const long qrow = tok0 + qloc + l31;
    bf16x8 bq[4];
#pragma unroll
    for (int ks = 0; ks < 4; ++ks) bq[ks] = *(const bf16x8*)(qb + qrow * 1024 + head * 64 + ks * 16 + hh * 8);
    float m = p.c_sink[head] * LOG2E;
    float lsum = hh == 0 ? 1.f : 0.f;
    f32x16 o0, o1;
#pragma unroll
    for (int i = 0; i < 16; ++i) { o0[i] = 0.f; o1[i] = 0.f; }
    int wlo = 0, nwin = 4;
    if (lat) {
      wlo = qblk * 256 - 128; wlo = wlo < 0 ? 0 : wlo;
      int whi = qblk * 256 + 384; whi = whi > 2048 ? 2048 : whi;
      nwin = (whi - wlo) >> 6;
    }
    const int nblk = lat ? nwin + 4 : 4;
    const bf16_t* kwin = kb + (long)(tok0 + wlo + kr) * 256 + kvh * 64 + kc * 8;
    const bf16_t* vwin = vTa + (long)(kvh * 64 + kr) * T + tok0 + wlo + kc * 8;
    const bf16_t* kcach = p.ck() + (long)(b * 256 + kr) * 256 + kvh * 64 + kc * 8;
    const bf16_t* vcach = p.cvT() + (long)(b * 256 + kvh * 64 + kr) * 256 + kc * 8;
    uint4 rk, rv;
    rk = gld16(kwin); rv = gld16(vwin);
    asm volatile("s_waitcnt vmcnt(0)" ::: "memory");
    *(uint4*)(smem + lo_off) = rk; *(uint4*)(smem + 8192 + lo_off) = rv;
    __syncthreads();
    for (int bi = 0; bi < nblk; ++bi) {
      const bool more = bi + 1 < nblk;
      if (more) {
        const int nb = bi + 1;
        if (nb < nwin) { rk = gld16(kwin + (long)nb * 64 * 256); rv = gld16(vwin + nb * 64); }
        else { rk = gld16(kcach + (long)(nb - nwin) * 64 * 256); rv = gld16(vcach + (nb - nwin) * 64); }
      }
      const char* Ks = smem + (bi & 1) * 16384;
      if (bi < nwin) {
        const int k0 = wlo + 64 * bi;
        if (!lat) attn_block_lds(Ks, Ks + 8192, false, 0, 0, bq, m, lsum, o0, o1, l31, hh);
        else if (!(k0 + 63 < qloc - 128 || k0 > qloc + 31 + 128)) attn_block_lds(Ks, Ks + 8192, true, k0, qloc + l31, bq, m, lsum, o0, o1, l31, hh);
      } else {
        attn_block_lds(Ks, Ks + 8192, false, 0, 0, bq, m, lsum, o0, o1, l31, hh);
      }
      if (more) {
        asm volatile("s_waitcnt vmcnt(0)" ::: "memory");
        char* Kn = smem + ((bi + 1) & 1) * 16384;
        *(uint4*)(Kn + lo_off) = rk; *(uint4*)(Kn + 8192 + lo_off) = rv;
      }
      __syncthreads();
    }
    lsum += __shfl_xor(lsum, 32);
    const float inv = 1.f / lsum;
#pragma unroll
    for (int q = 0; q < 4; ++q) {
      uint2 v0, v1;
      v0.x = pk_bf16(o0[4 * q] * inv, o0[4 * q + 1] * inv); v0.y = pk_bf16(o0[4 * q + 2] * inv, o0[4 * q + 3] * inv);
      v1.x = pk_bf16(o1[4 * q] * inv, o1[4 * q + 1] * inv); v1.y = pk_bf16(o1[4 * q + 2] * inv, o1[4 * q + 3] * inv);
      *(uint2*)(ob + qrow * 1024 + head * 64 + 8 * q + 4 * hh) = v0;
      *(uint2*)(ob + qrow * 1024 + head * 64 + 32 + 8 * q + 4 * hh) = v1;
    }
  }
}

enum { OP_PREP, OP_FIRST, OP_NORM_MIX, OP_GMLP_IN, OP_SPATIAL, OP_GMLP_OUT, OP_FFN_IN, OP_FFN_FIX, OP_FFN_OUT, OP_POOL, OP_POOL_GEMM, OP_QKV, OP_QKPREP, OP_ATTN, OP_WO };
__constant__ unsigned char c_prog[NPH][2] = {
    {OP_PREP, 0}, {OP_FIRST, 0},
    {OP_GMLP_IN, 0}, {OP_SPATIAL, 0}, {OP_GMLP_OUT, 0}, {OP_FFN_IN, 0}, {OP_FFN_OUT, 0},
    {OP_POOL_GEMM, 1}, {OP_FFN_IN, 1}, {OP_FFN_OUT, 1},
    {OP_QKV, 2}, {OP_ATTN, 2}, {OP_WO, 2}, {OP_FFN_IN, 2}, {OP_FFN_OUT, 2},
    {OP_GMLP_IN, 3}, {OP_SPATIAL, 3}, {OP_GMLP_OUT, 3}, {OP_FFN_IN, 3}, {OP_FFN_OUT, 3}};

__device__ void run_phase(const P& p0, int ph, char* smem) {
  P p = p0;
  asm volatile("" : "+s"(p.ws), "+s"(p.out_g));
  const int op = c_prog[ph][0], layer = c_prog[ph][1];
  const int j = layer / 3;
  switch (op) {
    case OP_PREP: phase_prep(p, smem); break;
    case OP_FIRST: phase_norm(p, 0, 0, true); phase_shw(p, 0, 5632, 0, 0, false); break;
    case OP_NORM_MIX: phase_norm(p, layer, 0, false); break;
    case OP_GMLP_IN: {
      const int fx = layer == 0 ? -1 : 2 * layer;
      phase_gemm<G_GMLP_IN>(p, p.h(), 1024, p.wt_a_in() + (long)j * 4096 * 1024, 1024, 1024, 8, layer, j, fx, smem);
      phase_gemm<G_GMLP_V>(p, p.h(), 1024, p.wt_a_in() + (long)j * 4096 * 1024, 1024, 1024, 8, layer, j, fx, smem);
    } break;
    case OP_SPATIAL: phase_spatial(p, j, smem); break;
    case OP_GMLP_OUT: phase_gemm<G_RESID>(p, (const bf16_t*)p.big2(), 2048, p.wt_a_out() + (long)j * 1024 * 2048, 2048, 2048, 4, layer, 2048, 2 * layer + 1, smem); break;
    case OP_FFN_IN:
      phase_gemm<G_FFN_IN>(p, p.h(), 1024, p.wt_ffn_in() + (long)layer * 5632 * 1024, 1024, 1024, 22, layer, 0, 2 * layer + 1, smem);
      if (layer < 3) phase_filler(p, layer + 1, smem);
      break;
    case OP_FFN_OUT:
      phase_gemm<G_RESID>(p, (const bf16_t*)p.big2(), 2816, p.wt_ffn_out() + (long)layer * 1024 * 2816, 2816, 2816, 4, layer, 5120, layer <= 2 ? 2 * layer + 2 : -1, smem);
      if (layer == 0) phase_shw(p, 5632, 11264, 0, 0, true);
      else if (layer == 1) phase_shw(p, 11264, 16896, 22528, 24064, true);
      else if (layer == 2) phase_shw(p, 16896, 22528, 24064, 28160, true);
      break;
    case OP_POOL_GEMM: phase_gemm<G_POOL>(p, (const bf16_t*)p.big1(), 1024, p.wt_p(), 256, 256, 4, layer, 2048, 2 * layer + 1, smem); break;
    case OP_QKV:
      phase_gemm<G_QKV>(p, p.h(), 1024, p.wt_qkv(), 1024, 1024, 5, layer, 0, 2 * layer, smem);
      phase_gemm<G_QKV_V>(p, p.h(), 1024, p.wt_qkv(), 1024, 1024, 1, layer, 0, 2 * layer, smem);
      break;
    case OP_ATTN: phase_attn(p, smem); break;
    default: phase_gemm<G_RESID>(p, (const bf16_t*)p.big2() + (long)T * 1024 + (long)T * 256 + (long)256 * T, 1024, p.wt_o(), 1024, 1024, 4, layer, 2048, 2 * layer + 1, smem); break;
  }
}

#define XB_TMO      128
#define XB_XCNT(j)  (256  + 64 * (j))
#define XB_XSUB(j)  (1280 + 64 * (j))
#define XB_XGEN(j)  (2304 + 64 * (j))
#define XB_TOP      3328
#define XB_TOPGEN   3392
#define XCD_BAR_WORDS 3456
#define XB_SPIN_CAP (1u << 22)
#define LAS __attribute__((address_space(3)))
__device__ __forceinline__ unsigned xb_ld(unsigned* p) { return __hip_atomic_load(p, __ATOMIC_RELAXED, __HIP_MEMORY_SCOPE_AGENT); }
__device__ __forceinline__ unsigned xb_add(unsigned* p, unsigned v) { return __hip_atomic_fetch_add(p, v, __ATOMIC_RELAXED, __HIP_MEMORY_SCOPE_AGENT); }
__device__ __forceinline__ unsigned xb_xcc_id() { return (unsigned)__builtin_amdgcn_s_getreg((3 << 11) | 20) & 0xFu; }
#define XB_SPIN(cond, bar) do { unsigned _sp = 0; while (cond) { __builtin_amdgcn_s_sleep(1); \
    if ((++_sp & 255u) == 0u) { if (xb_ld(&(bar)[XB_TMO])) break; if (_sp > XB_SPIN_CAP) { atomicAdd(&(bar)[XB_TMO], 1u); break; } } } } while (0)
struct XcdBarrier { unsigned* bar; unsigned x; volatile LAS unsigned* st; };
__device__ __forceinline__ XcdBarrier xcd_barrier_post(unsigned* bar, volatile LAS unsigned* st) {
  XcdBarrier b; b.bar = bar; b.x = xb_xcc_id(); b.st = st;
  if (threadIdx.x == 0) (void)xb_add(&bar[XB_XCNT(b.x)], 1u);
  return b;
}
__device__ __forceinline__ void xcd_barrier_complete(unsigned* bar, unsigned x, unsigned& nloc, unsigned& nx) {
  const unsigned G = gridDim.x * gridDim.y * gridDim.z;
  unsigned sum, cnt, mine, sp = 0u;
  for (;;) {
    sum = 0u; cnt = 0u; mine = 0u;
#pragma unroll
    for (unsigned j = 0; j < 16; ++j) { const unsigned c = xb_ld(&bar[XB_XCNT(j)]); sum += c; cnt += (c > 0u) ? 1u : 0u; mine = (j == x) ? c : mine; }
    if (sum == G) break;
    __builtin_amdgcn_s_sleep(1);
    if ((++sp & 255u) == 0u) { if (xb_ld(&bar[XB_TMO])) break; if (sp > XB_SPIN_CAP) { atomicAdd(&bar[XB_TMO], 1u); break; } }
  }
  nloc = mine > 0u ? mine : 1u; nx = cnt > 0u ? cnt : 1u;
}
__device__ __forceinline__ void xcd_barrier(const XcdBarrier& b) {
  asm volatile("s_waitcnt vmcnt(0)" ::: "memory");
  __syncthreads();
  if (threadIdx.x == 0) {
    unsigned* bar = b.bar;
    __builtin_amdgcn_s_waitcnt(0);
    unsigned nloc = b.st[0], nx = b.st[1];
    if (nloc == 0u) { xcd_barrier_complete(bar, b.x, nloc, nx); b.st[0] = nloc; b.st[1] = nx; }
    const unsigned old = xb_add(&bar[XB_XSUB(b.x)], 1u);
    const unsigned gen = old / nloc;
    if (old + 1u == (gen + 1u) * nloc) {
      __builtin_amdgcn_fence(__ATOMIC_RELEASE, "agent");
      asm volatile("s_waitcnt vmcnt(0)" ::: "memory");
      const unsigned og = xb_add(&bar[XB_TOP], 1u);
      const unsigned tg = og / nx;
      if (og + 1u == (tg + 1u) * nx) xb_add(&bar[XB_TOPGEN], 1u);
      else XB_SPIN(xb_ld(&bar[XB_TOPGEN]) == tg, bar);
      __builtin_amdgcn_fence(__ATOMIC_ACQUIRE, "agent");
      xb_add(&bar[XB_XGEN(b.x)], 1u);
      asm volatile("s_waitcnt vmcnt(0)" ::: "memory");
    } else {
      XB_SPIN(xb_ld(&bar[XB_XGEN(b.x)]) == gen, bar);
      __builtin_amdgcn_fence(__ATOMIC_ACQUIRE, "agent");
      asm volatile("s_waitcnt vmcnt(0)" ::: "memory");
    }
  }
  __syncthreads();
}

__global__ void __launch_bounds__(512, 2) mega(P p, unsigned* bar, int lo, int hi) {
  __shared__ __attribute__((aligned(16))) char smem[131072 + 16 + 4096 + 8192 + 16];
  if (hi < 0) cg::this_grid().sync();
  volatile LAS unsigned* st = (volatile LAS unsigned*)(smem + 131072 + 16 + 4096 + 8192);
  if (threadIdx.x == 0) { st[0] = 0u; st[1] = 0u; }
  __syncthreads();
  XcdBarrier xb = xcd_barrier_post(bar, st);
  for (int ph = lo; ph < hi; ++ph) {
    if (ph > lo) xcd_barrier(xb);
    run_phase(p, ph, smem);
  }
}

extern "C" void kernel_launch(void* const* d_in, const int* in_sizes, int n_in, void* d_out, int out_size, void* d_ws, size_t ws_size, hipStream_t stream) {
  static int grid_blocks = 0;
  if (!grid_blocks) {
    int dev = 0, cus = 0, per_cu = 0;
    (void)hipGetDevice(&dev);
    (void)hipDeviceGetAttribute(&cus, hipDeviceAttributeMultiprocessorCount, dev);
    (void)hipOccupancyMaxActiveBlocksPerMultiprocessor(&per_cu, mega, 512, 0);
    if (per_cu > 1) per_cu = 1;
    if (per_cu < 1) per_cu = 1;
    grid_blocks = cus * per_cu;
  }
  P p{};
  const float* const* in = (const float* const*)d_in;
  p.x_prompt = in[0]; p.x_sample = in[1]; p.cache_k = in[2]; p.cache_v = in[3]; p.c = in[4]; p.c_ctx = in[5];
  p.w_ada = in[6]; p.b_ada = in[7]; p.g_mix = in[8]; p.g_ffn = in[9]; p.w_ffn_in = in[10]; p.ffn_conv_w = in[11]; p.ffn_conv_b = in[12]; p.w_ffn_out = in[13];
  p.a_w_in = in[14]; p.a_g_v = in[15]; p.a_w_s = in[16]; p.a_b_s = in[17]; p.a_w_out = in[18];
  p.p_w = in[19]; p.p_b = in[20]; p.p_scale = in[21];
  p.c_w_qkv = in[22]; p.c_g_q = in[23]; p.c_g_k = in[24]; p.c_sink = in[25]; p.c_w_o = in[26];
  p.out_g = (__attribute__((address_space(1))) float*)d_out;
  char* ws = (char*)d_ws;
  unsigned* bar = (unsigned*)ws;
  p.ws = (__attribute__((address_space(1))) char*)ws;
  if ((size_t)335869440ull > ws_size) { fprintf(stderr, "workspace too small: need %zu have %zu\n", (size_t)335869440ull, ws_size); return; }
#if ONE_LAUNCH
  int lo = 0, hi = NPH;
  (void)hipMemsetAsync(bar, 0, (size_t)XCD_BAR_WORDS * 4, stream);
  void* args[] = {&p, &bar, &lo, &hi};
  hipError_t e = hipLaunchCooperativeKernel((void*)mega, dim3(grid_blocks), dim3(512), args, 0, stream);
  if (e != hipSuccess) {
    fprintf(stderr, "cooperative launch failed: %s (grid %d); falling back to one launch per phase\n", hipGetErrorString(e), grid_blocks);
    (void)hipGetLastError();
    for (int ph = 0; ph < NPH; ++ph) mega<<<grid_blocks, 512, 0, stream>>>(p, bar, ph, ph + 1);
  }
#else
  for (int ph = 0; ph < NPH; ++ph) mega<<<grid_blocks, 512, 0, stream>>>(p, bar, ph, ph + 1);
#endif
}
```
